# Optimizing an MI355X kernel written in HIP

```python
import math
import jax
import jax.numpy as jnp
from jax import lax
import numpy as np


D_MODEL = 1024
BATCH = 4
SEQ = 4096
DEPTH = 2

NORM_EPS = 1e-6
GDN_HEADS = 4
GDN_HEAD_DIM = 128
GDN_WIDTH = GDN_HEADS * GDN_HEAD_DIM
GDN_CHUNK = 64
CONV_WIDTH = 4
GDN_COLS = 4 * GDN_WIDTH + 2 * GDN_HEADS
RWKV_HEADS = 8
RWKV_HEAD_DIM = 64
RWKV_WIDTH = RWKV_HEADS * RWKV_HEAD_DIM
DECAY_LORA = 64
AAA_LORA = 64
GATE_LORA = 128
RWKV_COLS = 3 * RWKV_WIDTH + DECAY_LORA + AAA_LORA + GATE_LORA
RWKV_GN_EPS = 64e-5
MIX_WIDTH = GDN_WIDTH + RWKV_WIDTH
LRU_WIDTH = D_MODEL
LRU_BLOCKS = 4
LRU_BLOCK = LRU_WIDTH // LRU_BLOCKS
LRU_C = 8.0
D_FF = -(-8 * D_MODEL // (3 * 256)) * 256

kernel_name = 'hybrid_gdn_rwkv7_rglru_block'


def rms_norm(x, w):
    xf = x.astype(jnp.float32)
    y = xf * lax.rsqrt(jnp.mean(xf * xf, axis=-1, keepdims=True) + NORM_EPS)
    return (y * w.astype(jnp.float32)).astype(x.dtype)


def l2_normalize(x):
    return x * lax.rsqrt(jnp.sum(x * x, axis=-1, keepdims=True) + NORM_EPS)


def adaln_params(c, w, b):
    m = (jax.nn.silu(c) @ w + b)[:, None, :]
    shift, scale, gate = jnp.split(m, 3, axis=-1)
    return shift, scale, gate


def causal_depthwise_conv(x, w):
    width = w.shape[0]
    T = x.shape[1]
    xp = jnp.pad(x, ((0, 0), (width - 1, 0), (0, 0)))
    y = xp[:, 0:T] * w[0]
    for j in range(1, width):
        y = y + xp[:, j:j + T] * w[j]
    return y


def token_shift(x):
    return jnp.pad(x, ((0, 0), (1, 0), (0, 0)))[:, :-1]


def chunk_gated_delta_rule(q, k, v, g, beta):
    Bsz, T, H, Dk = q.shape
    Dv = v.shape[-1]
    C = GDN_CHUNK
    N = T // C

    def chunk(t):
        t = t.reshape((Bsz, N, C, H) + t.shape[3:])
        return jnp.moveaxis(t, 3, 1)

    q = chunk(q) * (Dk ** -0.5)
    k = chunk(k)
    v = chunk(v)
    g = chunk(g)
    beta = chunk(beta)
    G = jnp.cumsum(g, axis=-1)
    causal = jnp.tril(jnp.ones((C, C), dtype=bool))
    strict = jnp.tril(jnp.ones((C, C), dtype=bool), -1)
    decay = jnp.exp(jnp.where(causal, G[..., :, None] - G[..., None, :], -jnp.inf))
    k_beta = k * beta[..., None]
    m = jnp.where(strict, jnp.einsum('bhnik,bhnjk->bhnij', k_beta, k) * decay, 0.0)
    rhs = jnp.concatenate([v * beta[..., None], k_beta * jnp.exp(G)[..., None]], axis=-1)
    sol = lax.linalg.triangular_solve(m + jnp.eye(C, dtype=m.dtype), rhs, left_side=True,
                                      lower=True, unit_diagonal=True)
    u = sol[..., :Dv]
    w = sol[..., Dv:]
    attn = jnp.where(causal, jnp.einsum('bhnik,bhnjk->bhnij', q, k) * decay, 0.0)
    q_dec = q * jnp.exp(G)[..., None]
    k_dec = k * jnp.exp(G[..., -1:] - G)[..., None]
    g_last = jnp.exp(G[..., -1])
    xs = tuple(jnp.moveaxis(t, 2, 0) for t in (q_dec, k_dec, u, w, attn, g_last))

    def step(S, inp):
        qd, kd, uc, wc, ac, gl = inp
        v_new = uc - jnp.einsum('bhck,bhkv->bhcv', wc, S)
        o = jnp.einsum('bhck,bhkv->bhcv', qd, S) + jnp.einsum('bhcs,bhsv->bhcv', ac, v_new)
        S = S * gl[..., None, None] + jnp.einsum('bhck,bhcv->bhkv', kd, v_new)
        return S, o

    S0 = jnp.zeros((Bsz, H, Dk, Dv), dtype=q.dtype)
    _, o = lax.scan(step, S0, xs)
    o = jnp.moveaxis(o, 0, 2)
    return jnp.moveaxis(o, 1, 3).reshape(Bsz, T, H, Dv)


def gated_deltanet_group(cols, conv_w, a_log, dt_bias, norm_w):
    Bsz, T, _ = cols.shape
    W = GDN_WIDTH
    qkv = jax.nn.silu(causal_depthwise_conv(cols[..., :3 * W], conv_w)).astype(jnp.float32)
    z = cols[..., 3 * W:4 * W].astype(jnp.float32).reshape(Bsz, T, GDN_HEADS, GDN_HEAD_DIM)
    alpha = cols[..., 4 * W:4 * W + GDN_HEADS].astype(jnp.float32)
    b = cols[..., 4 * W + GDN_HEADS:].astype(jnp.float32)
    q, k, v = jnp.split(qkv, 3, axis=-1)
    q = l2_normalize(q.reshape(Bsz, T, GDN_HEADS, GDN_HEAD_DIM))
    k = l2_normalize(k.reshape(Bsz, T, GDN_HEADS, GDN_HEAD_DIM))
    v = v.reshape(Bsz, T, GDN_HEADS, GDN_HEAD_DIM)
    beta = jax.nn.sigmoid(b)
    g = -jnp.exp(a_log.astype(jnp.float32)) * jax.nn.softplus(alpha + dt_bias.astype(jnp.float32))
    o = chunk_gated_delta_rule(q, k, v, g, beta)
    o = rms_norm(o, norm_w) * jax.nn.silu(z)
    return o.reshape(Bsz, T, W).astype(cols.dtype)


def rwkv7_group(cols, mu, w0, w2, a0, a2, g2, k_k, k_a, r_k, ln_w, ln_b):
    Bsz, T, _ = cols.shape
    W = RWKV_WIDTH
    H = RWKV_HEADS
    Dh = RWKV_HEAD_DIM
    cf = cols.astype(jnp.float32)
    cf = cf + mu * (token_shift(cf) - cf)
    r = cf[..., :W]
    k = cf[..., W:2 * W]
    v = cf[..., 2 * W:3 * W]
    off = 3 * W
    wd = cf[..., off:off + DECAY_LORA]
    off = off + DECAY_LORA
    ad = cf[..., off:off + AAA_LORA]
    off = off + AAA_LORA
    gd = cf[..., off:off + GATE_LORA]
    w_log = -jax.nn.softplus(-(w0 + jnp.tanh(wd) @ w2)) - 0.5
    decay = jnp.exp(-jnp.exp(w_log))
    a = jax.nn.sigmoid(a0 + ad @ a2)
    g = jax.nn.sigmoid(gd) @ g2

    def heads(t):
        return t.reshape(Bsz, T, H, Dh)

    kk = l2_normalize(heads(k * k_k))
    k = k * (1.0 + (a - 1.0) * k_a)
    r, k, v, decay, a = heads(r), heads(k), heads(v), heads(decay), heads(a)
    kka = kk * a
    xs = tuple(jnp.moveaxis(t, 1, 0) for t in (r, decay, k, v, kk, kka))

    def step(S, inp):
        r_t, w_t, k_t, v_t, kk_t, b_t = inp
        sa = -jnp.einsum('bhvk,bhk->bhv', S, kk_t)
        S = S * w_t[:, :, None, :] + sa[..., None] * b_t[:, :, None, :] + v_t[..., None] * k_t[:, :, None, :]
        return S, jnp.einsum('bhvk,bhk->bhv', S, r_t)

    S0 = jnp.zeros((Bsz, H, Dh, Dh), dtype=jnp.float32)
    _, y = lax.scan(step, S0, xs)
    y = jnp.moveaxis(y, 0, 1)
    mean = jnp.mean(y, axis=-1, keepdims=True)
    var = jnp.mean(jnp.square(y - mean), axis=-1, keepdims=True)
    y = ((y - mean) * lax.rsqrt(var + RWKV_GN_EPS)).reshape(Bsz, T, W) * ln_w + ln_b
    bonus = (jnp.sum(r * k * r_k, axis=-1, keepdims=True) * v).reshape(Bsz, T, W)
    y = (y + bonus) * g
    return y.astype(cols.dtype)


def delta_rwkv_mixer(h, w_in, w_out, gdn_conv_w, gdn_a_log, gdn_dt_bias, gdn_norm_w,
                     rwkv_mu, rwkv_w0, rwkv_w2, rwkv_a0, rwkv_a2, rwkv_g2, rwkv_k_k, rwkv_k_a,
                     rwkv_r_k, rwkv_ln_w, rwkv_ln_b):
    cols = h @ w_in
    out_a = gated_deltanet_group(cols[..., :GDN_COLS], gdn_conv_w, gdn_a_log, gdn_dt_bias, gdn_norm_w)
    out_b = rwkv7_group(cols[..., GDN_COLS:], rwkv_mu, rwkv_w0, rwkv_w2, rwkv_a0, rwkv_a2, rwkv_g2,
                        rwkv_k_k, rwkv_k_a, rwkv_r_k, rwkv_ln_w, rwkv_ln_b)
    return jnp.concatenate([out_a, out_b], axis=-1) @ w_out


def rglru_mixer(h, w_in, conv_w, conv_b, wa, ba, wx, bx, lam, w_out):
    Bsz, T, _ = h.shape
    gate_branch, xb = jnp.split(h @ w_in, 2, axis=-1)
    xb = (causal_depthwise_conv(xb, conv_w) + conv_b).astype(jnp.float32)
    xblk = xb.reshape(Bsz, T, LRU_BLOCKS, LRU_BLOCK)
    r = jax.nn.sigmoid(jnp.einsum('btnd,nde->btne', xblk, wa).reshape(Bsz, T, LRU_WIDTH) + ba)
    i = jax.nn.sigmoid(jnp.einsum('btnd,nde->btne', xblk, wx).reshape(Bsz, T, LRU_WIDTH) + bx)
    log_a = -LRU_C * r * jax.nn.softplus(-lam)
    a = jnp.exp(log_a)
    u = xb * i * jnp.sqrt(-jnp.expm1(2.0 * log_a))

    def combine(left, right):
        a_l, u_l = left
        a_r, u_r = right
        return a_l * a_r, a_r * u_l + u_r

    _, hs = lax.associative_scan(combine, (a, u), axis=1)
    y = hs.astype(h.dtype) * jax.nn.gelu(gate_branch)
    return y @ w_out


def swiglu_ffn(h, w_gate, w_up, w_down):
    return (jax.nn.silu(h @ w_gate) * (h @ w_up)) @ w_down


def setup_inputs(seed: int = 0) -> dict:
    key = jax.random.key(seed)
    keys = iter(jax.random.split(key, 48))
    f32 = jnp.float32

    def normal(shape, scale):
        return scale * jax.random.normal(next(keys), shape, f32)

    def uniform(shape, lo, hi):
        return jax.random.uniform(next(keys), shape, f32, lo, hi)

    D = D_MODEL
    L = DEPTH
    NE = (DEPTH + 1) // 2
    NO = DEPTH // 2
    x = normal((BATCH, SEQ, D), 1.0)
    c = normal((BATCH, D), 1.0)
    norm_pre = 1.0 + normal((L, 2, D), 0.05)
    norm_post = 1.0 + normal((L, 2, D), 0.05)
    ada_w = normal((L, 2, D, 3 * D), D ** -0.5)
    ada_b = normal((L, 2, 3 * D), 0.02)
    ffn_w_gate = normal((L, D, D_FF), D ** -0.5)
    ffn_w_up = normal((L, D, D_FF), D ** -0.5)
    ffn_w_down = normal((L, D_FF, D), D_FF ** -0.5)
    mix_w_in = normal((NE, D, GDN_COLS + RWKV_COLS), D ** -0.5)
    mix_w_out = normal((NE, MIX_WIDTH, D), MIX_WIDTH ** -0.5)
    gdn_conv_w = normal((NE, CONV_WIDTH, 3 * GDN_WIDTH), CONV_WIDTH ** -0.5)
    gdn_a_log = jnp.log(uniform((NE, GDN_HEADS), 1.0, 16.0))
    dt = jnp.exp(uniform((NE, GDN_HEADS), math.log(1e-3), math.log(1e-1)))
    gdn_dt_bias = dt + jnp.log(-jnp.expm1(-dt))
    gdn_norm_w = 1.0 + normal((NE, GDN_HEAD_DIM), 0.05)
    rwkv_mu = uniform((NE, RWKV_COLS), 0.0, 1.0)
    rwkv_w0 = uniform((NE, RWKV_WIDTH), -6.0, -1.0)
    rwkv_w2 = normal((NE, DECAY_LORA, RWKV_WIDTH), 0.3 * DECAY_LORA ** -0.5)
    rwkv_a0 = normal((NE, RWKV_WIDTH), 0.1)
    rwkv_a2 = normal((NE, AAA_LORA, RWKV_WIDTH), AAA_LORA ** -0.5)
    rwkv_g2 = normal((NE, GATE_LORA, RWKV_WIDTH), GATE_LORA ** -0.5)
    rwkv_k_k = 0.85 + normal((NE, RWKV_WIDTH), 0.05)
    rwkv_k_a = 1.0 + normal((NE, RWKV_WIDTH), 0.05)
    rwkv_r_k = normal((NE, RWKV_HEADS, RWKV_HEAD_DIM), 0.1)
    rwkv_ln_w = 1.0 + normal((NE, RWKV_WIDTH), 0.05)
    rwkv_ln_b = normal((NE, RWKV_WIDTH), 0.02)
    lru_w_in = normal((NO, D, 2 * LRU_WIDTH), D ** -0.5)
    lru_conv_w = normal((NO, CONV_WIDTH, LRU_WIDTH), CONV_WIDTH ** -0.5)
    lru_conv_b = normal((NO, LRU_WIDTH), 0.02)
    lru_wa = normal((NO, LRU_BLOCKS, LRU_BLOCK, LRU_BLOCK), LRU_BLOCK ** -0.5)
    lru_ba = normal((NO, LRU_WIDTH), 0.02)
    lru_wx = normal((NO, LRU_BLOCKS, LRU_BLOCK, LRU_BLOCK), LRU_BLOCK ** -0.5)
    lru_bx = normal((NO, LRU_WIDTH), 0.02)
    a_init = uniform((NO, LRU_WIDTH), 0.9, 0.999) ** (1.0 / LRU_C)
    lru_lambda = jnp.log(a_init) - jnp.log1p(-a_init)
    lru_w_out = normal((NO, LRU_WIDTH, D), LRU_WIDTH ** -0.5)
    return {'x': x, 'c': c, 'norm_pre': norm_pre, 'norm_post': norm_post, 'ada_w': ada_w, 'ada_b': ada_b,
            'ffn_w_gate': ffn_w_gate, 'ffn_w_up': ffn_w_up, 'ffn_w_down': ffn_w_down,
            'mix_w_in': mix_w_in, 'mix_w_out': mix_w_out, 'gdn_conv_w': gdn_conv_w, 'gdn_a_log': gdn_a_log,
            'gdn_dt_bias': gdn_dt_bias, 'gdn_norm_w': gdn_norm_w, 'rwkv_mu': rwkv_mu, 'rwkv_w0': rwkv_w0,
            'rwkv_w2': rwkv_w2, 'rwkv_a0': rwkv_a0, 'rwkv_a2': rwkv_a2, 'rwkv_g2': rwkv_g2,
            'rwkv_k_k': rwkv_k_k, 'rwkv_k_a': rwkv_k_a, 'rwkv_r_k': rwkv_r_k, 'rwkv_ln_w': rwkv_ln_w,
            'rwkv_ln_b': rwkv_ln_b, 'lru_w_in': lru_w_in, 'lru_conv_w': lru_conv_w, 'lru_conv_b': lru_conv_b,
            'lru_wa': lru_wa, 'lru_ba': lru_ba, 'lru_wx': lru_wx, 'lru_bx': lru_bx, 'lru_lambda': lru_lambda,
            'lru_w_out': lru_w_out}


def reference(x, c, norm_pre, norm_post, ada_w, ada_b, ffn_w_gate, ffn_w_up, ffn_w_down,
              mix_w_in, mix_w_out, gdn_conv_w, gdn_a_log, gdn_dt_bias, gdn_norm_w,
              rwkv_mu, rwkv_w0, rwkv_w2, rwkv_a0, rwkv_a2, rwkv_g2, rwkv_k_k, rwkv_k_a, rwkv_r_k,
              rwkv_ln_w, rwkv_ln_b, lru_w_in, lru_conv_w, lru_conv_b, lru_wa, lru_ba, lru_wx, lru_bx,
              lru_lambda, lru_w_out):
    for layer in range(DEPTH):
        j = layer // 2
        shift, scale, gate = adaln_params(c, ada_w[layer, 0], ada_b[layer, 0])
        h = rms_norm(x, norm_pre[layer, 0]) * (1.0 + scale) + shift
        if layer % 2 == 0:
            y = delta_rwkv_mixer(h, mix_w_in[j], mix_w_out[j], gdn_conv_w[j], gdn_a_log[j], gdn_dt_bias[j],
                                 gdn_norm_w[j], rwkv_mu[j], rwkv_w0[j], rwkv_w2[j], rwkv_a0[j], rwkv_a2[j],
                                 rwkv_g2[j], rwkv_k_k[j], rwkv_k_a[j], rwkv_r_k[j], rwkv_ln_w[j], rwkv_ln_b[j])
        else:
            y = rglru_mixer(h, lru_w_in[j], lru_conv_w[j], lru_conv_b[j], lru_wa[j], lru_ba[j], lru_wx[j],
                            lru_bx[j], lru_lambda[j], lru_w_out[j])
        x = x + gate * rms_norm(y, norm_post[layer, 0])
        shift, scale, gate = adaln_params(c, ada_w[layer, 1], ada_b[layer, 1])
        h = rms_norm(x, norm_pre[layer, 1]) * (1.0 + scale) + shift
        y = swiglu_ffn(h, ffn_w_gate[layer], ffn_w_up[layer], ffn_w_down[layer])
        x = x + gate * rms_norm(y, norm_post[layer, 1])
    return x
```

```cpp
#include <hip/hip_runtime.h>
#include <cstdio>
#include <cstdint>

#ifndef MK_N_LAUNCHES
#define MK_N_LAUNCHES 18
#endif

namespace pg8 {
#define PG8_LAS __attribute__((address_space(3)))
typedef unsigned short bf16_t;
typedef short bf16x8 __attribute__((ext_vector_type(8)));
typedef float f32x4 __attribute__((ext_vector_type(4)));
typedef unsigned u32x4 __attribute__((ext_vector_type(4)));
typedef unsigned u32x2 __attribute__((ext_vector_type(2)));
constexpr int BM = 256, BK = 64, HALF = 128, HTB = HALF * BK * 2, STAGE_BYTES = 8 * HTB, NXCD = 8, WGM = 8;

__host__ __device__ __forceinline__ int lds_byte(int r, int c) { const int st = (r >> 4) * 2 + (c >> 5), rr = r & 15, cc = c & 31, ob = rr * 64 + cc * 2; return st * 1024 + (ob ^ (((ob >> 9) & 1) << 5)); }
__host__ __device__ __forceinline__ void stage_rc(int b, int& R, int& C) { const int st = b / 1024, sb = b % 1024, swz = sb ^ (((sb >> 9) & 1) << 5); R = (st >> 1) * 16 + swz / 64; C = (st & 1) * 32 + (swz % 64) / 2; }
__host__ __device__ __forceinline__ int perm32(int rho) { const int n = rho >> 4, i = rho & 15; return 8 * (i >> 2) + 4 * n + (i & 3); }

struct Unit { int pm, pn; };
struct Gemm { const bf16_t* A; const bf16_t* Bt; int lda, ldb, K, acol_mul; };

struct StaticOrder {
    int nM, nN, nwg, G, c;
    __host__ __device__ void init(int M, int N, int G_, int c_) { nM = M / BM; nN = N / BM; nwg = nM * nN; G = G_; c = c_; }
    __host__ __device__ bool next(int i, Unit& u) const {
        const long L = (long)i * G + c; if (L >= nwg) return false;
        int wgid = (int)L; { const int q = nwg / NXCD, r = nwg % NXCD, xcd = wgid % NXCD, off = wgid / NXCD; wgid = (xcd < r ? xcd * (q + 1) : r * (q + 1) + (xcd - r) * q) + off; }
        const int nig = WGM * nN, gid = wgid / nig, fm = gid * WGM, gsz = (nM - fm) < WGM ? (nM - fm) : WGM;
        u.pm = fm + ((wgid % nig) % gsz); u.pn = (wgid % nig) / gsz; return true;
    }
};

__device__ __forceinline__ unsigned cvt_pk_bf16(float lo, float hi) { unsigned r; asm volatile("v_cvt_pk_bf16_f32 %0, %1, %2" : "=v"(r) : "v"(lo), "v"(hi)); return r; }
__device__ __forceinline__ float bf_lo(unsigned w) { return __uint_as_float(w << 16); }
__device__ __forceinline__ float bf_hi(unsigned w) { return __uint_as_float(w & 0xffff0000u); }
__device__ __forceinline__ float sigmoidf_(float x) { return __builtin_amdgcn_rcpf(1.0f + __expf(-x)); }
__device__ __forceinline__ float siluf_(float x) { return x / (1.0f + __expf(-x)); }
__device__ __forceinline__ float softplusf_(float x) { return fmaxf(x, 0.f) + log1pf(__expf(-fabsf(x))); }

struct EpiF32 {
    static constexpr bool PERM = false;
    float* C; int ldc;
    __device__ __forceinline__ void operator()(const f32x4 (&acc)[2][2][4][2], const Unit& u, int wr, int wc, int fr, int fq) const {
        const int row0 = u.pm * BM + wr * 64 + fr, col0 = u.pn * BM + wc * 32 + 4 * fq;
#pragma unroll
        for (int ai = 0; ai < 2; ++ai)
#pragma unroll
            for (int m = 0; m < 4; ++m) { float* rowp = C + (size_t)(row0 + ai * HALF + m * 16) * ldc + col0;
#pragma unroll
                for (int bj = 0; bj < 2; ++bj)
#pragma unroll
                    for (int n = 0; n < 2; ++n) *(f32x4*)(rowp + bj * HALF + n * 16) = acc[ai][bj][m][n]; }
    }
};
struct EpiBf16 {
    static constexpr bool PERM = true;
    bf16_t* O; int ldc;
    __device__ __forceinline__ void operator()(const f32x4 (&acc)[2][2][4][2], const Unit& u, int wr, int wc, int fr, int fq) const {
        const int row0 = u.pm * BM + wr * 64 + fr, col0 = u.pn * BM + wc * 32 + 8 * fq;
#pragma unroll
        for (int ai = 0; ai < 2; ++ai)
#pragma unroll
            for (int m = 0; m < 4; ++m) { bf16_t* rowp = O + (size_t)(row0 + ai * HALF + m * 16) * ldc + col0;
#pragma unroll
                for (int bj = 0; bj < 2; ++bj) { const f32x4 v0 = acc[ai][bj][m][0], v1 = acc[ai][bj][m][1];
                    u32x4 w; w.x = cvt_pk_bf16(v0[0], v0[1]); w.y = cvt_pk_bf16(v0[2], v0[3]); w.z = cvt_pk_bf16(v1[0], v1[1]); w.w = cvt_pk_bf16(v1[2], v1[3]);
                    *(u32x4*)(rowp + bj * HALF) = w; } }
    }
};
struct EpiSwiGLU {
    static constexpr bool PERM = true;
    bf16_t* O; int ldc;
    __device__ __forceinline__ void operator()(const f32x4 (&acc)[2][2][4][2], const Unit& u, int wr, int wc, int fr, int fq) const {
        const int row0 = u.pm * BM + wr * 64 + fr, col0 = u.pn * HALF + wc * 32 + 8 * fq;
#pragma unroll
        for (int ai = 0; ai < 2; ++ai)
#pragma unroll
            for (int m = 0; m < 4; ++m) { bf16_t* rowp = O + (size_t)(row0 + ai * HALF + m * 16) * ldc + col0;
                float o[8];
#pragma unroll
                for (int n = 0; n < 2; ++n)
#pragma unroll
                    for (int j = 0; j < 4; ++j) { const float g = acc[ai][0][m][n][j], up = acc[ai][1][m][n][j]; o[n * 4 + j] = siluf_(g) * up; }
                u32x4 w; w.x = cvt_pk_bf16(o[0], o[1]); w.y = cvt_pk_bf16(o[2], o[3]); w.z = cvt_pk_bf16(o[4], o[5]); w.w = cvt_pk_bf16(o[6], o[7]);
                *(u32x4*)rowp = w; }
    }
};
struct EpiGates {
    static constexpr bool PERM = true;
    float* Aout; bf16_t* Uout; const bf16_t* XC; const float* ba; const float* bx; const float* lam;
    __device__ __forceinline__ void operator()(const f32x4 (&acc)[2][2][4][2], const Unit& u, int wr, int wc, int fr, int fq) const {
        const int ch0 = u.pn * HALF + wc * 32 + 8 * fq;
        const unsigned eo0 = (unsigned)(u.pm * BM + wr * 64 + fr) * 1024u + (unsigned)ch0;
        f32x4 bav[2], bxv[2], spl[2];
#pragma unroll
        for (int n = 0; n < 2; ++n) { bav[n] = *(const f32x4*)(ba + ch0 + 4 * n); bxv[n] = *(const f32x4*)(bx + ch0 + 4 * n); spl[n] = *(const f32x4*)(lam + ch0 + 4 * n); }
#pragma unroll
        for (int ai = 0; ai < 2; ++ai)
#pragma unroll
            for (int m = 0; m < 4; ++m) { const unsigned eo = eo0 + (unsigned)((ai * HALF + m * 16) * 1024);
                const u32x4 xw = *(const u32x4*)((const char*)XC + (size_t)(eo * 2u));
                const float xv[8] = {bf_lo(xw.x), bf_hi(xw.x), bf_lo(xw.y), bf_hi(xw.y), bf_lo(xw.z), bf_hi(xw.z), bf_lo(xw.w), bf_hi(xw.w)};
                float uv[8];
#pragma unroll
                for (int n = 0; n < 2; ++n) { f32x4 av;
#pragma unroll
                    for (int j = 0; j < 4; ++j) { const float r = sigmoidf_(acc[ai][0][m][n][j] + bav[n][j]), ig = sigmoidf_(acc[ai][1][m][n][j] + bxv[n][j]);
                        const float la = spl[n][j] * r, t = 2.0f * la; av[j] = __expf(la);
                        const float om = (t > -0.3f) ? -t * (1.0f + t * (0.5f + t * (0.16666667f + t * (0.041666668f + t * (0.0083333333f + t * 0.0013888889f))))) : 1.0f - __expf(t);
                        uv[n * 4 + j] = xv[n * 4 + j] * ig * sqrtf(fmaxf(om, 0.f)); }
                    *(f32x4*)((char*)Aout + (size_t)(eo * 4u) + 16 * n) = av; }
                u32x4 w; w.x = cvt_pk_bf16(uv[0], uv[1]); w.y = cvt_pk_bf16(uv[2], uv[3]); w.z = cvt_pk_bf16(uv[4], uv[5]); w.w = cvt_pk_bf16(uv[6], uv[7]);
                *(u32x4*)((char*)Uout + (size_t)(eo * 2u)) = w; asm volatile("" ::: "memory"); }
    }
};

template <class Epi, bool ALIGN_EPI = true>
__device__ __forceinline__ void gemm_phase(PG8_LAS unsigned char* lds, const Gemm g, const StaticOrder& S, const Epi& E) {
    const int tid = threadIdx.x, wid = __builtin_amdgcn_readfirstlane(tid >> 6), lane = tid & 63, wr = wid >> 2, wc = wid & 3, fr = lane & 15, fq = lane >> 4;
    const int K = g.K, nt = K / BK;
    unsigned voffA[2], voffB[2];
#pragma unroll
    for (int i = 0; i < 2; ++i) { int R, C; stage_rc(tid * 16 + i * 8192, R, C); const int Rb = Epi::PERM ? ((R & ~31) + perm32(R & 31)) : R;
        voffA[i] = (unsigned)(R * g.lda + C) * 2u; voffB[i] = (unsigned)(Rb * g.ldb + C) * 2u; }
    const size_t kstep = (size_t)(BK * 2);
    const size_t hstepA = (size_t)HALF * g.lda * 2, hstepB = (size_t)HALF * g.ldb * 2;
    const size_t tstepA = 2 * hstepA, tstepB = 2 * hstepB;
    const unsigned ldsw = (unsigned)wid * 1024u;
    const int aoff = lds_byte(wr * 64 + fr, fq * 8), boff = lds_byte(wc * 32 + fr, fq * 8);
#define PG8_SA(b, h) (((b) * 2 + (h)) * HTB)
#define PG8_SB(b, h) ((4 + (b) * 2 + (h)) * HTB)
#define PG8_STAGE(bufoff, gbase, voff) do { _Pragma("unroll") for (int _i = 0; _i < 2; ++_i) \
        __builtin_amdgcn_global_load_lds((const unsigned*)((const char*)(gbase) + (voff)[_i]), (PG8_LAS unsigned*)(lds + (bufoff) + ldsw + _i * 8192), 16, 0, 0); } while (0)
#define PG8_LDA(dst, b, h) do { _Pragma("unroll") for (int m = 0; m < 4; ++m) _Pragma("unroll") for (int k = 0; k < 2; ++k) dst[m][k] = *(const PG8_LAS bf16x8*)(lds + PG8_SA(b, h) + aoff + m * 2048 + k * 1024); } while (0)
#define PG8_LDB(dst, b, h) do { _Pragma("unroll") for (int n = 0; n < 2; ++n) _Pragma("unroll") for (int k = 0; k < 2; ++k) dst[n][k] = *(const PG8_LAS bf16x8*)(lds + PG8_SB(b, h) + boff + n * 2048 + k * 1024); } while (0)
#define PG8_MMA(ai, bj, At, Bt) do { __builtin_amdgcn_s_setprio(1); _Pragma("unroll") for (int m = 0; m < 4; ++m) _Pragma("unroll") for (int n = 0; n < 2; ++n) _Pragma("unroll") for (int k = 0; k < 2; ++k) \
        acc[ai][bj][m][n] = __builtin_amdgcn_mfma_f32_16x16x32_bf16(Bt[n][k], At[m][k], acc[ai][bj][m][n], 0, 0, 0); __builtin_amdgcn_s_setprio(0); } while (0)
#define PG8_WAIT_V(n) asm volatile("s_waitcnt vmcnt(" #n ")" ::: "memory")
#define PG8_WAIT_L(n) asm volatile("s_waitcnt lgkmcnt(" #n ")" ::: "memory")
#define PG8_BAR __builtin_amdgcn_s_barrier()
#define PG8_SCHED __builtin_amdgcn_sched_barrier(0)
    Unit cur, nxt; int ui = 0;
    if (!S.next(0, cur)) return;
    f32x4 acc[2][2][4][2];
#pragma unroll
    for (int a = 0; a < 2; ++a)
#pragma unroll
        for (int b = 0; b < 2; ++b)
#pragma unroll
            for (int m = 0; m < 4; ++m)
#pragma unroll
                for (int n = 0; n < 2; ++n) acc[a][b][m][n] = (f32x4){0.f, 0.f, 0.f, 0.f};
    bf16x8 At[4][2], B0[2][2], B1[2][2];
    const char* cA = (const char*)g.A + (size_t)cur.pm * tstepA + (size_t)((cur.pn >> 1) * g.acol_mul) * 2; const char* cB = (const char*)g.Bt + (size_t)cur.pn * tstepB;
    PG8_STAGE(PG8_SB(0, 0), cB, voffB); PG8_STAGE(PG8_SB(0, 1), cB + hstepB, voffB); PG8_STAGE(PG8_SA(0, 0), cA, voffA); PG8_STAGE(PG8_SA(0, 1), cA + hstepA, voffA);
    if (wr == 1) PG8_BAR;
    PG8_WAIT_V(2); PG8_BAR;
    PG8_STAGE(PG8_SB(1, 0), cB + kstep, voffB); PG8_STAGE(PG8_SA(1, 0), cA + kstep, voffA); PG8_STAGE(PG8_SB(1, 1), cB + hstepB + kstep, voffB);
    PG8_WAIT_V(6); PG8_BAR;
    for (;;) {
        const bool has_next = S.next(ui + 1, nxt);
        const char* nA = has_next ? (const char*)g.A + (size_t)nxt.pm * tstepA + (size_t)((nxt.pn >> 1) * g.acol_mul) * 2 : cA; const char* nB = has_next ? (const char*)g.Bt + (size_t)nxt.pn * tstepB : cB;
#pragma nounroll
        for (int t = 0; t < nt; t += 2) {
            const bool last = (t == nt - 2);
            const char* a1 = cA + (size_t)(t + 1) * kstep;
            const char* a2 = last ? nA : cA + (size_t)(t + 2) * kstep; const char* b2 = last ? nB : cB + (size_t)(t + 2) * kstep;
            const char* a3 = a2 + kstep; const char* b3 = b2 + kstep;
            PG8_LDB(B0, 0, 0); PG8_LDB(B1, 0, 1); PG8_SCHED; PG8_LDA(At, 0, 0); PG8_STAGE(PG8_SA(1, 1), a1 + hstepA, voffA);
            PG8_WAIT_V(8); PG8_WAIT_L(0); PG8_BAR; PG8_MMA(0, 0, At, B0); PG8_MMA(0, 1, At, B1); PG8_BAR; PG8_SCHED;
            PG8_LDA(At, 0, 1); PG8_STAGE(PG8_SB(0, 0), b2, voffB); PG8_STAGE(PG8_SB(0, 1), b2 + hstepB, voffB); PG8_STAGE(PG8_SA(0, 0), a2, voffA);
            PG8_WAIT_V(8); PG8_WAIT_L(0); PG8_BAR; PG8_MMA(1, 0, At, B0); PG8_MMA(1, 1, At, B1); PG8_BAR; PG8_SCHED;
            PG8_LDB(B0, 1, 0); PG8_LDB(B1, 1, 1); PG8_SCHED; PG8_LDA(At, 1, 0); PG8_STAGE(PG8_SA(0, 1), a2 + hstepA, voffA);
            PG8_WAIT_V(8); PG8_WAIT_L(0); PG8_BAR; PG8_MMA(0, 0, At, B0); PG8_MMA(0, 1, At, B1); PG8_BAR; PG8_SCHED;
            PG8_LDA(At, 1, 1); PG8_STAGE(PG8_SB(1, 0), b3, voffB); PG8_STAGE(PG8_SB(1, 1), b3 + hstepB, voffB); PG8_STAGE(PG8_SA(1, 0), a3, voffA);
            PG8_WAIT_V(8); PG8_WAIT_L(0); PG8_BAR; PG8_MMA(1, 0, At, B0); PG8_MMA(1, 1, At, B1); PG8_BAR; PG8_SCHED;
        }
        if constexpr (ALIGN_EPI) { if (wr == 0) PG8_BAR; }
        E(acc, cur, wr, wc, fr, fq);
        if (!has_next) break;
#pragma unroll
        for (int a = 0; a < 2; ++a)
#pragma unroll
            for (int b = 0; b < 2; ++b)
#pragma unroll
                for (int m = 0; m < 4; ++m)
#pragma unroll
                    for (int n = 0; n < 2; ++n) acc[a][b][m][n] = (f32x4){0.f, 0.f, 0.f, 0.f};
        cur = nxt; cA = nA; cB = nB; ++ui;
        if constexpr (ALIGN_EPI) { if (wr == 1) PG8_BAR; }
    }
    PG8_WAIT_V(0);
    if constexpr (!ALIGN_EPI) { if (wr == 0) PG8_BAR; }
    PG8_BAR;
#undef PG8_SA
#undef PG8_SB
#undef PG8_STAGE
#undef PG8_LDA
#undef PG8_LDB
#undef PG8_MMA
#undef PG8_WAIT_V
#undef PG8_WAIT_L
#undef PG8_BAR
#undef PG8_SCHED
}
}

using pg8::bf_lo; using pg8::bf_hi; using pg8::cvt_pk_bf16; using pg8::sigmoidf_; using pg8::siluf_; using pg8::softplusf_;

constexpr int NWAVES = 8;
constexpr int N_LAUNCHES = MK_N_LAUNCHES;
constexpr int PER_PHASE = 18;
constexpr int NB = 4, T = 4096, D = 1024, M = NB * T, FF = 2816;
constexpr int NCOLS = 3840;
constexpr int WIN_LD = 3848;
constexpr float EPS = 1e-6f;

constexpr size_t MiB = 1u << 20;
constexpr size_t WS_CTL = 0, CTL_ZERO_BYTES = 64 * 1024;
constexpr size_t WS_MODS = 256 * 1024;
constexpr size_t WS_WSPEC = 512 * 1024;
constexpr size_t WS_SPL = 576 * 1024;
constexpr size_t WS_CARRY = 1 * MiB;
constexpr size_t WS_MODP = 4 * MiB;
constexpr size_t WS_GB = 6 * MiB;
constexpr size_t WS_W = 8 * MiB;
constexpr size_t WB_IN = WS_W;
constexpr size_t WB_OUT = WB_IN + (size_t)NCOLS * D * 2;
constexpr size_t WB_GU0 = WB_OUT + (size_t)D * D * 2;
constexpr size_t WB_DN0 = WB_GU0 + (size_t)2 * FF * D * 2;
constexpr size_t WB_GU1 = WB_DN0 + (size_t)D * FF * 2;
constexpr size_t WB_DN1 = WB_GU1 + (size_t)2 * FF * D * 2;
constexpr size_t WB_LIN = WB_DN1 + (size_t)D * FF * 2;
constexpr size_t WB_LG = WB_LIN + (size_t)2048 * D * 2;
constexpr size_t WB_LOUT = WB_LG + (size_t)2048 * 256 * 2;
constexpr size_t WB_END = WB_LOUT + (size_t)D * D * 2;
constexpr size_t WS_H = 58 * MiB;
constexpr size_t WS_BIG = 90 * MiB;
constexpr size_t WS_END = 256 * MiB;
static_assert(WB_END <= WS_H, "weights fit");
static_assert(WS_BIG + (size_t)M * NCOLS * 2 <= WS_END, "cols fit");
constexpr size_t BIG_COLS = WS_BIG;
constexpr size_t BIG_Y0 = WS_BIG;
constexpr size_t BIG_ACT = WS_BIG;
constexpr size_t BIG_Y1 = WS_BIG + 88 * MiB;
constexpr size_t BIG_GX = WS_BIG;
constexpr size_t BIG_XC = WS_BIG + 64 * MiB;
constexpr size_t BIG_A = WS_BIG + 96 * MiB;
static_assert(BIG_A + (size_t)M * D * 4 <= WS_END, "lru buffers fit");

constexpr int CW_TMO = 0;
constexpr int CW_BAR = 1024;
constexpr int RING_OFF = 0, RING_BYTES = 131072;
constexpr int LDSCTL_OFF = RING_BYTES, MISC_OFF = LDSCTL_OFF + 320;
constexpr int LDS_BYTES = 147456;

#define GAS __attribute__((address_space(1)))
#define LAS __attribute__((address_space(3)))
typedef unsigned short bf16;
typedef unsigned v4u __attribute__((ext_vector_type(4)));
typedef unsigned v2u __attribute__((ext_vector_type(2)));
typedef float f32x4 __attribute__((ext_vector_type(4)));
typedef GAS unsigned gu32;
#define RLX_AGENT __ATOMIC_RELAXED, __HIP_MEMORY_SCOPE_AGENT
#define LDS_WAIT() asm volatile("s_waitcnt lgkmcnt(0)" ::: "memory")
#define VM_WAIT() asm volatile("s_waitcnt vmcnt(0)" ::: "memory")
__device__ __forceinline__ unsigned f2bf(float f) { unsigned u = __builtin_bit_cast(unsigned, f); return (u + 0x7fffu + ((u >> 16) & 1u)) >> 16; }
__device__ __forceinline__ unsigned pk2(float lo, float hi) { return f2bf(lo) | (f2bf(hi) << 16); }
__device__ __forceinline__ float bf2f(bf16 v) { return __uint_as_float(((unsigned)v) << 16); }

#define XB_TMO      128
#define XB_XCNT(j)  (256  + 64 * (j))
#define XB_XSUB(j)  (1280 + 64 * (j))
#define XB_XGEN(j)  (2304 + 64 * (j))
#define XB_TOP      3328
#define XB_TOPGEN   3392
#define XCD_BAR_WORDS 3456
#define XB_SPIN_CAP (1u << 22)
__device__ __forceinline__ unsigned xb_ld(unsigned* p)              { return __hip_atomic_load(p, __ATOMIC_RELAXED, __HIP_MEMORY_SCOPE_AGENT); }
__device__ __forceinline__ unsigned xb_add(unsigned* p, unsigned v) { return __hip_atomic_fetch_add(p, v, __ATOMIC_RELAXED, __HIP_MEMORY_SCOPE_AGENT); }
__device__ __forceinline__ unsigned xb_xcc_id() { return (unsigned)__builtin_amdgcn_s_getreg((3 << 11) | 20) & 0xFu; }
#define XB_SPIN(cond, bar) do { unsigned _sp = 0; while (cond) { __builtin_amdgcn_s_sleep(1); \
    if ((++_sp & 255u) == 0u) { if (xb_ld(&(bar)[XB_TMO])) break; if (_sp > XB_SPIN_CAP) { atomicAdd(&(bar)[XB_TMO], 1u); break; } } } } while (0)
struct XcdBarrier { unsigned* bar; unsigned x; volatile LAS unsigned* st; };
__device__ __forceinline__ XcdBarrier xcd_barrier_post(unsigned* bar, volatile LAS unsigned* st) {
    XcdBarrier b; b.bar = bar; b.x = xb_xcc_id(); b.st = st;
    if (threadIdx.x == 0) (void)xb_add(&bar[XB_XCNT(b.x)], 1u);
    return b;
}
__device__ __forceinline__ void xcd_barrier_complete(unsigned* bar, unsigned x, unsigned& nloc, unsigned& nx) {
    const unsigned G = gridDim.x * gridDim.y * gridDim.z;
    unsigned sum, cnt, mine, sp = 0u;
    for (;;) {
        sum = 0u; cnt = 0u; mine = 0u;
#pragma unroll
        for (unsigned j = 0; j < 16; ++j) { const unsigned c = xb_ld(&bar[XB_XCNT(j)]); sum += c; cnt += (c > 0u) ? 1u : 0u; mine = (j == x) ? c : mine; }
        if (sum == G) break;
        __builtin_amdgcn_s_sleep(1);
        if ((++sp & 255u) == 0u) { if (xb_ld(&bar[XB_TMO])) break; if (sp > XB_SPIN_CAP) { atomicAdd(&bar[XB_TMO], 1u); break; } }
    }
    nloc = mine > 0u ? mine : 1u; nx = cnt > 0u ? cnt : 1u;
}
__device__ __forceinline__ void xcd_barrier(const XcdBarrier& b) {
    asm volatile("s_waitcnt vmcnt(0)" ::: "memory");
    __syncthreads();
    if (threadIdx.x == 0) {
        unsigned* bar = b.bar;
        __builtin_amdgcn_s_waitcnt(0);
        unsigned nloc = b.st[0], nx = b.st[1];
        if (nloc == 0u) { xcd_barrier_complete(bar, b.x, nloc, nx); b.st[0] = nloc; b.st[1] = nx; }
        const unsigned old = xb_add(&bar[XB_XSUB(b.x)], 1u);
        const unsigned gen = old / nloc;
        if (old + 1u == (gen + 1u) * nloc) {
            __builtin_amdgcn_fence(__ATOMIC_RELEASE, "agent");
            asm volatile("s_waitcnt vmcnt(0)" ::: "memory");
            const unsigned og = xb_add(&bar[XB_TOP], 1u);
            const unsigned tg = og / nx;
            if (og + 1u == (tg + 1u) * nx) xb_add(&bar[XB_TOPGEN], 1u);
            else XB_SPIN(xb_ld(&bar[XB_TOPGEN]) == tg, bar);
            __builtin_amdgcn_fence(__ATOMIC_ACQUIRE, "agent");
            xb_add(&bar[XB_XGEN(b.x)], 1u);
            asm volatile("s_waitcnt vmcnt(0)" ::: "memory");
        } else {
            XB_SPIN(xb_ld(&bar[XB_XGEN(b.x)]) == gen, bar);
            __builtin_amdgcn_fence(__ATOMIC_ACQUIRE, "agent");
            asm volatile("s_waitcnt vmcnt(0)" ::: "memory");
        }
    }
    __syncthreads();
}

struct Frame {
    LAS unsigned char* lds;
    float* ldsf;
    volatile LAS unsigned* MISC;
    gu32* ctl;
    int tid, lane, wave;
    int vcu, G;
    const float* const* in;
    unsigned char* ws;
    float* out;
};
struct Args { const float* in[35]; float* out; unsigned char* ws; int ph_lo, ph_hi, li, pad; };

__device__ __forceinline__ float wave_sum(float v) {
#pragma unroll
    for (int o = 1; o < 64; o <<= 1) v += __shfl_xor(v, o);
    return v;
}

__device__ __forceinline__ void transpose_tile(const float* W, int ld, bf16* WT, int Kdst, float* scr, int lane) {
#pragma unroll 8
    for (int i = 0; i < 32; ++i) { const int kk = 2 * i + (lane >> 5); scr[kk * 33 + (lane & 31)] = W[(size_t)kk * ld + (lane & 31)]; }
    LDS_WAIT(); asm volatile("" ::: "memory");
    const int c = lane & 7;
#pragma unroll
    for (int j = 0; j < 4; ++j) { const int n = (lane >> 3) + 8 * j; const float* s = scr + (8 * c) * 33 + n;
        v4u o; o.x = pk2(s[0 * 33], s[1 * 33]); o.y = pk2(s[2 * 33], s[3 * 33]); o.z = pk2(s[4 * 33], s[5 * 33]); o.w = pk2(s[6 * 33], s[7 * 33]);
        *(v4u*)(WT + (size_t)n * Kdst + 8 * c) = o; }
    LDS_WAIT(); asm volatile("" ::: "memory");
}

__device__ __forceinline__ void convert_item(const Args& a, int it, float* scr, int lane) {
    unsigned char* ws = a.ws;
    if (it < 1024) { const int kb = it / 64, nb = it % 64; transpose_tile(a.in[9] + (size_t)(64 * kb) * WIN_LD + 32 * nb, WIN_LD, (bf16*)(ws + WB_IN) + (size_t)(32 * nb) * D + 64 * kb, D, scr, lane); return; } it -= 1024;
    if (it < 896) { const int kb = it / 56, nb = it % 56; transpose_tile(a.in[9] + (size_t)(64 * kb) * WIN_LD + 2056 + 32 * nb, WIN_LD, (bf16*)(ws + WB_IN) + (size_t)(2048 + 32 * nb) * D + 64 * kb, D, scr, lane); return; } it -= 896;
    if (it < 512) { const int kb = it / 32, nb = it % 32; transpose_tile(a.in[10] + (size_t)(64 * kb) * D + 32 * nb, D, (bf16*)(ws + WB_OUT) + (size_t)(32 * nb) * D + 64 * kb, D, scr, lane); return; } it -= 512;
    if (it < 4 * 1408) { const int which = it / 1408, r = it % 1408, l = which >> 1, gu = which & 1, kb = r / 88, nb = r % 88, n0 = 32 * nb;
        const float* W = a.in[gu ? 7 : 6] + (size_t)l * D * FF; bf16* dst = (bf16*)(ws + (l ? WB_GU1 : WB_GU0));
        const int drow = (n0 / 128) * 256 + gu * 128 + (n0 % 128);
        transpose_tile(W + (size_t)(64 * kb) * FF + n0, FF, dst + (size_t)drow * D + 64 * kb, D, scr, lane); return; } it -= 4 * 1408;
    if (it < 2 * 1408) { const int l = it / 1408, r = it % 1408, kb = r / 32, nb = r % 32;
        transpose_tile(a.in[8] + (size_t)l * FF * D + (size_t)(64 * kb) * D + 32 * nb, D, (bf16*)(ws + (l ? WB_DN1 : WB_DN0)) + (size_t)(32 * nb) * FF + 64 * kb, FF, scr, lane); return; } it -= 2 * 1408;
    if (it < 1024) { const int kb = it / 64, nb = it % 64; transpose_tile(a.in[26] + (size_t)(64 * kb) * 2048 + 32 * nb, 2048, (bf16*)(ws + WB_LIN) + (size_t)(32 * nb) * D + 64 * kb, D, scr, lane); return; } it -= 1024;
    if (it < 256) { const int mt = it / 32, r = it % 32, ax = mt & 1, n = mt >> 1, kb = r / 8, nb = r % 8, e0 = 32 * nb;
        const float* W = a.in[ax ? 31 : 29] + (size_t)n * 256 * 256;
        const int drow = (2 * n + e0 / 128) * 256 + ax * 128 + (e0 % 128);
        transpose_tile(W + (size_t)(64 * kb) * 256 + e0, 256, (bf16*)(ws + WB_LG) + (size_t)drow * 256 + 64 * kb, 256, scr, lane); return; } it -= 256;
    { const int kb = it / 32, nb = it % 32; transpose_tile(a.in[34] + (size_t)(64 * kb) * D + 32 * nb, D, (bf16*)(ws + WB_LOUT) + (size_t)(32 * nb) * D + 64 * kb, D, scr, lane); }
}
constexpr int N_CONV_ITEMS = 1024 + 896 + 512 + 4 * 1408 + 2 * 1408 + 1024 + 256 + 512;

__device__ __forceinline__ void adaln_item(const Args& a, int it, float* scr, int lane) {
    const int kc = it & 7, cg = (it >> 3) % 12, combo = it / 96;
    const float* cin = a.in[1];
#pragma unroll
    for (int i = 0; i < 8; ++i) { const int idx = lane + 64 * i, b = idx >> 7, kk = idx & 127; const float c = cin[b * D + kc * 128 + kk]; scr[idx] = siluf_(c); }
    LDS_WAIT(); asm volatile("" ::: "memory");
    const float* W = a.in[4] + ((size_t)combo * D + kc * 128) * 3072 + cg * 256 + lane * 4;
    f32x4 acc[4] = {{0.f, 0.f, 0.f, 0.f}, {0.f, 0.f, 0.f, 0.f}, {0.f, 0.f, 0.f, 0.f}, {0.f, 0.f, 0.f, 0.f}};
#pragma unroll 4
    for (int kk = 0; kk < 128; ++kk) { const f32x4 w = *(const f32x4*)(W + (size_t)kk * 3072);
#pragma unroll
        for (int b = 0; b < 4; ++b) acc[b] += w * scr[b * 128 + kk]; }
    float* P = (float*)(a.ws + WS_MODP);
#pragma unroll
    for (int b = 0; b < 4; ++b) *(f32x4*)(P + ((size_t)((kc * 4 + combo) * 4 + b)) * 3072 + cg * 256 + lane * 4) = acc[b];
    LDS_WAIT(); asm volatile("" ::: "memory");
}

__device__ __forceinline__ float mod_from_partials(const Args& a, int combo, int b, int n) {
    const float* P = (const float*)(a.ws + WS_MODP);
    float s = a.in[5][combo * 3072 + n];
#pragma unroll
    for (int kc = 0; kc < 8; ++kc) s += P[((size_t)((kc * 4 + combo) * 4 + b)) * 3072 + n];
    return s;
}

template <int MODE>
__device__ __forceinline__ void row_pass(const Args& a, Frame& F, const float* xres, const float* y, int combo_res, const float* npost, int combo_h, const float* npre) {
    float* tab = F.ldsf;
    const bool from_partials = (MODE == 0);
    const float* MODS = (const float*)(a.ws + WS_MODS);
    for (int rb = F.vcu; rb < M / 64; rb += F.G) {
        const int b = rb / (T / 64);
        __syncthreads();
        for (int k = F.tid; k < D; k += NWAVES * 64) {
            if (MODE != 2) {
                float sh, sc;
                if (from_partials) { sh = mod_from_partials(a, combo_h, b, k); sc = mod_from_partials(a, combo_h, b, D + k); }
                else { sh = MODS[(combo_h * 4 + b) * 3072 + k]; sc = MODS[(combo_h * 4 + b) * 3072 + D + k]; }
                tab[k] = npre[k] * (1.0f + sc); tab[D + k] = sh;
            }
            if (MODE != 0) tab[2 * D + k] = MODS[(combo_res * 4 + b) * 3072 + 2 * D + k] * npost[k];
        }
        __syncthreads();
        for (int rr = F.wave; rr < 64; rr += NWAVES) {
            const int row = rb * 64 + rr;
            f32x4 v[4];
            if (MODE == 0) {
#pragma unroll
                for (int j = 0; j < 4; ++j) v[j] = *(const f32x4*)(xres + (size_t)row * D + 256 * j + 4 * F.lane);
            } else {
                f32x4 yv[4]; float ss = 0.f;
#pragma unroll
                for (int j = 0; j < 4; ++j) { yv[j] = *(const f32x4*)(y + (size_t)row * D + 256 * j + 4 * F.lane); ss += (yv[j].x * yv[j].x + yv[j].y * yv[j].y) + (yv[j].z * yv[j].z + yv[j].w * yv[j].w); }
                const float rstd = 1.0f / sqrtf(wave_sum(ss) * (1.0f / D) + EPS);
#pragma unroll
                for (int j = 0; j < 4; ++j) { const f32x4 xr = *(const f32x4*)(xres + (size_t)row * D + 256 * j + 4 * F.lane); const f32x4 gp = *(const f32x4*)(tab + 2 * D + 256 * j + 4 * F.lane);
                    v[j] = xr + gp * (yv[j] * rstd); *(f32x4*)(a.out + (size_t)row * D + 256 * j + 4 * F.lane) = v[j]; }
            }
            if (MODE != 2) {
                float ss = 0.f;
#pragma unroll
                for (int j = 0; j < 4; ++j) ss += (v[j].x * v[j].x + v[j].y * v[j].y) + (v[j].z * v[j].z + v[j].w * v[j].w);
                const float rstd = 1.0f / sqrtf(wave_sum(ss) * (1.0f / D) + EPS);
                bf16* H = (bf16*)(a.ws + WS_H);
#pragma unroll
                for (int j = 0; j < 4; ++j) { const f32x4 g = *(const f32x4*)(tab + 256 * j + 4 * F.lane), s = *(const f32x4*)(tab + D + 256 * j + 4 * F.lane);
                    v[j] = v[j] * rstd * g + s;
                    v2u o; o.x = pk2(v[j].x, v[j].y); o.y = pk2(v[j].z, v[j].w); *(v2u*)(H + (size_t)row * D + 256 * j + 4 * F.lane) = o; }
                if (MODE == 0) {
                    const float* WSP = (const float*)(a.ws + WS_WSPEC);
                    float dots[8];
#pragma unroll
                    for (int c = 0; c < 8; ++c) { float s = 0.f;
#pragma unroll
                        for (int j = 0; j < 4; ++j) { const f32x4 w = *(const f32x4*)(WSP + c * D + 256 * j + 4 * F.lane); s += (v[j].x * w.x + v[j].y * w.y) + (v[j].z * w.z + v[j].w * w.w); }
                        dots[c] = wave_sum(s); }
                    if (F.lane < 4) { const int hh = F.lane; float al = dots[0], bb = dots[4];
                        al = hh == 1 ? dots[1] : al; al = hh == 2 ? dots[2] : al; al = hh == 3 ? dots[3] : al;
                        bb = hh == 1 ? dots[5] : bb; bb = hh == 2 ? dots[6] : bb; bb = hh == 3 ? dots[7] : bb;
                        float* GB = (float*)(a.ws + WS_GB);
                        GB[(size_t)row * 8 + hh] = -__expf(a.in[12][hh]) * softplusf_(al + a.in[13][hh]);
                        GB[(size_t)row * 8 + 4 + hh] = sigmoidf_(bb); }
                }
            }
        }
    }
}

__device__ __forceinline__ void gdn_seq(const Args& a, Frame& F, int b, int h) {
    float* qs = F.ldsf; float* ks = qs + 64 * 128; float* vs = ks + 64 * 128; float* gbs = vs + 64 * 128;
    const bf16* COLS = (const bf16*)(a.ws + BIG_COLS);
    const float* cw = a.in[11]; const float* GB = (const float*)(a.ws + WS_GB); const float* nw = a.in[14];
    bf16* A2 = (bf16*)(a.ws + WS_H);
    float s[64];
#pragma unroll
    for (int k = 0; k < 64; ++k) s[k] = 0.f;
    const int vcol = (F.wave & 3) * 32 + (F.lane & 31), khalf = (F.lane >> 5) * 64;
    for (int n = 0; n < T / 64; ++n) {
        const int t0 = n * 64;
        for (int it = F.tid; it < 64 * 48; it += NWAVES * 64) {
            const int tok = it / 48, cg = it % 48, part = cg >> 4, c8 = (cg & 15) * 8, wcol = part * 512 + h * 128 + c8;
            float acc[8];
#pragma unroll
            for (int e = 0; e < 8; ++e) acc[e] = 0.f;
#pragma unroll
            for (int j = 0; j < 4; ++j) { const int tt = t0 + tok - 3 + j;
                if (tt >= 0) { const v4u xw = *(const v4u*)(COLS + (size_t)(b * T + tt) * NCOLS + wcol); const float* w = cw + j * 1536 + wcol;
                    acc[0] += w[0] * bf_lo(xw.x); acc[1] += w[1] * bf_hi(xw.x); acc[2] += w[2] * bf_lo(xw.y); acc[3] += w[3] * bf_hi(xw.y);
                    acc[4] += w[4] * bf_lo(xw.z); acc[5] += w[5] * bf_hi(xw.z); acc[6] += w[6] * bf_lo(xw.w); acc[7] += w[7] * bf_hi(xw.w); } }
            float* dst = (part == 0 ? qs : (part == 1 ? ks : vs)) + tok * 128 + c8;
#pragma unroll
            for (int e = 0; e < 8; ++e) dst[e] = siluf_(acc[e]);
        }
        if (F.tid < 64) { gbs[F.tid * 2] = GB[(size_t)(b * T + t0 + F.tid) * 8 + h]; gbs[F.tid * 2 + 1] = GB[(size_t)(b * T + t0 + F.tid) * 8 + 4 + h]; }
        __syncthreads();
        for (int p = F.wave * 16; p < F.wave * 16 + 16; ++p) { const int tok = p >> 1, isk = p & 1; float* base = (isk ? ks : qs) + tok * 128;
            const float x0 = base[F.lane], x1 = base[F.lane + 64]; const float ss = wave_sum(x0 * x0 + x1 * x1);
            const float sc = (1.0f / sqrtf(ss + EPS)) * (isk ? 1.0f : 0.08838834764831845f);
            base[F.lane] = x0 * sc; base[F.lane + 64] = x1 * sc; }
        __syncthreads();
        if (F.wave < 4) {
            for (int tok = 0; tok < 64; ++tok) {
                const float al = __expf(gbs[tok * 2]), be = gbs[tok * 2 + 1];
                const float* kr = ks + tok * 128 + khalf; const float* qr = qs + tok * 128 + khalf;
                float kS = 0.f;
#pragma unroll
                for (int k = 0; k < 64; k += 4) { const f32x4 kv = *(const f32x4*)(kr + k); kS += kv.x * s[k] + kv.y * s[k + 1] + kv.z * s[k + 2] + kv.w * s[k + 3]; if ((k & 12) == 12) asm volatile("" ::: "memory"); }
                kS += __shfl_xor(kS, 32);
                const float vv = vs[tok * 128 + vcol];
                const float dlt = be * (vv - al * kS);
                float o = 0.f;
#pragma unroll
                for (int k = 0; k < 64; k += 4) { const f32x4 kv = *(const f32x4*)(kr + k); const f32x4 qv = *(const f32x4*)(qr + k);
                    s[k] = al * s[k] + kv.x * dlt; s[k + 1] = al * s[k + 1] + kv.y * dlt; s[k + 2] = al * s[k + 2] + kv.z * dlt; s[k + 3] = al * s[k + 3] + kv.w * dlt;
                    o += qv.x * s[k] + qv.y * s[k + 1] + qv.z * s[k + 2] + qv.w * s[k + 3]; if ((k & 4) == 4) asm volatile("" ::: "memory"); }
                o += __shfl_xor(o, 32);
                if (F.lane < 32) vs[tok * 128 + vcol] = o;
            }
        }
        __syncthreads();
        for (int tok = F.wave * 8; tok < F.wave * 8 + 8; ++tok) {
            const float o0 = vs[tok * 128 + F.lane], o1 = vs[tok * 128 + 64 + F.lane];
            const float rstd = 1.0f / sqrtf(wave_sum(o0 * o0 + o1 * o1) * (1.0f / 128.0f) + EPS);
            const size_t row = (size_t)(b * T + t0 + tok);
            const float z0 = bf2f(COLS[row * NCOLS + 1536 + h * 128 + F.lane]), z1 = bf2f(COLS[row * NCOLS + 1536 + h * 128 + 64 + F.lane]);
            A2[row * D + h * 128 + F.lane] = (bf16)f2bf(o0 * rstd * nw[F.lane] * siluf_(z0));
            A2[row * D + h * 128 + 64 + F.lane] = (bf16)f2bf(o1 * rstd * nw[64 + F.lane] * siluf_(z1));
        }
        __syncthreads();
    }
}

__device__ __forceinline__ void rwkv_seq(const Args& a, Frame& F, int b, int h) {
    float* cf = F.ldsf;
    float* wv = cf + 32 * 448;
    float* av = wv + 32 * 64;
    float* kkv = av + 32 * 64;
    float* kav = kkv + 32 * 64;
    float* kmv = kav + 32 * 64;
    float* gv = kmv + 32 * 64;
    float* ys = gv + 32 * 64;
    float* bon = ys + 32 * 64;
    const bf16* COLS = (const bf16*)(a.ws + BIG_COLS);
    const float* mu = a.in[15]; const float* w0 = a.in[16]; const float* w2 = a.in[17]; const float* a0 = a.in[18]; const float* a2 = a.in[19]; const float* g2 = a.in[20];
    const float* k_k = a.in[21]; const float* k_a = a.in[22]; const float* r_k = a.in[23]; const float* ln_w = a.in[24]; const float* ln_b = a.in[25];
    bf16* A2 = (bf16*)(a.ws + WS_H);
    float S[64];
#pragma unroll
    for (int k = 0; k < 64; ++k) S[k] = 0.f;
    for (int sc = 0; sc < T / 32; ++sc) {
        const int t0 = sc * 32;
        for (int it = F.tid; it < 32 * 56; it += NWAVES * 64) {
            const int tok = it / 56, g8 = it % 56, lc = g8 * 8;
            int rc;
            if (lc < 64) rc = h * 64 + lc; else if (lc < 128) rc = 512 + h * 64 + (lc - 64); else if (lc < 192) rc = 1024 + h * 64 + (lc - 128); else rc = 1536 + (lc - 192);
            const int tt = t0 + tok; const size_t row = (size_t)(b * T + tt);
            const v4u cw = *(const v4u*)(COLS + row * NCOLS + 2048 + rc);
            v4u pw = {0u, 0u, 0u, 0u}; if (tt > 0) pw = *(const v4u*)(COLS + (row - 1) * NCOLS + 2048 + rc);
            float cur[8] = {bf_lo(cw.x), bf_hi(cw.x), bf_lo(cw.y), bf_hi(cw.y), bf_lo(cw.z), bf_hi(cw.z), bf_lo(cw.w), bf_hi(cw.w)};
            float prv[8] = {bf_lo(pw.x), bf_hi(pw.x), bf_lo(pw.y), bf_hi(pw.y), bf_lo(pw.z), bf_hi(pw.z), bf_lo(pw.w), bf_hi(pw.w)};
#pragma unroll
            for (int e = 0; e < 8; ++e) { float v = cur[e] + mu[rc + e] * (prv[e] - cur[e]);
                if (lc >= 192 && lc < 256) v = tanhf(v); else if (lc >= 320) v = sigmoidf_(v);
                cf[tok * 448 + lc + e] = v; }
        }
        __syncthreads();
        { const int j = F.tid & 63, hc = h * 64 + j;
#pragma unroll
          for (int i4 = 0; i4 < 4; ++i4) { const int tok = (F.tid >> 6) + 8 * i4; const float* c = cf + tok * 448;
            float wl = w0[hc], al = a0[hc], gl = 0.f;
#pragma unroll 4
            for (int i = 0; i < 64; ++i) { wl += c[192 + i] * w2[i * 512 + hc]; al += c[256 + i] * a2[i * 512 + hc]; }
#pragma unroll 4
            for (int i = 0; i < 128; ++i) gl += c[320 + i] * g2[i * 512 + hc];
            const float dec = __expf(-__expf(-softplusf_(-wl) - 0.5f)); const float aa = sigmoidf_(al);
            const float k0 = c[64 + j];
            wv[tok * 64 + j] = dec; av[tok * 64 + j] = aa; kkv[tok * 64 + j] = k0 * k_k[hc]; kmv[tok * 64 + j] = k0 * (1.0f + (aa - 1.0f) * k_a[hc]); gv[tok * 64 + j] = gl; } }
        __syncthreads();
        for (int tok = F.wave * 4; tok < F.wave * 4 + 4; ++tok) { const int j = F.lane;
            const float kr = kkv[tok * 64 + j]; const float ss = wave_sum(kr * kr); const float kk = kr * (1.0f / sqrtf(ss + EPS));
            kkv[tok * 64 + j] = kk; kav[tok * 64 + j] = kk * av[tok * 64 + j];
            const float bs = wave_sum(cf[tok * 448 + j] * kmv[tok * 64 + j] * r_k[h * 64 + j]);
            if (j == 0) bon[tok] = bs; }
        __syncthreads();
        if (F.wave == 0) {
            for (int tok = 0; tok < 32; ++tok) {
                const float* kkr = kkv + tok * 64; const float* war = wv + tok * 64; const float* kar = kav + tok * 64; const float* kmr = kmv + tok * 64; const float* rr = cf + tok * 448;
                float sa = 0.f;
#pragma unroll
                for (int k = 0; k < 64; k += 4) { const f32x4 q = *(const f32x4*)(kkr + k); sa += q.x * S[k] + q.y * S[k + 1] + q.z * S[k + 2] + q.w * S[k + 3]; if ((k & 12) == 12) asm volatile("" ::: "memory"); }
                sa = -sa;
                const float vv = cf[tok * 448 + 128 + F.lane];
                float y = 0.f;
#pragma unroll
                for (int k = 0; k < 64; k += 4) { const f32x4 w4 = *(const f32x4*)(war + k), b4 = *(const f32x4*)(kar + k), k4 = *(const f32x4*)(kmr + k), r4 = *(const f32x4*)(rr + k);
                    S[k] = S[k] * w4.x + sa * b4.x + vv * k4.x; S[k + 1] = S[k + 1] * w4.y + sa * b4.y + vv * k4.y; S[k + 2] = S[k + 2] * w4.z + sa * b4.z + vv * k4.z; S[k + 3] = S[k + 3] * w4.w + sa * b4.w + vv * k4.w;
                    y += S[k] * r4.x + S[k + 1] * r4.y + S[k + 2] * r4.z + S[k + 3] * r4.w; if ((k & 4) == 4) asm volatile("" ::: "memory"); }
                ys[tok * 64 + F.lane] = y;
            }
        }
        __syncthreads();
        for (int tok = F.wave * 4; tok < F.wave * 4 + 4; ++tok) { const int j = F.lane, hc = h * 64 + j;
            const float y = ys[tok * 64 + j]; const float mean = wave_sum(y) * (1.0f / 64.0f); const float d = y - mean; const float var = wave_sum(d * d) * (1.0f / 64.0f);
            const float yn = d * (1.0f / sqrtf(var + 64e-5f)) * ln_w[hc] + ln_b[hc];
            const float o = (yn + bon[tok] * cf[tok * 448 + 128 + j]) * gv[tok * 64 + j];
            A2[(size_t)(b * T + t0 + tok) * D + 512 + hc] = (bf16)f2bf(o); }
        __syncthreads();
    }
}

__device__ __forceinline__ float gelu_tanh(float x) { const float u = 0.7978845608028654f * (x + 0.044715f * x * x * x); return 0.5f * x * (1.0f + tanhf(u)); }

__global__ void __launch_bounds__(NWAVES * 64, 2) fwd(Args args) {
    extern __shared__ __attribute__((aligned(16))) unsigned char lds[];
    Frame F;
    F.lds = (LAS unsigned char*)lds; F.ldsf = (float*)lds;
    F.MISC = (volatile LAS unsigned*)(F.lds + MISC_OFF);
    F.tid = threadIdx.x; F.lane = F.tid & 63; F.wave = __builtin_amdgcn_readfirstlane(F.tid >> 6);
    F.G = gridDim.x; { const int bx = blockIdx.x; F.vcu = (F.G % 8 == 0) ? (bx % 8) * (F.G / 8) + bx / 8 : bx; }
    F.ws = args.ws; F.out = args.out;
    F.ctl = (gu32*)(args.ws + WS_CTL);
    for (int u = F.tid; u < (LDS_BYTES - LDSCTL_OFF) / 4; u += NWAVES * 64) ((LAS unsigned*)(F.lds + LDSCTL_OFF))[u] = 0u;
    __syncthreads();
    XcdBarrier bar; bar.bar = (unsigned*)(F.ctl + CW_BAR); bar.x = 0; bar.st = nullptr;
    if (N_LAUNCHES != PER_PHASE) bar = xcd_barrier_post((unsigned*)(F.ctl + CW_BAR), F.MISC + 8);
#define GRID_BAR() do { if (N_LAUNCHES != PER_PHASE) xcd_barrier(bar); } while (0)
    const int lo = args.ph_lo, hi = args.ph_hi;
#ifndef PHMASK
#define PHMASK 0xFFFFFFFFu
#endif
#define IN(k) (((PHMASK >> (k)) & 1u) && lo <= (k) && (k) < hi)
#define BOTH(k) (IN(k) && IN((k) + 1))
    const int gw = F.vcu * NWAVES + F.wave, NGW = F.G * NWAVES;
    unsigned char* ws = args.ws;

    if (IN(0)) {
        float* scr = F.ldsf + F.wave * 4096;
        for (int it = gw; it < N_CONV_ITEMS + 384; it += NGW) { if (it < 384) adaln_item(args, it, scr, F.lane); else convert_item(args, it - 384, scr, F.lane); }
        { float* WSP = (float*)(ws + WS_WSPEC); for (int i = gw * 64 + F.lane; i < 8 * D; i += NGW * 64) { const int c = i / D, k = i % D; WSP[i] = args.in[9][(size_t)k * WIN_LD + 2048 + c]; } }
        { float* SPL = (float*)(ws + WS_SPL); for (int i = gw * 64 + F.lane; i < D; i += NGW * 64) SPL[i] = -8.0f * softplusf_(-args.in[33][i]); }
        if (BOTH(0)) GRID_BAR();
    }
    if (IN(1)) {
        { float* MODS = (float*)(ws + WS_MODS); for (int i = gw * 64 + F.lane; i < 16 * 3072; i += NGW * 64) { const int n = i % 3072, cb = i / 3072; MODS[i] = mod_from_partials(args, cb >> 2, cb & 3, n); } }
        row_pass<0>(args, F, args.in[0], nullptr, 0, nullptr, 0, args.in[2]);
        if (BOTH(1)) GRID_BAR();
    }
    if (IN(2)) {
        pg8::Gemm g{(const bf16*)(ws + WS_H), (const bf16*)(ws + WB_IN), D, D, D, 0}; pg8::StaticOrder S; S.init(M, NCOLS, F.G, (int)blockIdx.x);
        pg8::EpiBf16 E{(bf16*)(ws + BIG_COLS), NCOLS};
        pg8::gemm_phase<pg8::EpiBf16>(F.lds + RING_OFF, g, S, E);
        if (BOTH(2)) GRID_BAR();
    }
    if (IN(3)) {
        for (int u = F.vcu; u < 48; u += F.G) { if (u < 16) gdn_seq(args, F, u >> 2, u & 3); else rwkv_seq(args, F, (u - 16) >> 3, (u - 16) & 7); }
        if (BOTH(3)) GRID_BAR();
    }
    if (IN(4)) {
        pg8::Gemm g{(const bf16*)(ws + WS_H), (const bf16*)(ws + WB_OUT), D, D, D, 0}; pg8::StaticOrder S; S.init(M, D, F.G, (int)blockIdx.x);
        pg8::EpiF32 E{(float*)(ws + BIG_Y0), D};
        pg8::gemm_phase<pg8::EpiF32>(F.lds + RING_OFF, g, S, E);
        if (BOTH(4)) GRID_BAR();
    }
    if (IN(5)) { row_pass<1>(args, F, args.in[0], (const float*)(ws + BIG_Y0), 0, args.in[3] + 0 * D, 1, args.in[2] + 1 * D); if (BOTH(5)) GRID_BAR(); }
    if (IN(6)) {
        pg8::Gemm g{(const bf16*)(ws + WS_H), (const bf16*)(ws + WB_GU0), D, D, D, 0}; pg8::StaticOrder S; S.init(M, 2 * FF, F.G, (int)blockIdx.x);
        pg8::EpiSwiGLU E{(bf16*)(ws + BIG_ACT), FF};
        pg8::gemm_phase<pg8::EpiSwiGLU>(F.lds + RING_OFF, g, S, E);
        if (BOTH(6)) GRID_BAR();
    }
    if (IN(7)) {
        pg8::Gemm g{(const bf16*)(ws + BIG_ACT), (const bf16*)(ws + WB_DN0), FF, FF, FF, 0}; pg8::StaticOrder S; S.init(M, D, F.G, (int)blockIdx.x);
        pg8::EpiF32 E{(float*)(ws + BIG_Y1), D};
        pg8::gemm_phase<pg8::EpiF32>(F.lds + RING_OFF, g, S, E);
        if (BOTH(7)) GRID_BAR();
    }
    if (IN(8)) { row_pass<1>(args, F, args.out, (const float*)(ws + BIG_Y1), 1, args.in[3] + 1 * D, 2, args.in[2] + 2 * D); if (BOTH(8)) GRID_BAR(); }
    if (IN(9)) {
        pg8::Gemm g{(const bf16*)(ws + WS_H), (const bf16*)(ws + WB_LIN), D, D, D, 0}; pg8::StaticOrder S; S.init(M, 2048, F.G, (int)blockIdx.x);
        pg8::EpiBf16 E{(bf16*)(ws + BIG_GX), 2048};
        pg8::gemm_phase<pg8::EpiBf16>(F.lds + RING_OFF, g, S, E);
        if (BOTH(9)) GRID_BAR();
    }
    if (IN(10)) {
        const bf16* GX = (const bf16*)(ws + BIG_GX); bf16* XC = (bf16*)(ws + BIG_XC); const float* cw = args.in[27]; const float* cb = args.in[28];
        for (int it = gw * 64 + F.lane; it < M * 128; it += NGW * 64) {
            const int row = it >> 7, c8 = (it & 127) * 8, t = row % T;
            float acc[8];
#pragma unroll
            for (int e = 0; e < 8; ++e) acc[e] = cb[c8 + e];
#pragma unroll
            for (int j = 0; j < 4; ++j) { if (t - 3 + j >= 0) { const v4u xw = *(const v4u*)(GX + (size_t)(row - 3 + j) * 2048 + 1024 + c8); const float* w = cw + j * 1024 + c8;
                acc[0] += w[0] * bf_lo(xw.x); acc[1] += w[1] * bf_hi(xw.x); acc[2] += w[2] * bf_lo(xw.y); acc[3] += w[3] * bf_hi(xw.y);
                acc[4] += w[4] * bf_lo(xw.z); acc[5] += w[5] * bf_hi(xw.z); acc[6] += w[6] * bf_lo(xw.w); acc[7] += w[7] * bf_hi(xw.w); } }
            v4u o; o.x = pk2(acc[0], acc[1]); o.y = pk2(acc[2], acc[3]); o.z = pk2(acc[4], acc[5]); o.w = pk2(acc[6], acc[7]);
            *(v4u*)(XC + (size_t)row * D + c8) = o;
        }
        if (BOTH(10)) GRID_BAR();
    }
    if (IN(11)) {
        pg8::Gemm g{(const bf16*)(ws + BIG_XC), (const bf16*)(ws + WB_LG), D, 256, 256, 256}; pg8::StaticOrder S; S.init(M, 2048, F.G, (int)blockIdx.x);
        pg8::EpiGates E{(float*)(ws + BIG_A), (bf16*)(ws + WS_H), (const bf16*)(ws + BIG_XC), args.in[30], args.in[32], (const float*)(ws + WS_SPL)};
        pg8::gemm_phase<pg8::EpiGates>(F.lds + RING_OFF, g, S, E);
        if (BOTH(11)) GRID_BAR();
    }
    if (IN(12)) {
        const float* Aa = (const float*)(ws + BIG_A); const bf16* U = (const bf16*)(ws + WS_H); float* CA = (float*)(ws + WS_CARRY); float* CH = CA + NB * 64 * D;
        for (int it = gw; it < NB * 64 * 16; it += NGW) { const int cg = it & 15, seg = (it >> 4) & 63, b = it >> 10, ch = cg * 64 + F.lane;
            float hh = 0.f, P = 1.f; const size_t base = (size_t)(b * T + seg * 64) * D + ch;
#pragma unroll 8
            for (int t = 0; t < 64; ++t) { const float av = Aa[base + (size_t)t * D], uv = bf2f(U[base + (size_t)t * D]); hh = av * hh + uv; P *= av; }
            CA[(b * 64 + seg) * D + ch] = P; CH[(b * 64 + seg) * D + ch] = hh; }
        if (BOTH(12)) GRID_BAR();
    }
    if (IN(13)) {
        const float* Aa = (const float*)(ws + BIG_A); const bf16* U = (const bf16*)(ws + WS_H); const float* CA = (const float*)(ws + WS_CARRY); const float* CH = CA + NB * 64 * D;
        const bf16* GX = (const bf16*)(ws + BIG_GX); bf16* Y2 = (bf16*)(ws + BIG_XC);
        for (int it = gw; it < NB * 64 * 16; it += NGW) { const int cg = it & 15, seg = (it >> 4) & 63, b = it >> 10, ch = cg * 64 + F.lane;
            float hh = 0.f;
            for (int s2 = 0; s2 < seg; ++s2) hh = CA[(b * 64 + s2) * D + ch] * hh + CH[(b * 64 + s2) * D + ch];
            const size_t base = (size_t)(b * T + seg * 64) * D + ch; const size_t gbase = (size_t)(b * T + seg * 64) * 2048 + ch;
#pragma unroll 8
            for (int t = 0; t < 64; ++t) { const float av = Aa[base + (size_t)t * D], uv = bf2f(U[base + (size_t)t * D]); hh = av * hh + uv;
                const float gt = bf2f(GX[gbase + (size_t)t * 2048]); Y2[base + (size_t)t * D] = (bf16)f2bf(hh * gelu_tanh(gt)); } }
        if (BOTH(13)) GRID_BAR();
    }
    if (IN(14)) {
        pg8::Gemm g{(const bf16*)(ws + BIG_XC), (const bf16*)(ws + WB_LOUT), D, D, D, 0}; pg8::StaticOrder S; S.init(M, D, F.G, (int)blockIdx.x);
        pg8::EpiF32 E{(float*)(ws + BIG_A), D};
        pg8::gemm_phase<pg8::EpiF32>(F.lds + RING_OFF, g, S, E);
        if (BOTH(14)) GRID_BAR();
    }
    if (IN(15)) { row_pass<1>(args, F, args.out, (const float*)(ws + BIG_A), 2, args.in[3] + 2 * D, 3, args.in[2] + 3 * D); if (BOTH(15)) GRID_BAR(); }
    if (IN(16)) {
        pg8::Gemm g{(const bf16*)(ws + WS_H), (const bf16*)(ws + WB_GU1), D, D, D, 0}; pg8::StaticOrder S; S.init(M, 2 * FF, F.G, (int)blockIdx.x);
        pg8::EpiSwiGLU E{(bf16*)(ws + BIG_ACT), FF};
        pg8::gemm_phase<pg8::EpiSwiGLU>(F.lds + RING_OFF, g, S, E);
        if (BOTH(16)) GRID_BAR();
    }
    if (IN(17)) {
        pg8::Gemm g{(const bf16*)(ws + BIG_ACT), (const bf16*)(ws + WB_DN1), FF, FF, FF, 0}; pg8::StaticOrder S; S.init(M, D, F.G, (int)blockIdx.x);
        pg8::EpiF32 E{(float*)(ws + BIG_Y1), D};
        pg8::gemm_phase<pg8::EpiF32>(F.lds + RING_OFF, g, S, E);
        if (BOTH(17)) GRID_BAR();
    }
    if (IN(18)) { row_pass<2>(args, F, args.out, (const float*)(ws + BIG_Y1), 3, args.in[3] + 3 * D, 0, nullptr); }
#undef IN
#undef BOTH
}

extern "C" void kernel_launch(void* const* d_in, const int* in_sizes, int n_in, void* d_out, int out_size, void* d_ws, size_t ws_size, hipStream_t stream) {
    static int grid = 0;
    if (grid == 0) {
        if (n_in != 35 || out_size != M * D || ws_size < WS_END) { fprintf(stderr, "kernel_launch: unexpected shapes n_in %d out %d ws %zu\n", n_in, out_size, ws_size); grid = -1; return; }
        int dev = 0, cus = 0;
        if (hipGetDevice(&dev) != hipSuccess || hipDeviceGetAttribute(&cus, hipDeviceAttributeMultiprocessorCount, dev) != hipSuccess) { grid = -1; return; }
        if (hipFuncSetAttribute((const void*)fwd, hipFuncAttributeMaxDynamicSharedMemorySize, LDS_BYTES) != hipSuccess) { grid = -1; return; }
        grid = cus;
    }
    if (grid < 0) return;
    (void)hipMemsetAsync((char*)d_ws + WS_CTL, 0, CTL_ZERO_BYTES, stream);
    Args a{};
    for (int i = 0; i < 35; ++i) a.in[i] = (const float*)d_in[i];
    a.out = (float*)d_out; a.ws = (unsigned char*)d_ws;
    constexpr int NPH = 19;
    if (N_LAUNCHES == PER_PHASE) {
        for (int p = 0; p < NPH; ++p) { a.ph_lo = p; a.ph_hi = p + 1; a.li = p; hipLaunchKernelGGL(fwd, dim3(grid), dim3(NWAVES * 64), LDS_BYTES, stream, a); }
    } else {
        a.ph_lo = 0; a.ph_hi = NPH; a.li = 0; hipLaunchKernelGGL(fwd, dim3(grid), dim3(NWAVES * 64), LDS_BYTES, stream, a);
    }
}
```

```cpp
#include <hip/hip_runtime.h>
#include <cstdio>
#include <cstdint>

#ifndef MK_N_LAUNCHES
#define MK_N_LAUNCHES 1
#endif

namespace pg8 {
#define PG8_LAS __attribute__((address_space(3)))
typedef unsigned short bf16_t;
typedef short bf16x8 __attribute__((ext_vector_type(8)));
typedef float f32x4 __attribute__((ext_vector_type(4)));
typedef unsigned u32x4 __attribute__((ext_vector_type(4)));
typedef unsigned u32x2 __attribute__((ext_vector_type(2)));
constexpr int BM = 256, BK = 64, HALF = 128, HTB = HALF * BK * 2, STAGE_BYTES = 8 * HTB, NXCD = 8, WGM = 8;

__host__ __device__ __forceinline__ int lds_byte(int r, int c) { const int st = (r >> 4) * 2 + (c >> 5), rr = r & 15, cc = c & 31, ob = rr * 64 + cc * 2; return st * 1024 + (ob ^ (((ob >> 9) & 1) << 5)); }
__host__ __device__ __forceinline__ void stage_rc(int b, int& R, int& C) { const int st = b / 1024, sb = b % 1024, swz = sb ^ (((sb >> 9) & 1) << 5); R = (st >> 1) * 16 + swz / 64; C = (st & 1) * 32 + (swz % 64) / 2; }
__host__ __device__ __forceinline__ int perm32(int rho) { const int n = rho >> 4, i = rho & 15; return 8 * (i >> 2) + 4 * n + (i & 3); }

struct Unit { int pm, pn; };
struct Gemm { const bf16_t* A; const bf16_t* Bt; int lda, ldb, K, acol_mul; };

struct StaticOrder {
    int nM, nN, nwg, G, c;
    __host__ __device__ void init(int M, int N, int G_, int c_) { nM = M / BM; nN = N / BM; nwg = nM * nN; G = G_; c = c_; }
    __host__ __device__ bool next(int i, Unit& u) const {
        const long L = (long)i * G + c; if (L >= nwg) return false;
        int wgid = (int)L; { const int q = nwg / NXCD, r = nwg % NXCD, xcd = wgid % NXCD, off = wgid / NXCD; wgid = (xcd < r ? xcd * (q + 1) : r * (q + 1) + (xcd - r) * q) + off; }
        const int nig = WGM * nN, gid = wgid / nig, fm = gid * WGM, gsz = (nM - fm) < WGM ? (nM - fm) : WGM;
        u.pm = fm + ((wgid % nig) % gsz); u.pn = (wgid % nig) / gsz; return true;
    }
};

__device__ __forceinline__ unsigned cvt_pk_bf16(float lo, float hi) { unsigned r; asm volatile("v_cvt_pk_bf16_f32 %0, %1, %2" : "=v"(r) : "v"(lo), "v"(hi)); return r; }
__device__ __forceinline__ float bf_lo(unsigned w) { return __uint_as_float(w << 16); }
__device__ __forceinline__ float bf_hi(unsigned w) { return __uint_as_float(w & 0xffff0000u); }
__device__ __forceinline__ float sigmoidf_(float x) { return __builtin_amdgcn_rcpf(1.0f + __expf(-x)); }
__device__ __forceinline__ float siluf_(float x) { return x / (1.0f + __expf(-x)); }
__device__ __forceinline__ float softplusf_(float x) { return fmaxf(x, 0.f) + log1pf(__expf(-fabsf(x))); }

struct EpiF32 {
    static constexpr bool PERM = false;
    float* C; int ldc;
    __device__ __forceinline__ void operator()(const f32x4 (&acc)[2][2][4][2], const Unit& u, int wr, int wc, int fr, int fq) const {
        const int row0 = u.pm * BM + wr * 64 + fr, col0 = u.pn * BM + wc * 32 + 4 * fq;
#pragma unroll
        for (int ai = 0; ai < 2; ++ai)
#pragma unroll
            for (int m = 0; m < 4; ++m) { float* rowp = C + (size_t)(row0 + ai * HALF + m * 16) * ldc + col0;
#pragma unroll
                for (int bj = 0; bj < 2; ++bj)
#pragma unroll
                    for (int n = 0; n < 2; ++n) *(f32x4*)(rowp + bj * HALF + n * 16) = acc[ai][bj][m][n]; }
    }
};
struct EpiBf16 {
    static constexpr bool PERM = true;
    bf16_t* O; int ldc;
    __device__ __forceinline__ void operator()(const f32x4 (&acc)[2][2][4][2], const Unit& u, int wr, int wc, int fr, int fq) const {
        const int row0 = u.pm * BM + wr * 64 + fr, col0 = u.pn * BM + wc * 32 + 8 * fq;
#pragma unroll
        for (int ai = 0; ai < 2; ++ai)
#pragma unroll
            for (int m = 0; m < 4; ++m) { bf16_t* rowp = O + (size_t)(row0 + ai * HALF + m * 16) * ldc + col0;
#pragma unroll
                for (int bj = 0; bj < 2; ++bj) { const f32x4 v0 = acc[ai][bj][m][0], v1 = acc[ai][bj][m][1];
                    u32x4 w; w.x = cvt_pk_bf16(v0[0], v0[1]); w.y = cvt_pk_bf16(v0[2], v0[3]); w.z = cvt_pk_bf16(v1[0], v1[1]); w.w = cvt_pk_bf16(v1[2], v1[3]);
                    *(u32x4*)(rowp + bj * HALF) = w; } }
    }
};
struct EpiBf16Halo {
    static constexpr bool PERM = true;
    bf16_t* O; int ldc; bf16_t* Hl;
    __device__ __forceinline__ void operator()(const f32x4 (&acc)[2][2][4][2], const Unit& u, int wr, int wc, int fr, int fq) const {
        const int row0 = u.pm * BM + wr * 64 + fr, col0 = u.pn * BM + wc * 32 + 8 * fq;
#pragma unroll
        for (int ai = 0; ai < 2; ++ai)
#pragma unroll
            for (int m = 0; m < 4; ++m) { const int row = row0 + ai * HALF + m * 16; bf16_t* rowp = O + (size_t)row * ldc + col0;
#pragma unroll
                for (int bj = 0; bj < 2; ++bj) { const f32x4 v0 = acc[ai][bj][m][0], v1 = acc[ai][bj][m][1];
                    u32x4 w; w.x = cvt_pk_bf16(v0[0], v0[1]); w.y = cvt_pk_bf16(v0[2], v0[3]); w.z = cvt_pk_bf16(v1[0], v1[1]); w.w = cvt_pk_bf16(v1[2], v1[3]);
                    *(u32x4*)(rowp + bj * HALF) = w;
                    if (m == 3 && fr >= 13) *(u32x4*)(Hl + ((size_t)(row >> 6) * 3 + (fr - 13)) * ldc + col0 + bj * HALF) = w; } }
    }
};
struct EpiSwiGLU {
    static constexpr bool PERM = true;
    bf16_t* O; int ldc;
    __device__ __forceinline__ void operator()(const f32x4 (&acc)[2][2][4][2], const Unit& u, int wr, int wc, int fr, int fq) const {
        const int row0 = u.pm * BM + wr * 64 + fr, col0 = u.pn * HALF + wc * 32 + 8 * fq;
#pragma unroll
        for (int ai = 0; ai < 2; ++ai)
#pragma unroll
            for (int m = 0; m < 4; ++m) { bf16_t* rowp = O + (size_t)(row0 + ai * HALF + m * 16) * ldc + col0;
                float o[8];
#pragma unroll
                for (int n = 0; n < 2; ++n)
#pragma unroll
                    for (int j = 0; j < 4; ++j) { const float g = acc[ai][0][m][n][j], up = acc[ai][1][m][n][j]; o[n * 4 + j] = siluf_(g) * up; }
                u32x4 w; w.x = cvt_pk_bf16(o[0], o[1]); w.y = cvt_pk_bf16(o[2], o[3]); w.z = cvt_pk_bf16(o[4], o[5]); w.w = cvt_pk_bf16(o[6], o[7]);
                *(u32x4*)rowp = w; }
    }
};
struct EpiGates {
    static constexpr bool PERM = true;
    float* Aout; bf16_t* Uout; const bf16_t* XC; const float* ba; const float* bx; const float* lam;
    __device__ __forceinline__ void operator()(const f32x4 (&acc)[2][2][4][2], const Unit& u, int wr, int wc, int fr, int fq) const {
        const int ch0 = u.pn * HALF + wc * 32 + 8 * fq;
        const unsigned eo0 = (unsigned)(u.pm * BM + wr * 64 + fr) * 1024u + (unsigned)ch0;
        f32x4 bav[2], bxv[2], spl[2];
#pragma unroll
        for (int n = 0; n < 2; ++n) { bav[n] = *(const f32x4*)(ba + ch0 + 4 * n); bxv[n] = *(const f32x4*)(bx + ch0 + 4 * n); spl[n] = *(const f32x4*)(lam + ch0 + 4 * n); }
#pragma unroll
        for (int ai = 0; ai < 2; ++ai)
#pragma unroll
            for (int m = 0; m < 4; ++m) { const unsigned eo = eo0 + (unsigned)((ai * HALF + m * 16) * 1024);
                const u32x4 xw = *(const u32x4*)((const char*)XC + (size_t)(eo * 2u));
                const float xv[8] = {bf_lo(xw.x), bf_hi(xw.x), bf_lo(xw.y), bf_hi(xw.y), bf_lo(xw.z), bf_hi(xw.z), bf_lo(xw.w), bf_hi(xw.w)};
                float uv[8];
#pragma unroll
                for (int n = 0; n < 2; ++n) { f32x4 av;
#pragma unroll
                    for (int j = 0; j < 4; ++j) { const float r = sigmoidf_(acc[ai][0][m][n][j] + bav[n][j]), ig = sigmoidf_(acc[ai][1][m][n][j] + bxv[n][j]);
                        const float la = spl[n][j] * r, t = 2.0f * la; av[j] = __expf(la);
                        const float om = (t > -0.3f) ? -t * (1.0f + t * (0.5f + t * (0.16666667f + t * (0.041666668f + t * (0.0083333333f + t * 0.0013888889f))))) : 1.0f - __expf(t);
                        uv[n * 4 + j] = xv[n * 4 + j] * ig * sqrtf(fmaxf(om, 0.f)); }
                    *(f32x4*)((char*)Aout + (size_t)(eo * 4u) + 16 * n) = av; }
                u32x4 w; w.x = cvt_pk_bf16(uv[0], uv[1]); w.y = cvt_pk_bf16(uv[2], uv[3]); w.z = cvt_pk_bf16(uv[4], uv[5]); w.w = cvt_pk_bf16(uv[6], uv[7]);
                *(u32x4*)((char*)Uout + (size_t)(eo * 2u)) = w; asm volatile("" ::: "memory"); }
    }
};

template <class Epi, bool ALIGN_EPI = true>
__device__ __forceinline__ void gemm_phase(PG8_LAS unsigned char* lds, const Gemm g, const StaticOrder& S, const Epi& E) {
    const int tid = threadIdx.x, wid = __builtin_amdgcn_readfirstlane(tid >> 6), lane = tid & 63, wr = wid >> 2, wc = wid & 3, fr = lane & 15, fq = lane >> 4;
    const int K = g.K, nt = K / BK;
    unsigned voffA[2], voffB[2];
#pragma unroll
    for (int i = 0; i < 2; ++i) { int R, C; stage_rc(tid * 16 + i * 8192, R, C); const int Rb = Epi::PERM ? ((R & ~31) + perm32(R & 31)) : R;
        voffA[i] = (unsigned)(R * g.lda + C) * 2u; voffB[i] = (unsigned)(Rb * g.ldb + C) * 2u; }
    const size_t kstep = (size_t)(BK * 2);
    const size_t hstepA = (size_t)HALF * g.lda * 2, hstepB = (size_t)HALF * g.ldb * 2;
    const size_t tstepA = 2 * hstepA, tstepB = 2 * hstepB;
    const unsigned ldsw = (unsigned)wid * 1024u;
    const int aoff = lds_byte(wr * 64 + fr, fq * 8), boff = lds_byte(wc * 32 + fr, fq * 8);
#define PG8_SA(b, h) (((b) * 2 + (h)) * HTB)
#define PG8_SB(b, h) ((4 + (b) * 2 + (h)) * HTB)
#define PG8_STAGE(bufoff, gbase, voff) do { _Pragma("unroll") for (int _i = 0; _i < 2; ++_i) \
        __builtin_amdgcn_global_load_lds((const unsigned*)((const char*)(gbase) + (voff)[_i]), (PG8_LAS unsigned*)(lds + (bufoff) + ldsw + _i * 8192), 16, 0, 0); } while (0)
#define PG8_LDA(dst, b, h) do { _Pragma("unroll") for (int m = 0; m < 4; ++m) _Pragma("unroll") for (int k = 0; k < 2; ++k) dst[m][k] = *(const PG8_LAS bf16x8*)(lds + PG8_SA(b, h) + aoff + m * 2048 + k * 1024); } while (0)
#define PG8_LDB(dst, b, h) do { _Pragma("unroll") for (int n = 0; n < 2; ++n) _Pragma("unroll") for (int k = 0; k < 2; ++k) dst[n][k] = *(const PG8_LAS bf16x8*)(lds + PG8_SB(b, h) + boff + n * 2048 + k * 1024); } while (0)
#define PG8_MMA(ai, bj, At, Bt) do { __builtin_amdgcn_s_setprio(1); _Pragma("unroll") for (int m = 0; m < 4; ++m) _Pragma("unroll") for (int n = 0; n < 2; ++n) _Pragma("unroll") for (int k = 0; k < 2; ++k) \
        acc[ai][bj][m][n] = __builtin_amdgcn_mfma_f32_16x16x32_bf16(Bt[n][k], At[m][k], acc[ai][bj][m][n], 0, 0, 0); __builtin_amdgcn_s_setprio(0); } while (0)
#define PG8_WAIT_V(n) asm volatile("s_waitcnt vmcnt(" #n ")" ::: "memory")
#define PG8_WAIT_L(n) asm volatile("s_waitcnt lgkmcnt(" #n ")" ::: "memory")
#define PG8_BAR __builtin_amdgcn_s_barrier()
#define PG8_SCHED __builtin_amdgcn_sched_barrier(0)
    Unit cur, nxt; int ui = 0;
    if (!S.next(0, cur)) return;
    f32x4 acc[2][2][4][2];
#pragma unroll
    for (int a = 0; a < 2; ++a)
#pragma unroll
        for (int b = 0; b < 2; ++b)
#pragma unroll
            for (int m = 0; m < 4; ++m)
#pragma unroll
                for (int n = 0; n < 2; ++n) acc[a][b][m][n] = (f32x4){0.f, 0.f, 0.f, 0.f};
    bf16x8 At[4][2], B0[2][2], B1[2][2];
    const char* cA = (const char*)g.A + (size_t)cur.pm * tstepA + (size_t)((cur.pn >> 1) * g.acol_mul) * 2; const char* cB = (const char*)g.Bt + (size_t)cur.pn * tstepB;
    PG8_STAGE(PG8_SB(0, 0), cB, voffB); PG8_STAGE(PG8_SB(0, 1), cB + hstepB, voffB); PG8_STAGE(PG8_SA(0, 0), cA, voffA); PG8_STAGE(PG8_SA(0, 1), cA + hstepA, voffA);
    if (wr == 1) PG8_BAR;
    PG8_WAIT_V(2); PG8_BAR;
    PG8_STAGE(PG8_SB(1, 0), cB + kstep, voffB); PG8_STAGE(PG8_SA(1, 0), cA + kstep, voffA); PG8_STAGE(PG8_SB(1, 1), cB + hstepB + kstep, voffB);
    PG8_WAIT_V(6); PG8_BAR;
    for (;;) {
        const bool has_next = S.next(ui + 1, nxt);
        const char* nA = has_next ? (const char*)g.A + (size_t)nxt.pm * tstepA + (size_t)((nxt.pn >> 1) * g.acol_mul) * 2 : cA; const char* nB = has_next ? (const char*)g.Bt + (size_t)nxt.pn * tstepB : cB;
#pragma nounroll
        for (int t = 0; t < nt; t += 2) {
            const bool last = (t == nt - 2);
            const char* a1 = cA + (size_t)(t + 1) * kstep;
            const char* a2 = last ? nA : cA + (size_t)(t + 2) * kstep; const char* b2 = last ? nB : cB + (size_t)(t + 2) * kstep;
            const char* a3 = a2 + kstep; const char* b3 = b2 + kstep;
            PG8_LDB(B0, 0, 0); PG8_LDB(B1, 0, 1); PG8_SCHED; PG8_LDA(At, 0, 0); PG8_STAGE(PG8_SA(1, 1), a1 + hstepA, voffA);
            PG8_WAIT_V(8); PG8_WAIT_L(0); PG8_BAR; PG8_MMA(0, 0, At, B0); PG8_MMA(0, 1, At, B1); PG8_BAR; PG8_SCHED;
            PG8_LDA(At, 0, 1); PG8_STAGE(PG8_SB(0, 0), b2, voffB); PG8_STAGE(PG8_SB(0, 1), b2 + hstepB, voffB); PG8_STAGE(PG8_SA(0, 0), a2, voffA);
            PG8_WAIT_V(8); PG8_WAIT_L(0); PG8_BAR; PG8_MMA(1, 0, At, B0); PG8_MMA(1, 1, At, B1); PG8_BAR; PG8_SCHED;
            PG8_LDB(B0, 1, 0); PG8_LDB(B1, 1, 1); PG8_SCHED; PG8_LDA(At, 1, 0); PG8_STAGE(PG8_SA(0, 1), a2 + hstepA, voffA);
            PG8_WAIT_V(8); PG8_WAIT_L(0); PG8_BAR; PG8_MMA(0, 0, At, B0); PG8_MMA(0, 1, At, B1); PG8_BAR; PG8_SCHED;
            PG8_LDA(At, 1, 1); PG8_STAGE(PG8_SB(1, 0), b3, voffB); PG8_STAGE(PG8_SB(1, 1), b3 + hstepB, voffB); PG8_STAGE(PG8_SA(1, 0), a3, voffA);
            PG8_WAIT_V(8); PG8_WAIT_L(0); PG8_BAR; PG8_MMA(1, 0, At, B0); PG8_MMA(1, 1, At, B1); PG8_BAR; PG8_SCHED;
        }
        if constexpr (ALIGN_EPI) { if (wr == 0) PG8_BAR; }
        E(acc, cur, wr, wc, fr, fq);
        if (!has_next) break;
#pragma unroll
        for (int a = 0; a < 2; ++a)
#pragma unroll
            for (int b = 0; b < 2; ++b)
#pragma unroll
                for (int m = 0; m < 4; ++m)
#pragma unroll
                    for (int n = 0; n < 2; ++n) acc[a][b][m][n] = (f32x4){0.f, 0.f, 0.f, 0.f};
        cur = nxt; cA = nA; cB = nB; ++ui;
        if constexpr (ALIGN_EPI) { if (wr == 1) PG8_BAR; }
    }
    PG8_WAIT_V(0);
    if constexpr (!ALIGN_EPI) { if (wr == 0) PG8_BAR; }
    PG8_BAR;
#undef PG8_SA
#undef PG8_SB
#undef PG8_STAGE
#undef PG8_LDA
#undef PG8_LDB
#undef PG8_MMA
#undef PG8_WAIT_V
#undef PG8_WAIT_L
#undef PG8_BAR
#undef PG8_SCHED
}
}

using pg8::bf_lo; using pg8::bf_hi; using pg8::cvt_pk_bf16; using pg8::sigmoidf_; using pg8::siluf_; using pg8::softplusf_;

constexpr int NWAVES = 8;
constexpr int N_LAUNCHES = MK_N_LAUNCHES;
constexpr int PER_PHASE = 18;
constexpr int NB = 4, T = 4096, D = 1024, M = NB * T, FF = 2816;
constexpr int NCOLS = 3840;
constexpr int WIN_LD = 3848;
constexpr float EPS = 1e-6f;

constexpr size_t MiB = 1u << 20;
constexpr size_t WS_CTL = 0, CTL_ZERO_BYTES = 64 * 1024;
constexpr size_t WS_MODS = 256 * 1024;
constexpr size_t WS_WSPEC = 512 * 1024;
constexpr size_t WS_SPL = 576 * 1024;
constexpr size_t WS_CARRY = 1 * MiB;
constexpr size_t WS_MODP = 4 * MiB;
constexpr size_t WS_GB = 6 * MiB;
constexpr size_t WS_W = 8 * MiB;
constexpr size_t WB_IN = WS_W;
constexpr size_t WB_OUT = WB_IN + (size_t)NCOLS * D * 2;
constexpr size_t WB_GU0 = WB_OUT + (size_t)D * D * 2;
constexpr size_t WB_DN0 = WB_GU0 + (size_t)2 * FF * D * 2;
constexpr size_t WB_GU1 = WB_DN0 + (size_t)D * FF * 2;
constexpr size_t WB_DN1 = WB_GU1 + (size_t)2 * FF * D * 2;
constexpr size_t WB_LIN = WB_DN1 + (size_t)D * FF * 2;
constexpr size_t WB_LG = WB_LIN + (size_t)2048 * D * 2;
constexpr size_t WB_LOUT = WB_LG + (size_t)2048 * 256 * 2;
constexpr size_t WB_END = WB_LOUT + (size_t)D * D * 2;
constexpr size_t WS_H = 58 * MiB;
constexpr size_t WS_BIG = 90 * MiB;
constexpr size_t WS_END = 256 * MiB;
static_assert(WB_END <= WS_H, "weights fit");
static_assert(WS_BIG + (size_t)M * NCOLS * 2 <= WS_END, "cols fit");
constexpr size_t BIG_COLS = WS_BIG;
constexpr size_t BIG_Y0 = WS_BIG;
constexpr size_t BIG_ACT = WS_BIG;
constexpr size_t BIG_Y1 = WS_BIG + 88 * MiB;
constexpr size_t BIG_GX = WS_BIG;
constexpr size_t BIG_XC = WS_BIG + 64 * MiB;
constexpr size_t BIG_A = WS_BIG + 96 * MiB;
static_assert(BIG_A + (size_t)M * D * 4 <= WS_END, "lru buffers fit");

constexpr int CW_TMO = 0;
constexpr int CW_BAR = 1024;
constexpr int RING_OFF = 0, RING_BYTES = 131072;
constexpr int LDSCTL_OFF = 147456, MISC_OFF = LDSCTL_OFF + 320;
constexpr int LDS_BYTES = 155648;
constexpr size_t GDN_WP = 34 * MiB;
constexpr size_t WS_HALO = 50 * MiB;
constexpr size_t RW_YL = 210 * MiB;
constexpr size_t GDN_ATT = 226 * MiB;
constexpr size_t RW_DS = 234 * MiB;
constexpr size_t GDN_GL = 250 * MiB;
constexpr size_t RW_WC = 251 * MiB;
constexpr size_t RW_LW = 7 * MiB;
constexpr size_t DO_WM = 0, DO_BT = 16 * MiB, DO_ARB = 32 * MiB, DO_U = 48 * MiB;

#define GAS __attribute__((address_space(1)))
#define LAS __attribute__((address_space(3)))
typedef unsigned short bf16;
typedef unsigned v4u __attribute__((ext_vector_type(4)));
typedef unsigned v2u __attribute__((ext_vector_type(2)));
typedef float f32x4 __attribute__((ext_vector_type(4)));
typedef GAS unsigned gu32;
#define RLX_AGENT __ATOMIC_RELAXED, __HIP_MEMORY_SCOPE_AGENT
#define LDS_WAIT() asm volatile("s_waitcnt lgkmcnt(0)" ::: "memory")
#define VM_WAIT() asm volatile("s_waitcnt vmcnt(0)" ::: "memory")
__device__ __forceinline__ unsigned f2bf(float f) { unsigned u = __builtin_bit_cast(unsigned, f); return (u + 0x7fffu + ((u >> 16) & 1u)) >> 16; }
__device__ __forceinline__ unsigned pk2(float lo, float hi) { return f2bf(lo) | (f2bf(hi) << 16); }
__device__ __forceinline__ float bf2f(bf16 v) { return __uint_as_float(((unsigned)v) << 16); }

#define XB_TMO      128
#define XB_XCNT(j)  (256  + 64 * (j))
#define XB_XSUB(j)  (1280 + 64 * (j))
#define XB_XGEN(j)  (2304 + 64 * (j))
#define XB_TOP      3328
#define XB_TOPGEN   3392
#define XCD_BAR_WORDS 3456
#define XB_SPIN_CAP (1u << 22)
__device__ __forceinline__ unsigned xb_ld(unsigned* p)              { return __hip_atomic_load(p, __ATOMIC_RELAXED, __HIP_MEMORY_SCOPE_AGENT); }
__device__ __forceinline__ unsigned xb_add(unsigned* p, unsigned v) { return __hip_atomic_fetch_add(p, v, __ATOMIC_RELAXED, __HIP_MEMORY_SCOPE_AGENT); }
__device__ __forceinline__ unsigned xb_xcc_id() { return (unsigned)__builtin_amdgcn_s_getreg((3 << 11) | 20) & 0xFu; }
#define XB_SPIN(cond, bar) do { unsigned _sp = 0; while (cond) { __builtin_amdgcn_s_sleep(1); \
    if ((++_sp & 255u) == 0u) { if (xb_ld(&(bar)[XB_TMO])) break; if (_sp > XB_SPIN_CAP) { atomicAdd(&(bar)[XB_TMO], 1u); break; } } } } while (0)
struct XcdBarrier { unsigned* bar; unsigned x; volatile LAS unsigned* st; };
__device__ __forceinline__ XcdBarrier xcd_barrier_post(unsigned* bar, volatile LAS unsigned* st) {
    XcdBarrier b; b.bar = bar; b.x = xb_xcc_id(); b.st = st;
    if (threadIdx.x == 0) (void)xb_add(&bar[XB_XCNT(b.x)], 1u);
    return b;
}
__device__ __forceinline__ void xcd_barrier_complete(unsigned* bar, unsigned x, unsigned& nloc, unsigned& nx) {
    const unsigned G = gridDim.x * gridDim.y * gridDim.z;
    unsigned sum, cnt, mine, sp = 0u;
    for (;;) {
        sum = 0u; cnt = 0u; mine = 0u;
#pragma unroll
        for (unsigned j = 0; j < 16; ++j) { const unsigned c = xb_ld(&bar[XB_XCNT(j)]); sum += c; cnt += (c > 0u) ? 1u : 0u; mine = (j == x) ? c : mine; }
        if (sum == G) break;
        __builtin_amdgcn_s_sleep(1);
        if ((++sp & 255u) == 0u) { if (xb_ld(&bar[XB_TMO])) break; if (sp > XB_SPIN_CAP) { atomicAdd(&bar[XB_TMO], 1u); break; } }
    }
    nloc = mine > 0u ? mine : 1u; nx = cnt > 0u ? cnt : 1u;
}
__device__ __forceinline__ void xcd_barrier(const XcdBarrier& b) {
    asm volatile("s_waitcnt vmcnt(0)" ::: "memory");
    __syncthreads();
    if (threadIdx.x == 0) {
        unsigned* bar = b.bar;
        __builtin_amdgcn_s_waitcnt(0);
        unsigned nloc = b.st[0], nx = b.st[1];
        if (nloc == 0u) { xcd_barrier_complete(bar, b.x, nloc, nx); b.st[0] = nloc; b.st[1] = nx; }
        const unsigned old = xb_add(&bar[XB_XSUB(b.x)], 1u);
        const unsigned gen = old / nloc;
        if (old + 1u == (gen + 1u) * nloc) {
            __builtin_amdgcn_fence(__ATOMIC_RELEASE, "agent");
            asm volatile("s_waitcnt vmcnt(0)" ::: "memory");
            const unsigned og = xb_add(&bar[XB_TOP], 1u);
            const unsigned tg = og / nx;
            if (og + 1u == (tg + 1u) * nx) xb_add(&bar[XB_TOPGEN], 1u);
            else XB_SPIN(xb_ld(&bar[XB_TOPGEN]) == tg, bar);
            __builtin_amdgcn_fence(__ATOMIC_ACQUIRE, "agent");
            xb_add(&bar[XB_XGEN(b.x)], 1u);
            asm volatile("s_waitcnt vmcnt(0)" ::: "memory");
        } else {
            XB_SPIN(xb_ld(&bar[XB_XGEN(b.x)]) == gen, bar);
            __builtin_amdgcn_fence(__ATOMIC_ACQUIRE, "agent");
            asm volatile("s_waitcnt vmcnt(0)" ::: "memory");
        }
    }
    __syncthreads();
}

struct Frame {
    LAS unsigned char* lds;
    float* ldsf;
    volatile LAS unsigned* MISC;
    gu32* ctl;
    int tid, lane, wave;
    int vcu, G;
    const float* const* in;
    unsigned char* ws;
    float* out;
};
struct Args { const float* in[35]; float* out; unsigned char* ws; int ph_lo, ph_hi, li, pad; };

__device__ __forceinline__ float wave_sum(float v) {
#pragma unroll
    for (int o = 1; o < 64; o <<= 1) v += __shfl_xor(v, o);
    return v;
}

__device__ __forceinline__ void transpose_tile(const float* W, int ld, bf16* WT, int Kdst, float* scr, int lane) {
#pragma unroll 8
    for (int i = 0; i < 32; ++i) { const int kk = 2 * i + (lane >> 5); scr[kk * 33 + (lane & 31)] = W[(size_t)kk * ld + (lane & 31)]; }
    LDS_WAIT(); asm volatile("" ::: "memory");
    const int c = lane & 7;
#pragma unroll
    for (int j = 0; j < 4; ++j) { const int n = (lane >> 3) + 8 * j; const float* s = scr + (8 * c) * 33 + n;
        v4u o; o.x = pk2(s[0 * 33], s[1 * 33]); o.y = pk2(s[2 * 33], s[3 * 33]); o.z = pk2(s[4 * 33], s[5 * 33]); o.w = pk2(s[6 * 33], s[7 * 33]);
        *(v4u*)(WT + (size_t)n * Kdst + 8 * c) = o; }
    LDS_WAIT(); asm volatile("" ::: "memory");
}

__device__ __forceinline__ void convert_item0(const Args& a, int it, float* scr, int lane) {
    unsigned char* ws = a.ws;
    if (it < 1024) { const int kb = it / 64, nb = it % 64; transpose_tile(a.in[9] + (size_t)(64 * kb) * WIN_LD + 32 * nb, WIN_LD, (bf16*)(ws + WB_IN) + (size_t)(32 * nb) * D + 64 * kb, D, scr, lane); return; } it -= 1024;
    if (it < 896) { const int kb = it / 56, nb = it % 56; transpose_tile(a.in[9] + (size_t)(64 * kb) * WIN_LD + 2056 + 32 * nb, WIN_LD, (bf16*)(ws + WB_IN) + (size_t)(2048 + 32 * nb) * D + 64 * kb, D, scr, lane); return; } it -= 896;
    if (it < 512) { const int kb = it / 32, nb = it % 32; transpose_tile(a.in[10] + (size_t)(64 * kb) * D + 32 * nb, D, (bf16*)(ws + WB_OUT) + (size_t)(32 * nb) * D + 64 * kb, D, scr, lane); return; } it -= 512;
    if (it < 2 * 1408) { const int gu = it / 1408, r = it % 1408, kb = r / 88, nb = r % 88, n0 = 32 * nb;
        const float* W = a.in[gu ? 7 : 6]; bf16* dst = (bf16*)(ws + WB_GU0);
        const int drow = (n0 / 128) * 256 + gu * 128 + (n0 % 128);
        transpose_tile(W + (size_t)(64 * kb) * FF + n0, FF, dst + (size_t)drow * D + 64 * kb, D, scr, lane); return; } it -= 2 * 1408;
    { const int kb = it / 32, nb = it % 32;
        transpose_tile(a.in[8] + (size_t)(64 * kb) * D + 32 * nb, D, (bf16*)(ws + WB_DN0) + (size_t)(32 * nb) * FF + 64 * kb, FF, scr, lane); }
}
constexpr int N_CONV_ITEMS0 = 1024 + 896 + 512 + 2 * 1408 + 1408;
__device__ __forceinline__ void convert_item1(const Args& a, int it, float* scr, int lane) {
    unsigned char* ws = a.ws;
    if (it < 2 * 1408) { const int gu = it / 1408, r = it % 1408, kb = r / 88, nb = r % 88, n0 = 32 * nb;
        const float* W = a.in[gu ? 7 : 6] + (size_t)D * FF; bf16* dst = (bf16*)(ws + WB_GU1);
        const int drow = (n0 / 128) * 256 + gu * 128 + (n0 % 128);
        transpose_tile(W + (size_t)(64 * kb) * FF + n0, FF, dst + (size_t)drow * D + 64 * kb, D, scr, lane); return; } it -= 2 * 1408;
    if (it < 1408) { const int kb = it / 32, nb = it % 32;
        transpose_tile(a.in[8] + (size_t)FF * D + (size_t)(64 * kb) * D + 32 * nb, D, (bf16*)(ws + WB_DN1) + (size_t)(32 * nb) * FF + 64 * kb, FF, scr, lane); return; } it -= 1408;
    if (it < 1024) { const int kb = it / 64, nb = it % 64; transpose_tile(a.in[26] + (size_t)(64 * kb) * 2048 + 32 * nb, 2048, (bf16*)(ws + WB_LIN) + (size_t)(32 * nb) * D + 64 * kb, D, scr, lane); return; } it -= 1024;
    if (it < 256) { const int mt = it / 32, r = it % 32, ax = mt & 1, n = mt >> 1, kb = r / 8, nb = r % 8, e0 = 32 * nb;
        const float* W = a.in[ax ? 31 : 29] + (size_t)n * 256 * 256;
        const int drow = (2 * n + e0 / 128) * 256 + ax * 128 + (e0 % 128);
        transpose_tile(W + (size_t)(64 * kb) * 256 + e0, 256, (bf16*)(ws + WB_LG) + (size_t)drow * 256 + 64 * kb, 256, scr, lane); return; } it -= 256;
    { const int kb = it / 32, nb = it % 32; transpose_tile(a.in[34] + (size_t)(64 * kb) * D + 32 * nb, D, (bf16*)(ws + WB_LOUT) + (size_t)(32 * nb) * D + 64 * kb, D, scr, lane); }
}
constexpr int N_CONV_ITEMS1 = 2 * 1408 + 1408 + 1024 + 256 + 512;

__device__ __forceinline__ void adaln_item(const Args& a, int it, float* scr, int lane) {
    const int kc = it & 7, cg = (it >> 3) % 12, combo = it / 96;
    const float* cin = a.in[1];
#pragma unroll
    for (int i = 0; i < 8; ++i) { const int idx = lane + 64 * i, b = idx >> 7, kk = idx & 127; const float c = cin[b * D + kc * 128 + kk]; scr[idx] = siluf_(c); }
    LDS_WAIT(); asm volatile("" ::: "memory");
    const float* W = a.in[4] + ((size_t)combo * D + kc * 128) * 3072 + cg * 256 + lane * 4;
    f32x4 acc[4] = {{0.f, 0.f, 0.f, 0.f}, {0.f, 0.f, 0.f, 0.f}, {0.f, 0.f, 0.f, 0.f}, {0.f, 0.f, 0.f, 0.f}};
#pragma unroll 4
    for (int kk = 0; kk < 128; ++kk) { const f32x4 w = *(const f32x4*)(W + (size_t)kk * 3072);
#pragma unroll
        for (int b = 0; b < 4; ++b) acc[b] += w * scr[b * 128 + kk]; }
    float* P = (float*)(a.ws + WS_MODP);
#pragma unroll
    for (int b = 0; b < 4; ++b) *(f32x4*)(P + ((size_t)((kc * 4 + combo) * 4 + b)) * 3072 + cg * 256 + lane * 4) = acc[b];
    LDS_WAIT(); asm volatile("" ::: "memory");
}

__device__ __forceinline__ float mod_from_partials(const Args& a, int combo, int b, int n) {
    const float* P = (const float*)(a.ws + WS_MODP);
    float s = a.in[5][combo * 3072 + n];
#pragma unroll
    for (int kc = 0; kc < 8; ++kc) s += P[((size_t)((kc * 4 + combo) * 4 + b)) * 3072 + n];
    return s;
}

template <int MODE>
__device__ __forceinline__ void row_pass(const Args& a, Frame& F, const float* xres, const float* y, int combo_res, const float* npost, int combo_h, const float* npre) {
    float* tab = F.ldsf;
    const bool from_partials = (MODE == 0);
    const float* MODS = (const float*)(a.ws + WS_MODS);
    for (int rb = F.vcu; rb < M / 64; rb += F.G) {
        const int b = rb / (T / 64);
        __syncthreads();
        for (int k = F.tid; k < D; k += NWAVES * 64) {
            if (MODE != 2) {
                float sh, sc;
                if (from_partials) { sh = mod_from_partials(a, combo_h, b, k); sc = mod_from_partials(a, combo_h, b, D + k); }
                else { sh = MODS[(combo_h * 4 + b) * 3072 + k]; sc = MODS[(combo_h * 4 + b) * 3072 + D + k]; }
                tab[k] = npre[k] * (1.0f + sc); tab[D + k] = sh;
            }
            if (MODE != 0) tab[2 * D + k] = MODS[(combo_res * 4 + b) * 3072 + 2 * D + k] * npost[k];
        }
        __syncthreads();
        for (int rr = F.wave; rr < 64; rr += NWAVES) {
            const int row = rb * 64 + rr;
            f32x4 v[4];
            if (MODE == 0) {
#pragma unroll
                for (int j = 0; j < 4; ++j) v[j] = *(const f32x4*)(xres + (size_t)row * D + 256 * j + 4 * F.lane);
            } else {
                f32x4 yv[4]; float ss = 0.f;
#pragma unroll
                for (int j = 0; j < 4; ++j) { yv[j] = *(const f32x4*)(y + (size_t)row * D + 256 * j + 4 * F.lane); ss += (yv[j].x * yv[j].x + yv[j].y * yv[j].y) + (yv[j].z * yv[j].z + yv[j].w * yv[j].w); }
                const float rstd = 1.0f / sqrtf(wave_sum(ss) * (1.0f / D) + EPS);
#pragma unroll
                for (int j = 0; j < 4; ++j) { const f32x4 xr = *(const f32x4*)(xres + (size_t)row * D + 256 * j + 4 * F.lane); const f32x4 gp = *(const f32x4*)(tab + 2 * D + 256 * j + 4 * F.lane);
                    v[j] = xr + gp * (yv[j] * rstd); *(f32x4*)(a.out + (size_t)row * D + 256 * j + 4 * F.lane) = v[j]; }
            }
            if (MODE != 2) {
                float ss = 0.f;
#pragma unroll
                for (int j = 0; j < 4; ++j) ss += (v[j].x * v[j].x + v[j].y * v[j].y) + (v[j].z * v[j].z + v[j].w * v[j].w);
                const float rstd = 1.0f / sqrtf(wave_sum(ss) * (1.0f / D) + EPS);
                bf16* H = (bf16*)(a.ws + WS_H);
#pragma unroll
                for (int j = 0; j < 4; ++j) { const f32x4 g = *(const f32x4*)(tab + 256 * j + 4 * F.lane), s = *(const f32x4*)(tab + D + 256 * j + 4 * F.lane);
                    v[j] = v[j] * rstd * g + s;
                    v2u o; o.x = pk2(v[j].x, v[j].y); o.y = pk2(v[j].z, v[j].w); *(v2u*)(H + (size_t)row * D + 256 * j + 4 * F.lane) = o; }
                if (MODE == 0) {
                    const float* WSP = (const float*)(a.ws + WS_WSPEC);
                    float dots[8];
#pragma unroll
                    for (int c = 0; c < 8; ++c) { float s = 0.f;
#pragma unroll
                        for (int j = 0; j < 4; ++j) { const f32x4 w = *(const f32x4*)(WSP + c * D + 256 * j + 4 * F.lane); s += (v[j].x * w.x + v[j].y * w.y) + (v[j].z * w.z + v[j].w * w.w); }
                        dots[c] = wave_sum(s); }
                    if (F.lane < 4) { const int hh = F.lane; float al = dots[0], bb = dots[4];
                        al = hh == 1 ? dots[1] : al; al = hh == 2 ? dots[2] : al; al = hh == 3 ? dots[3] : al;
                        bb = hh == 1 ? dots[5] : bb; bb = hh == 2 ? dots[6] : bb; bb = hh == 3 ? dots[7] : bb;
                        float* GB = (float*)(a.ws + WS_GB);
                        GB[(size_t)row * 8 + hh] = -__expf(a.in[12][hh]) * softplusf_(al + a.in[13][hh]);
                        GB[(size_t)row * 8 + 4 + hh] = sigmoidf_(bb); }
                }
            }
        }
    }
}

typedef float f32x16 __attribute__((ext_vector_type(16)));
typedef short bf16x8s __attribute__((ext_vector_type(8)));
typedef float f32x2_t __attribute__((ext_vector_type(2))); typedef __bf16 bf16x2_t __attribute__((ext_vector_type(2)));
#define MFMA32(a, b, c) __builtin_amdgcn_mfma_f32_32x32x16_bf16((a), (b), (c), 0, 0, 0)
__device__ __forceinline__ unsigned cvtpk(float lo, float hi) { f32x2_t v = {lo, hi}; bf16x2_t b = __builtin_convertvector(v, bf16x2_t); return __builtin_bit_cast(unsigned, b); }
__device__ __forceinline__ int pi_(int k) { return (k & ~12) | ((k & 4) << 1) | ((k & 8) >> 1); }
__device__ __forceinline__ int img256(int row, int pos) { return row * 256 + ((((pos >> 3) ^ (row & 15))) << 4) + ((pos & 7) << 1); }
__device__ __forceinline__ int img128(int row, int pos) { return row * 128 + ((((pos >> 3) ^ ((row >> 1) & 7))) << 4) + ((pos & 7) << 1); }
__device__ __forceinline__ int crow(int r, int hh) { return (r & 3) + 8 * (r >> 2) + 4 * hh; }
__device__ __forceinline__ bf16x8s pack8(const f32x16& x, int s) { v4u p; p.x = cvtpk(x[8 * s], x[8 * s + 1]); p.y = cvtpk(x[8 * s + 2], x[8 * s + 3]); p.z = cvtpk(x[8 * s + 4], x[8 * s + 5]); p.w = cvtpk(x[8 * s + 6], x[8 * s + 7]); return __builtin_bit_cast(bf16x8s, p); }
__device__ __forceinline__ f32x16 zero16() { f32x16 z;
#pragma unroll
    for (int i = 0; i < 16; ++i) z[i] = 0.f; return z; }

__device__ __forceinline__ void tri_inverse64(float* MTf_in, int lane) {
    LAS float* MTf; { unsigned a32 = (unsigned)(unsigned long long)((LAS float*)MTf_in); asm volatile("" : "+v"(a32)); MTf = (LAS float*)(unsigned long long)a32; }
    float Tc[64];
#pragma unroll
    for (int i = 0; i < 64; ++i) Tc[i] = 0.f;
#pragma unroll
    for (int i = 0; i < 64; ++i) {
        float a0 = 0.f, a1 = 0.f, a2 = 0.f, a3 = 0.f;
#pragma unroll
        for (int j = 0; j < i; j += 4) { const f32x4 m4 = *(const LAS f32x4*)(MTf + i * 68 + j); a0 += m4.x * Tc[j]; a1 += m4.y * Tc[j + 1]; a2 += m4.z * Tc[j + 2]; a3 += m4.w * Tc[j + 3]; }
        Tc[i] = (lane == i ? 1.0f : 0.0f) - ((a0 + a1) + (a2 + a3));
        MTf[i * 68 + lane] = Tc[i];
        asm volatile("" ::: "memory");
    }
}

__device__ __forceinline__ void gdn_prep_unit(const Args& a, Frame& F, int b, int n, int h) {
    unsigned char* L = (unsigned char*)F.ldsf;
    constexpr int QH = 0, KH = 16384, VT = 32768, KBT = 49152, KDT = 65536, MT = 81920, GS = MT + 17408;
    float* Gs = (float*)(L + GS); float* MTf = (float*)(L + MT);
    int tid_ = F.tid; asm volatile("" : "+v"(tid_));
    const int R0 = b * T + n * 64, uid = (b * 64 + n) * 4 + h, lane = tid_ & 63, r32 = lane & 31, hh = lane >> 5;
    unsigned char* ws = a.ws;
    const bf16* COLS = (const bf16*)(ws + BIG_COLS); const bf16* HALO = (const bf16*)(ws + WS_HALO); const float* GB = (const float*)(ws + WS_GB); const float* cw = a.in[11];
    unsigned char* colsb = ws + BIG_COLS;
#define SLOT(part, o) (colsb + (size_t)(R0 + ((o) >> 8)) * (NCOLS * 2) + ((part) * 512 + h * 128) * 2 + ((o) & 255))
    if (F.wave == 0) {
        const float g = GB[(size_t)(R0 + lane) * 8 + h], be = GB[(size_t)(R0 + lane) * 8 + 4 + h];
        float G = g;
#pragma unroll
        for (int o = 1; o < 64; o <<= 1) { const float t = __shfl_up(G, o); if (lane >= o) G += t; }
        const float Gl = __shfl(G, 63);
        Gs[lane] = G; Gs[64 + lane] = be; Gs[128 + lane] = __expf(G); Gs[192 + lane] = __expf(Gl - G);
        if (lane == 0) ((float*)(ws + GDN_GL))[uid] = __expf(Gl);
    }
    __syncthreads();
    unsigned qdpk[2][4];
#pragma unroll
    for (int i = 0; i < 6; ++i) {
        const int item = tid_ + 512 * i, part = item >> 10, rem = item & 1023, tok = rem >> 4, m = rem & 15, c8 = m * 8, wcol = part * 512 + h * 128 + c8;
        float v[8];
#pragma unroll
        for (int e = 0; e < 8; ++e) v[e] = 0.f;
#pragma unroll
        for (int j = 0; j < 4; ++j) { const int tau = tok - 3 + j; v4u xw = {0u, 0u, 0u, 0u};
            if (tau >= 0) xw = *(const v4u*)(COLS + (size_t)(R0 + tau) * NCOLS + wcol);
            else if (n > 0) xw = *(const v4u*)(HALO + ((size_t)((b * 64 + n - 1) * 3) + (3 + tau)) * NCOLS + wcol);
            const float* w = cw + j * 1536 + wcol;
            v[0] += w[0] * bf_lo(xw.x); v[1] += w[1] * bf_hi(xw.x); v[2] += w[2] * bf_lo(xw.y); v[3] += w[3] * bf_hi(xw.y);
            v[4] += w[4] * bf_lo(xw.z); v[5] += w[5] * bf_hi(xw.z); v[6] += w[6] * bf_lo(xw.w); v[7] += w[7] * bf_hi(xw.w); }
#pragma unroll
        for (int e = 0; e < 8; ++e) v[e] = siluf_(v[e]);
        if (part < 2) { float ss = 0.f;
#pragma unroll
            for (int e = 0; e < 8; ++e) ss += v[e] * v[e];
            ss += __shfl_xor(ss, 1); ss += __shfl_xor(ss, 2); ss += __shfl_xor(ss, 4); ss += __shfl_xor(ss, 8);
            const float sc = (1.0f / sqrtf(ss + EPS)) * (part == 0 ? 0.08838834764831845f : 1.0f);
#pragma unroll
            for (int e = 0; e < 8; ++e) v[e] *= sc; }
        if (part == 0) {
            v4u o; o.x = cvtpk(v[0], v[1]); o.y = cvtpk(v[2], v[3]); o.z = cvtpk(v[4], v[5]); o.w = cvtpk(v[6], v[7]);
            *(v4u*)(L + QH + tok * 256 + ((m ^ (tok & 15)) << 4)) = o;
            const float eg = Gs[128 + tok];
            qdpk[i & 1][0] = cvtpk(v[0] * eg, v[1] * eg); qdpk[i & 1][1] = cvtpk(v[2] * eg, v[3] * eg); qdpk[i & 1][2] = cvtpk(v[4] * eg, v[5] * eg); qdpk[i & 1][3] = cvtpk(v[6] * eg, v[7] * eg);
        } else if (part == 1) {
            v4u o; o.x = cvtpk(v[0], v[1]); o.y = cvtpk(v[2], v[3]); o.z = cvtpk(v[4], v[5]); o.w = cvtpk(v[6], v[7]);
            *(v4u*)(L + KH + tok * 256 + ((m ^ (tok & 15)) << 4)) = o;
            const float sb = Gs[64 + tok] * Gs[128 + tok], sd = Gs[192 + tok]; const int ptok = pi_(tok);
#pragma unroll
            for (int e = 0; e < 8; ++e) { const int ch = c8 + e;
                *(bf16*)(L + KBT + img128(ch, tok)) = (bf16)f2bf(v[e] * sb);
                *(bf16*)(L + KDT + img128(ch, ptok)) = (bf16)f2bf(v[e] * sd); }
        } else {
            const float be = Gs[64 + tok];
#pragma unroll
            for (int e = 0; e < 8; ++e) { const int ch = c8 + e; *(bf16*)(L + VT + img128(ch, tok)) = (bf16)f2bf(v[e] * be); }
        }
        asm volatile("" ::: "memory");
    }
    __syncthreads();
#pragma unroll
    for (int i = 0; i < 2; ++i) { const int rem = (tid_ + 512 * i) & 1023, tok = rem >> 4, m = rem & 15, cA = 2 * (m >> 1);
        v2u p0 = {qdpk[i][0], qdpk[i][1]}, p1 = {qdpk[i][2], qdpk[i][3]};
        *(v2u*)SLOT(0, tok * 256 + ((cA ^ (tok & 15)) << 4) + (m & 1) * 8) = p0;
        *(v2u*)SLOT(0, tok * 256 + (((cA + 1) ^ (tok & 15)) << 4) + (m & 1) * 8) = p1; }
    { const int o = tid_ * 32; const v4u x0 = *(const v4u*)(L + KDT + o), x1 = *(const v4u*)(L + KDT + o + 16); *(v4u*)SLOT(1, o) = x0; *(v4u*)SLOT(1, o + 16) = x1; }
    { const int p = F.wave >> 2, ti = (F.wave >> 1) & 1, tj = F.wave & 1;
      f32x16 acc = zero16();
      if (!(ti == 0 && tj == 1)) {
          const int i = 32 * ti + r32, j = 32 * tj + r32; const unsigned char* Ab = L + (p ? QH : KH) + i * 256; const unsigned char* Bb = L + KH + j * 256;
#pragma unroll
          for (int ks = 0; ks < 8; ++ks) { const bf16x8s A = *(const bf16x8s*)(Ab + (((2 * ks + hh) ^ (i & 15)) << 4)); const bf16x8s B = *(const bf16x8s*)(Bb + (((2 * ks + hh) ^ (j & 15)) << 4)); acc = MFMA32(A, B, acc); }
      }
      const int j = 32 * tj + r32; const float Gj = Gs[j]; const int pj = pi_(j);
      unsigned char* att = ws + GDN_ATT + (size_t)uid * 8192;
#pragma unroll
      for (int r = 0; r < 16; ++r) { const int i = 32 * ti + crow(r, hh); const float e = __expf(fminf(Gs[i] - Gj, 0.f));
          if (p == 0) MTf[i * 68 + j] = (i > j) ? Gs[64 + i] * acc[r] * e : 0.f;
          else *(bf16*)(att + img128(i, pj)) = (bf16)f2bf((i >= j) ? acc[r] * e : 0.f); }
    }
    __syncthreads();
    if (F.wave == 0) tri_inverse64(MTf, lane);
    __syncthreads();
    { const int ti = F.wave >> 2, cj = F.wave & 3, t = 32 * ti + r32, ch = 32 * cj + r32;
      f32x16 au = zero16(), aw = zero16();
#pragma unroll
      for (int ks = 0; ks < 4; ++ks) { const f32x4 t0 = *(const f32x4*)(MTf + t * 68 + 16 * ks + 8 * hh), t1 = *(const f32x4*)(MTf + t * 68 + 16 * ks + 8 * hh + 4);
          v4u pa; pa.x = cvtpk(t0.x, t0.y); pa.y = cvtpk(t0.z, t0.w); pa.z = cvtpk(t1.x, t1.y); pa.w = cvtpk(t1.z, t1.w); const bf16x8s A = __builtin_bit_cast(bf16x8s, pa);
          const int sw = ((2 * ks + hh) ^ ((ch >> 1) & 7)) << 4;
          const bf16x8s Bu = *(const bf16x8s*)(L + VT + ch * 128 + sw), Bw = *(const bf16x8s*)(L + KBT + ch * 128 + sw);
          au = MFMA32(A, Bu, au); aw = MFMA32(A, Bw, aw); }
      v4u u0, u1; u0.x = cvtpk(au[0], au[1]); u0.y = cvtpk(au[2], au[3]); u0.z = cvtpk(au[4], au[5]); u0.w = cvtpk(au[6], au[7]);
      u1.x = cvtpk(au[8], au[9]); u1.y = cvtpk(au[10], au[11]); u1.z = cvtpk(au[12], au[13]); u1.w = cvtpk(au[14], au[15]);
      const int o = ((ti * 4 + cj) * 64 + lane) * 32;
      *(v4u*)SLOT(2, o) = u0; *(v4u*)SLOT(2, o + 16) = u1;
      unsigned char* wp = ws + GDN_WP + (size_t)uid * 16384; const int pk = pi_(ch);
#pragma unroll
      for (int r = 0; r < 16; ++r) { const int tt = 32 * ti + crow(r, hh); *(bf16*)(wp + img256(tt, pk)) = (bf16)f2bf(-aw[r]); }
    }
    __syncthreads();
#undef SLOT
}


__device__ __forceinline__ void gdn_load_stage(unsigned char* ws, unsigned char* L, int b, int h, int n, int stg, int ltid) {
    constexpr int STG = 57344;
    unsigned char* colsb = ws + BIG_COLS;
    const int R0 = b * T + n * 64, uid = (b * 64 + n) * 4 + h;
    v4u x[14];
#pragma unroll
    for (int i = 0; i < 14; ++i) { const int q = ltid + 256 * i; const unsigned char* src;
        if (q < 1024) src = ws + GDN_WP + (size_t)uid * 16384 + q * 16;
        else if (q < 3072) { const int part = (q - 1024) >> 10, o = ((q - 1024) & 1023) * 16; src = colsb + (size_t)(R0 + (o >> 8)) * (NCOLS * 2) + (part * 512 + h * 128) * 2 + (o & 255); }
        else src = ws + GDN_ATT + (size_t)uid * 8192 + (q - 3072) * 16;
        x[i] = *(const v4u*)src; }
#pragma unroll
    for (int i = 0; i < 14; ++i) { const int q = ltid + 256 * i; *(v4u*)(L + stg * STG + q * 16) = x[i]; }
}
__device__ __forceinline__ void gdn_load_u(unsigned char* ws, int b, int h, int n, int vt, int lane, v4u& u00, v4u& u01, v4u& u10, v4u& u11) {
    unsigned char* colsb = ws + BIG_COLS; const int R0 = b * T + n * 64;
    { const int o = ((0 * 4 + vt) * 64 + lane) * 32; const unsigned char* src = colsb + (size_t)(R0 + (o >> 8)) * (NCOLS * 2) + (2 * 512 + h * 128) * 2 + (o & 255); u00 = *(const v4u*)src; u01 = *(const v4u*)(src + 16); }
    { const int o = ((1 * 4 + vt) * 64 + lane) * 32; const unsigned char* src = colsb + (size_t)(R0 + (o >> 8)) * (NCOLS * 2) + (2 * 512 + h * 128) * 2 + (o & 255); u10 = *(const v4u*)src; u11 = *(const v4u*)(src + 16); }
}
__device__ __forceinline__ void gdn_post(unsigned char* ws, const float* OBf, const float* nw, int b, int h, int n, int lw, int lane) {
    const int R0 = b * T + n * 64; const bf16* COLS = (const bf16*)(ws + BIG_COLS); bf16* A2 = (bf16*)(ws + WS_H);
    for (int tok = lw * 16; tok < lw * 16 + 16; ++tok) {
        const float o0 = OBf[tok * 128 + lane], o1 = OBf[tok * 128 + 64 + lane];
        const float rstd = 1.0f / sqrtf(wave_sum(o0 * o0 + o1 * o1) * (1.0f / 128.0f) + EPS);
        const size_t row = (size_t)(R0 + tok);
        const float z0 = bf2f(COLS[row * NCOLS + 1536 + h * 128 + lane]), z1 = bf2f(COLS[row * NCOLS + 1536 + h * 128 + 64 + lane]);
        A2[row * D + h * 128 + lane] = (bf16)f2bf(o0 * rstd * nw[lane] * siluf_(z0));
        A2[row * D + h * 128 + 64 + lane] = (bf16)f2bf(o1 * rstd * nw[64 + lane] * siluf_(z1)); }
}
__device__ __forceinline__ void gdn_chain(const Args& a, Frame& F, int b, int h) {
    unsigned char* L = (unsigned char*)F.ldsf;
    constexpr int STG = 57344, OB = 2 * STG;
    float* OBf = (float*)(L + OB);
    unsigned char* ws = a.ws; unsigned char* colsb = ws + BIG_COLS;
    int tid0 = F.tid; asm volatile("" : "+v"(tid0));
    const int lane = tid0 & 63, r32_ = lane & 31, hh_ = lane >> 5;
    const bool chain = F.wave < 4; const int vt = F.wave & 3;
    const float* GLp = (const float*)(ws + GDN_GL); const float* nw = a.in[14];
    f32x16 S[4];
#pragma unroll
    for (int kt = 0; kt < 4; ++kt) S[kt] = zero16();
    v4u un00, un01, un10, un11;
    if (chain) gdn_load_u(ws, b, h, 0, vt, lane, un00, un01, un10, un11); else gdn_load_stage(ws, L, b, h, 0, 0, tid0 - 256);
    __syncthreads();
    for (int n = 0; n < T / 64; ++n) {
        const int stg = n & 1;
        f32x16 o[2];
        int r32 = r32_, hh = hh_, ltid = tid0 - 256; asm volatile("" : "+v"(r32), "+v"(hh), "+v"(ltid));
        if (chain) {
            const unsigned char* st = L + stg * STG;
            const float gl = GLp[(b * 64 + n) * 4 + h];
            f32x16 vn[2];
#pragma unroll
            for (int rb = 0; rb < 2; ++rb) { const v4u x0 = rb ? un10 : un00, x1 = rb ? un11 : un01;
                vn[rb][0] = bf_lo(x0.x); vn[rb][1] = bf_hi(x0.x); vn[rb][2] = bf_lo(x0.y); vn[rb][3] = bf_hi(x0.y); vn[rb][4] = bf_lo(x0.z); vn[rb][5] = bf_hi(x0.z); vn[rb][6] = bf_lo(x0.w); vn[rb][7] = bf_hi(x0.w);
                vn[rb][8] = bf_lo(x1.x); vn[rb][9] = bf_hi(x1.x); vn[rb][10] = bf_lo(x1.y); vn[rb][11] = bf_hi(x1.y); vn[rb][12] = bf_lo(x1.z); vn[rb][13] = bf_hi(x1.z); vn[rb][14] = bf_lo(x1.w); vn[rb][15] = bf_hi(x1.w); }
            if (n + 1 < T / 64) gdn_load_u(ws, b, h, n + 1, vt, lane, un00, un01, un10, un11);
            bf16x8s Sb[4][2];
#pragma unroll
            for (int kt = 0; kt < 4; ++kt) { Sb[kt][0] = pack8(S[kt], 0); Sb[kt][1] = pack8(S[kt], 1); }
            o[0] = zero16(); o[1] = zero16();
#pragma unroll
            for (int rb = 0; rb < 2; ++rb) { const int c = 32 * rb + r32;
#pragma unroll
                for (int kt = 0; kt < 4; ++kt)
#pragma unroll
                    for (int s = 0; s < 2; ++s) { const int off = c * 256 + (((4 * kt + 2 * s + hh) ^ (c & 15)) << 4);
                        const bf16x8s Aw = *(const bf16x8s*)(st + off), Aq = *(const bf16x8s*)(st + 16384 + off);
                        vn[rb] = MFMA32(Aw, Sb[kt][s], vn[rb]); o[rb] = MFMA32(Aq, Sb[kt][s], o[rb]); if (s == 1 && (kt & 1)) asm volatile("" ::: "memory"); } }
            bf16x8s Vb[2][2];
#pragma unroll
            for (int rb = 0; rb < 2; ++rb) { Vb[rb][0] = pack8(vn[rb], 0); Vb[rb][1] = pack8(vn[rb], 1); }
#pragma unroll
            for (int rb = 0; rb < 2; ++rb) { const int c = 32 * rb + r32;
#pragma unroll
                for (int rb2 = 0; rb2 <= rb; ++rb2)
#pragma unroll
                    for (int s = 0; s < 2; ++s) { const bf16x8s Aa = *(const bf16x8s*)(st + 49152 + c * 128 + (((4 * rb2 + 2 * s + hh) ^ ((c >> 1) & 7)) << 4)); o[rb] = MFMA32(Aa, Vb[rb2][s], o[rb]); } }
#pragma unroll
            for (int kt = 0; kt < 4; ++kt) { const int k = 32 * kt + r32;
#pragma unroll
                for (int r = 0; r < 16; ++r) S[kt][r] *= gl;
#pragma unroll
                for (int rb2 = 0; rb2 < 2; ++rb2)
#pragma unroll
                    for (int s = 0; s < 2; ++s) { const bf16x8s Ak = *(const bf16x8s*)(st + 32768 + k * 128 + (((4 * rb2 + 2 * s + hh) ^ ((k >> 1) & 7)) << 4)); S[kt] = MFMA32(Ak, Vb[rb2][s], S[kt]); } asm volatile("" ::: "memory"); }
        } else {
            if (n + 1 < T / 64) gdn_load_stage(ws, L, b, h, n + 1, stg ^ 1, ltid);
            if (n > 0) gdn_post(ws, OBf, nw, b, h, n - 1, F.wave - 4, ltid & 63);
        }
        __syncthreads();
        if (chain) {
#pragma unroll
            for (int rb = 0; rb < 2; ++rb)
#pragma unroll
                for (int r = 0; r < 16; ++r) OBf[(32 * rb + crow(r, hh)) * 128 + 32 * vt + r32] = o[rb][r];
        }
        __syncthreads();
    }
    if (!chain) gdn_post(ws, OBf, nw, b, h, T / 64 - 1, F.wave - 4, lane);
    __syncthreads();
}


__device__ __forceinline__ void rwkv_prep_unit(const Args& a, Frame& F, int b, int n, int h) {
    unsigned char* L = (unsigned char*)F.ldsf;
    constexpr int RM = 0, KM = 16384, VM = 32768;
    constexpr int KT = 0, KTT = 8192, BTI = 16384, KTIL = 24576, RT = 32768, VT = 40960;
    constexpr int LWI = 49152, LAI = 57344, LGI = 65536;
    constexpr int KHT = 49152, BHT = 57344, AKK = 65536, ARK = 73728;
    constexpr int LOGW = 81920, AA = 98304, CLS = 114688, MT = 115200;
    float* MTf = (float*)(L + MT); float* LOGWf = (float*)(L + LOGW); float* AAf = (float*)(L + AA); float* CLf = (float*)(L + CLS);
    int tid_ = F.tid; asm volatile("" : "+v"(tid_));
    const int R0 = b * T + n * 64, uid = ((b * 64 + n) << 3) + h, lane = tid_ & 63, r32 = lane & 31, hh = lane >> 5, hc0 = h * 64;
    unsigned char* ws = a.ws; unsigned char* dob = (unsigned char*)a.out;
    const bf16* COLS = (const bf16*)(ws + BIG_COLS); const bf16* HALO = (const bf16*)(ws + WS_HALO);
    unsigned char* colsb = ws + BIG_COLS;
    const float* mu = a.in[15]; const float* w0 = a.in[16]; const float* a0 = a.in[18]; const float* k_k = a.in[21]; const float* k_a = a.in[22]; const float* r_k = a.in[23];
#define SLOTR(part, o) (colsb + (size_t)(R0 + ((o) >> 7)) * (NCOLS * 2) + (2048 + (part) * 512 + hc0) * 2 + ((o) & 127))
#pragma unroll
    for (int i = 0; i < 7; ++i) {
        const int item = tid_ + 512 * i, tok = item / 56, g8 = item % 56, lc = g8 * 8;
        int rc; if (lc < 64) rc = hc0 + lc; else if (lc < 128) rc = 512 + hc0 + (lc - 64); else if (lc < 192) rc = 1024 + hc0 + (lc - 128); else rc = 1536 + (lc - 192);
        const v4u cw = *(const v4u*)(COLS + (size_t)(R0 + tok) * NCOLS + 2048 + rc);
        v4u pw = {0u, 0u, 0u, 0u};
        if (tok > 0) pw = *(const v4u*)(COLS + (size_t)(R0 + tok - 1) * NCOLS + 2048 + rc);
        else if (n > 0) pw = *(const v4u*)(HALO + ((size_t)((b * 64 + n - 1) * 3) + 2) * NCOLS + 2048 + rc);
        const float cur[8] = {bf_lo(cw.x), bf_hi(cw.x), bf_lo(cw.y), bf_hi(cw.y), bf_lo(cw.z), bf_hi(cw.z), bf_lo(cw.w), bf_hi(cw.w)};
        const float prv[8] = {bf_lo(pw.x), bf_hi(pw.x), bf_lo(pw.y), bf_hi(pw.y), bf_lo(pw.z), bf_hi(pw.z), bf_lo(pw.w), bf_hi(pw.w)};
        float v[8];
#pragma unroll
        for (int e = 0; e < 8; ++e) v[e] = cur[e] + mu[rc + e] * (prv[e] - cur[e]);
        if (lc < 192) { float* dst = (float*)(L + (lc < 64 ? RM : (lc < 128 ? KM : VM))) + tok * 64 + (lc & 63);
            *(f32x4*)dst = (f32x4){v[0], v[1], v[2], v[3]}; *(f32x4*)(dst + 4) = (f32x4){v[4], v[5], v[6], v[7]}; }
        else { const int idx = lc - 192;
            if (idx < 64) {
#pragma unroll
                for (int e = 0; e < 8; ++e) v[e] = tanhf(v[e]);
            } else if (idx >= 128) {
#pragma unroll
                for (int e = 0; e < 8; ++e) v[e] = sigmoidf_(v[e]);
            }
            v4u o; o.x = cvtpk(v[0], v[1]); o.y = cvtpk(v[2], v[3]); o.z = cvtpk(v[4], v[5]); o.w = cvtpk(v[6], v[7]);
            if (idx < 64) *(v4u*)(L + LWI + tok * 128 + (((idx >> 3) ^ ((tok >> 1) & 7)) << 4)) = o;
            else if (idx < 128) *(v4u*)(L + LAI + tok * 128 + ((((idx - 64) >> 3) ^ ((tok >> 1) & 7)) << 4)) = o;
            else *(v4u*)(L + LGI + tok * 256 + ((((idx - 128) >> 3) ^ (tok & 15)) << 4)) = o; }
        asm volatile("" ::: "memory");
    }
    __syncthreads();
    { const int wq = F.wave & 3, ti = wq >> 1, tj = wq & 1, t = 32 * ti + r32, j = 32 * tj + r32;
      const unsigned char* lwb = ws + RW_LW + ((size_t)(h * 64 + j) * 256) * 2;
      if (F.wave < 4) {
          f32x16 aw = zero16(), aa = zero16();
#pragma unroll
          for (int ks = 0; ks < 4; ++ks) { const int sw = ((2 * ks + hh) ^ ((t >> 1) & 7)) << 4;
              const bf16x8s Aw = *(const bf16x8s*)(L + LWI + t * 128 + sw), Aa = *(const bf16x8s*)(L + LAI + t * 128 + sw);
              const bf16x8s Bw = *(const bf16x8s*)(lwb + (16 * ks + 8 * hh) * 2), Ba = *(const bf16x8s*)(lwb + (64 + 16 * ks + 8 * hh) * 2);
              aw = MFMA32(Aw, Bw, aw); aa = MFMA32(Aa, Ba, aa); }
          const float w0j = w0[hc0 + j], a0j = a0[hc0 + j];
#pragma unroll
          for (int r = 0; r < 16; ++r) { const int tt = 32 * ti + crow(r, hh);
              LOGWf[tt * 64 + j] = -__expf(-softplusf_(-(w0j + aw[r])) - 0.5f); AAf[tt * 64 + j] = sigmoidf_(a0j + aa[r]); }
      } else {
          f32x16 ag = zero16();
#pragma unroll
          for (int ks = 0; ks < 8; ++ks) { const bf16x8s Ag = *(const bf16x8s*)(L + LGI + t * 256 + (((2 * ks + hh) ^ (t & 15)) << 4));
              const bf16x8s Bg = *(const bf16x8s*)(lwb + (128 + 16 * ks + 8 * hh) * 2); ag = MFMA32(Ag, Bg, ag); }
#pragma unroll
          for (int r = 0; r < 16; ++r) { const int tt = 32 * ti + crow(r, hh); *(bf16*)SLOTR(1, tt * 128 + j * 2) = (bf16)f2bf(ag[r]); }
      }
    }
    __syncthreads();
    {
#pragma unroll
      for (int q = 0; q < 8; ++q) { const int j = F.wave * 8 + q; float x = LOGWf[lane * 64 + j];
#pragma unroll
          for (int o = 1; o < 64; o <<= 1) { const float tv = __shfl_up(x, o); if (lane >= o) x += tv; }
          LOGWf[lane * 64 + j] = x; if (lane == 63) CLf[j] = x; }
    }
    __syncthreads();
    const int et = tid_ >> 3, em = tid_ & 7, ej0 = em * 8;
    unsigned pk_kt[4], pk_bt[4], pk_ktil[4], pk_rt[4], pk_bh[4], pk_kh[4], pk_v[4], pk_bv[4];
    {
        float rr[8], kk_[8], vv[8], aa[8], cu[8], cp[8], cl[8];
        { const f32x4 x0 = *(const f32x4*)(L + RM + (et * 64 + ej0) * 4), x1 = *(const f32x4*)(L + RM + (et * 64 + ej0 + 4) * 4); rr[0] = x0.x; rr[1] = x0.y; rr[2] = x0.z; rr[3] = x0.w; rr[4] = x1.x; rr[5] = x1.y; rr[6] = x1.z; rr[7] = x1.w; }
        { const f32x4 x0 = *(const f32x4*)(L + KM + (et * 64 + ej0) * 4), x1 = *(const f32x4*)(L + KM + (et * 64 + ej0 + 4) * 4); kk_[0] = x0.x; kk_[1] = x0.y; kk_[2] = x0.z; kk_[3] = x0.w; kk_[4] = x1.x; kk_[5] = x1.y; kk_[6] = x1.z; kk_[7] = x1.w; }
        { const f32x4 x0 = *(const f32x4*)(L + VM + (et * 64 + ej0) * 4), x1 = *(const f32x4*)(L + VM + (et * 64 + ej0 + 4) * 4); vv[0] = x0.x; vv[1] = x0.y; vv[2] = x0.z; vv[3] = x0.w; vv[4] = x1.x; vv[5] = x1.y; vv[6] = x1.z; vv[7] = x1.w; }
        { const f32x4 x0 = *(const f32x4*)(AAf + et * 64 + ej0), x1 = *(const f32x4*)(AAf + et * 64 + ej0 + 4); aa[0] = x0.x; aa[1] = x0.y; aa[2] = x0.z; aa[3] = x0.w; aa[4] = x1.x; aa[5] = x1.y; aa[6] = x1.z; aa[7] = x1.w; }
        { const f32x4 x0 = *(const f32x4*)(LOGWf + et * 64 + ej0), x1 = *(const f32x4*)(LOGWf + et * 64 + ej0 + 4); cu[0] = x0.x; cu[1] = x0.y; cu[2] = x0.z; cu[3] = x0.w; cu[4] = x1.x; cu[5] = x1.y; cu[6] = x1.z; cu[7] = x1.w; }
        if (et > 0) { const f32x4 x0 = *(const f32x4*)(LOGWf + (et - 1) * 64 + ej0), x1 = *(const f32x4*)(LOGWf + (et - 1) * 64 + ej0 + 4); cp[0] = x0.x; cp[1] = x0.y; cp[2] = x0.z; cp[3] = x0.w; cp[4] = x1.x; cp[5] = x1.y; cp[6] = x1.z; cp[7] = x1.w; }
        else {
#pragma unroll
            for (int e = 0; e < 8; ++e) cp[e] = 0.f; }
        { const f32x4 x0 = *(const f32x4*)(CLf + ej0), x1 = *(const f32x4*)(CLf + ej0 + 4); cl[0] = x0.x; cl[1] = x0.y; cl[2] = x0.z; cl[3] = x0.w; cl[4] = x1.x; cl[5] = x1.y; cl[6] = x1.z; cl[7] = x1.w; }
        float kkr[8], km2[8]; float ss = 0.f, bs = 0.f;
#pragma unroll
        for (int e = 0; e < 8; ++e) { const int c = hc0 + ej0 + e; kkr[e] = kk_[e] * k_k[c]; ss += kkr[e] * kkr[e]; km2[e] = kk_[e] * (1.0f + (aa[e] - 1.0f) * k_a[c]); bs += rr[e] * km2[e] * r_k[c]; }
        ss += __shfl_xor(ss, 1); ss += __shfl_xor(ss, 2); ss += __shfl_xor(ss, 4);
        bs += __shfl_xor(bs, 1); bs += __shfl_xor(bs, 2); bs += __shfl_xor(bs, 4);
        const float rn = 1.0f / sqrtf(ss + EPS);
        float o_kt[8], o_bt[8], o_ktil[8], o_rt[8], o_bh[8], o_kh[8], o_bv[8];
#pragma unroll
        for (int e = 0; e < 8; ++e) { const float kkn = kkr[e] * rn, kka = kkn * aa[e];
            const float eW = __expf(cu[e]), eWm1 = __expf(cp[e]), eWi = __expf(-cu[e]), eWC = __expf(cl[e] - cu[e]);
            o_kt[e] = kkn * eWm1; o_bt[e] = kka * eWi; o_ktil[e] = km2[e] * eWi; o_rt[e] = rr[e] * eW; o_bh[e] = kka * eWC; o_kh[e] = km2[e] * eWC; o_bv[e] = bs * vv[e]; }
#pragma unroll
        for (int q = 0; q < 4; ++q) { pk_kt[q] = cvtpk(o_kt[2 * q], o_kt[2 * q + 1]); pk_bt[q] = cvtpk(o_bt[2 * q], o_bt[2 * q + 1]); pk_ktil[q] = cvtpk(o_ktil[2 * q], o_ktil[2 * q + 1]); pk_rt[q] = cvtpk(o_rt[2 * q], o_rt[2 * q + 1]);
            pk_bh[q] = cvtpk(o_bh[2 * q], o_bh[2 * q + 1]); pk_kh[q] = cvtpk(o_kh[2 * q], o_kh[2 * q + 1]); pk_v[q] = cvtpk(vv[2 * q], vv[2 * q + 1]); pk_bv[q] = cvtpk(o_bv[2 * q], o_bv[2 * q + 1]); }
        if (tid_ < 64) ((float*)(ws + RW_WC))[(size_t)uid * 64 + tid_] = __expf(CLf[tid_]);
    }
    __syncthreads();
    { const int sw = (em ^ ((et >> 1) & 7)) << 4;
      *(v4u*)(L + KT + et * 128 + sw) = (v4u){pk_kt[0], pk_kt[1], pk_kt[2], pk_kt[3]};
      *(v4u*)(L + BTI + et * 128 + sw) = (v4u){pk_bt[0], pk_bt[1], pk_bt[2], pk_bt[3]};
      *(v4u*)(L + KTIL + et * 128 + sw) = (v4u){pk_ktil[0], pk_ktil[1], pk_ktil[2], pk_ktil[3]};
      *(v4u*)(L + RT + et * 128 + sw) = (v4u){pk_rt[0], pk_rt[1], pk_rt[2], pk_rt[3]};
      const int pt = pi_(et);
#pragma unroll
      for (int e = 0; e < 8; ++e) { const int j = ej0 + e; const int sh = (e & 1) * 16; const int q = e >> 1;
          const int ad = j * 128 + (((et >> 3) ^ ((j >> 1) & 7)) << 4) + (et & 7) * 2;
          *(bf16*)(L + KTT + ad) = (bf16)(pk_kt[q] >> sh); *(bf16*)(L + VT + ad) = (bf16)(pk_v[q] >> sh); *(bf16*)(L + KHT + ad) = (bf16)(pk_kh[q] >> sh);
          *(bf16*)(L + BHT + j * 128 + (((pt >> 3) ^ ((j >> 1) & 7)) << 4) + (pt & 7) * 2) = (bf16)(pk_bh[q] >> sh); }
      const int cA = 2 * (em >> 1), swr = (et >> 1) & 7;
      *(v2u*)SLOTR(0, et * 128 + ((cA ^ swr) << 4) + (em & 1) * 8) = (v2u){pk_rt[0], pk_rt[1]};
      *(v2u*)SLOTR(0, et * 128 + (((cA + 1) ^ swr) << 4) + (em & 1) * 8) = (v2u){pk_rt[2], pk_rt[3]};
      *(v4u*)SLOTR(2, et * 128 + ej0 * 2) = (v4u){pk_bv[0], pk_bv[1], pk_bv[2], pk_bv[3]};
    }
    __syncthreads();
    { const v4u x = *(const v4u*)(L + BHT + tid_ * 16); *(v4u*)(dob + DO_BT + (size_t)uid * 8192 + tid_ * 16) = x; }
#pragma unroll
    for (int rep = 0; rep < 2; ++rep) { const int q = F.wave + 8 * rep, pr = q >> 2, ti = (q >> 1) & 1, tj = q & 1, t = 32 * ti + r32, s2 = 32 * tj + r32;
        f32x16 acc = zero16();
        if (!(ti == 0 && tj == 1)) {
            const unsigned char* Ab = L + (pr < 2 ? KT : RT) + t * 128; const unsigned char* Bb = L + ((pr & 1) ? KTIL : BTI) + s2 * 128;
#pragma unroll
            for (int ks = 0; ks < 4; ++ks) { const bf16x8s A = *(const bf16x8s*)(Ab + (((2 * ks + hh) ^ ((t >> 1) & 7)) << 4)); const bf16x8s B = *(const bf16x8s*)(Bb + (((2 * ks + hh) ^ ((s2 >> 1) & 7)) << 4)); acc = MFMA32(A, B, acc); }
        }
        const int ps = pi_(s2);
#pragma unroll
        for (int r = 0; r < 16; ++r) { const int tt = 32 * ti + crow(r, hh);
            if (pr == 0) MTf[tt * 68 + s2] = (tt > s2) ? acc[r] : 0.f;
            else if (pr == 1) *(bf16*)(L + AKK + img128(tt, s2)) = (bf16)f2bf((tt > s2) ? acc[r] : 0.f);
            else if (pr == 2) *(bf16*)(dob + DO_ARB + (size_t)uid * 8192 + img128(tt, ps)) = (bf16)f2bf((tt >= s2) ? acc[r] : 0.f);
            else *(bf16*)(L + ARK + img128(tt, s2)) = (bf16)f2bf((tt >= s2) ? acc[r] : 0.f); }
    }
    __syncthreads();
    f32x16 x1a = zero16(), x1b = zero16();
    if (F.wave == 0) tri_inverse64(MTf, lane);
    else if (F.wave < 5) { const int tj = (F.wave - 1) & 1, vcol = 32 * tj + r32;
#pragma unroll
        for (int ks = 0; ks < 4; ++ks) { const bf16x8s B = *(const bf16x8s*)(L + VT + vcol * 128 + (((2 * ks + hh) ^ ((vcol >> 1) & 7)) << 4));
            const int ta = r32, tb = 32 + r32;
            const bf16x8s Aa = *(const bf16x8s*)(L + AKK + ta * 128 + (((2 * ks + hh) ^ ((ta >> 1) & 7)) << 4)), Ab = *(const bf16x8s*)(L + AKK + tb * 128 + (((2 * ks + hh) ^ ((tb >> 1) & 7)) << 4));
            x1a = MFMA32(Aa, B, x1a); x1b = MFMA32(Ab, B, x1b); }
    } else {
#pragma unroll
        for (int rep = 0; rep < 3; ++rep) { const int idx = (F.wave - 5) + 3 * rep;
            if (idx < 8) { const bool isds = idx >= 4; const int q = idx & 3, ti = q >> 1, tj = q & 1, arow = 32 * ti + r32, vcol = 32 * tj + r32;
                const unsigned char* Ab = L + (isds ? KHT : ARK) + arow * 128; const unsigned char* Bb = L + VT + vcol * 128;
                f32x16 acc = zero16();
#pragma unroll
                for (int ks = 0; ks < 4; ++ks) { const bf16x8s A = *(const bf16x8s*)(Ab + (((2 * ks + hh) ^ ((arow >> 1) & 7)) << 4)); const bf16x8s B = *(const bf16x8s*)(Bb + (((2 * ks + hh) ^ ((vcol >> 1) & 7)) << 4)); acc = MFMA32(A, B, acc); }
                v4u u0, u1; u0.x = cvtpk(acc[0], acc[1]); u0.y = cvtpk(acc[2], acc[3]); u0.z = cvtpk(acc[4], acc[5]); u0.w = cvtpk(acc[6], acc[7]);
                u1.x = cvtpk(acc[8], acc[9]); u1.y = cvtpk(acc[10], acc[11]); u1.z = cvtpk(acc[12], acc[13]); u1.w = cvtpk(acc[14], acc[15]);
                unsigned char* dst = ws + (isds ? RW_DS : RW_YL) + (size_t)uid * 8192 + ((ti * 2 + tj) * 64 + lane) * 32;
                *(v4u*)dst = u0; *(v4u*)(dst + 16) = u1; } }
    }
    __syncthreads();
    if (F.wave >= 1 && F.wave < 5) { const int ti = (F.wave - 1) >> 1, tj = (F.wave - 1) & 1, t = 32 * ti + r32;
        f32x16 acc = zero16();
#pragma unroll
        for (int ts = 0; ts < 2; ++ts)
#pragma unroll
            for (int s = 0; s < 2; ++s) { const float* tp = MTf + t * 68 + 32 * ts + 16 * s + 4 * hh; const f32x4 t0 = *(const f32x4*)tp, t1 = *(const f32x4*)(tp + 8);
                v4u pa; pa.x = cvtpk(t0.x, t0.y); pa.y = cvtpk(t0.z, t0.w); pa.z = cvtpk(t1.x, t1.y); pa.w = cvtpk(t1.z, t1.w);
                const bf16x8s Bx = ts ? pack8(x1b, s) : pack8(x1a, s);
                acc = MFMA32(__builtin_bit_cast(bf16x8s, pa), Bx, acc); }
        v4u u0, u1; u0.x = cvtpk(-acc[0], -acc[1]); u0.y = cvtpk(-acc[2], -acc[3]); u0.z = cvtpk(-acc[4], -acc[5]); u0.w = cvtpk(-acc[6], -acc[7]);
        u1.x = cvtpk(-acc[8], -acc[9]); u1.y = cvtpk(-acc[10], -acc[11]); u1.z = cvtpk(-acc[12], -acc[13]); u1.w = cvtpk(-acc[14], -acc[15]);
        unsigned char* dst = dob + DO_U + (size_t)uid * 8192 + ((ti * 2 + tj) * 64 + lane) * 32;
        *(v4u*)dst = u0; *(v4u*)(dst + 16) = u1;
    } else { const int idx = F.wave == 0 ? 3 : F.wave - 5, ti = idx >> 1, tj = idx & 1, t = 32 * ti + r32, j = 32 * tj + r32;
        f32x16 acc = zero16();
#pragma unroll
        for (int ks = 0; ks < 4; ++ks) { const float* tp = MTf + t * 68 + 16 * ks + 8 * hh; const f32x4 t0 = *(const f32x4*)tp, t1 = *(const f32x4*)(tp + 4);
            v4u pa; pa.x = cvtpk(t0.x, t0.y); pa.y = cvtpk(t0.z, t0.w); pa.z = cvtpk(t1.x, t1.y); pa.w = cvtpk(t1.z, t1.w);
            const bf16x8s B = *(const bf16x8s*)(L + KTT + j * 128 + (((2 * ks + hh) ^ ((j >> 1) & 7)) << 4));
            acc = MFMA32(__builtin_bit_cast(bf16x8s, pa), B, acc); }
        unsigned char* wm = dob + DO_WM + (size_t)uid * 8192; const int pj = pi_(j);
#pragma unroll
        for (int r = 0; r < 16; ++r) { const int tt = 32 * ti + crow(r, hh); *(bf16*)(wm + img128(tt, pj)) = (bf16)f2bf(-acc[r]); }
    }
    __syncthreads();
#undef SLOTR
}

constexpr int RSTG = 33280;
__device__ __forceinline__ void rwkv_load_stage(unsigned char* ws, unsigned char* dob, unsigned char* L, int b, int h, int n, int stg, int ltid) {
    unsigned char* colsb = ws + BIG_COLS;
    const int R0 = b * T + n * 64, uid = ((b * 64 + n) << 3) + h;
    v4u x[9];
#pragma unroll
    for (int i = 0; i < 9; ++i) { const int q = ltid + 256 * i; const unsigned char* src = dob + DO_WM + (size_t)uid * 8192;
        if (q < 512) src = dob + DO_WM + (size_t)uid * 8192 + q * 16;
        else if (q < 1024) { const int o = (q - 512) * 16; src = colsb + (size_t)(R0 + (o >> 7)) * (NCOLS * 2) + (2048 + h * 64) * 2 + (o & 127); }
        else if (q < 1536) src = dob + DO_BT + (size_t)uid * 8192 + (q - 1024) * 16;
        else if (q < 2048) src = dob + DO_ARB + (size_t)uid * 8192 + (q - 1536) * 16;
        else if (q < 2064) src = ws + RW_WC + (size_t)uid * 256 + (q - 2048) * 16;
        x[i] = *(const v4u*)src; }
#pragma unroll
    for (int i = 0; i < 9; ++i) { const int q = ltid + 256 * i; if (q < 2064) *(v4u*)(L + stg * RSTG + q * 16) = x[i]; }
}
__device__ __forceinline__ void rwkv_load_nat(unsigned char* ws, unsigned char* dob, int b, int h, int n, int vt, int lane, v4u (&nt)[6][2]) {
    const int uid = ((b * 64 + n) << 3) + h;
#pragma unroll
    for (int q = 0; q < 2; ++q) { const size_t o = (size_t)uid * 8192 + ((q * 2 + vt) * 64 + lane) * 32;
        nt[q][0] = *(const v4u*)(dob + DO_U + o); nt[q][1] = *(const v4u*)(dob + DO_U + o + 16);
        nt[2 + q][0] = *(const v4u*)(ws + RW_YL + o); nt[2 + q][1] = *(const v4u*)(ws + RW_YL + o + 16);
        nt[4 + q][0] = *(const v4u*)(ws + RW_DS + o); nt[4 + q][1] = *(const v4u*)(ws + RW_DS + o + 16); }
}
__device__ __forceinline__ f32x16 unpack16(const v4u x0, const v4u x1) { f32x16 v;
    v[0] = bf_lo(x0.x); v[1] = bf_hi(x0.x); v[2] = bf_lo(x0.y); v[3] = bf_hi(x0.y); v[4] = bf_lo(x0.z); v[5] = bf_hi(x0.z); v[6] = bf_lo(x0.w); v[7] = bf_hi(x0.w);
    v[8] = bf_lo(x1.x); v[9] = bf_hi(x1.x); v[10] = bf_lo(x1.y); v[11] = bf_hi(x1.y); v[12] = bf_lo(x1.z); v[13] = bf_hi(x1.z); v[14] = bf_lo(x1.w); v[15] = bf_hi(x1.w); return v; }
__device__ __forceinline__ void rwkv_post(const Args& a, const float* OBf, int b, int h, int n, int lw, int lane) {
    unsigned char* ws = a.ws; const int R0 = b * T + n * 64, hc = h * 64 + lane; const bf16* COLS = (const bf16*)(ws + BIG_COLS); bf16* A2 = (bf16*)(ws + WS_H);
    const float lnw = a.in[24][hc], lnb = a.in[25][hc];
    for (int tok = lw * 16; tok < lw * 16 + 16; ++tok) {
        const float y = OBf[tok * 64 + lane]; const float mean = wave_sum(y) * (1.0f / 64.0f); const float d = y - mean; const float var = wave_sum(d * d) * (1.0f / 64.0f);
        const float yn = d * (1.0f / sqrtf(var + 64e-5f)) * lnw + lnb;
        const size_t row = (size_t)(R0 + tok);
        const float g = bf2f(COLS[row * NCOLS + 2048 + 512 + hc]), bv = bf2f(COLS[row * NCOLS + 2048 + 1024 + hc]);
        A2[row * D + 512 + hc] = (bf16)f2bf((yn + bv) * g); }
}
__device__ __forceinline__ void rwkv_chain(const Args& a, Frame& F, int b, int h) {
    unsigned char* L = (unsigned char*)F.ldsf;
    constexpr int OB = 2 * RSTG;
    float* OBf = (float*)(L + OB);
    unsigned char* ws = a.ws; unsigned char* dob = (unsigned char*)a.out;
    int tid0 = F.tid; asm volatile("" : "+v"(tid0));
    const int lane = tid0 & 63, r32_ = lane & 31, hh_ = lane >> 5;
    const bool chain = F.wave < 2, loader = F.wave >= 4; const int vt = F.wave & 1;
    f32x16 Z[2]; Z[0] = zero16(); Z[1] = zero16();
    v4u nt[6][2];
    if (chain) rwkv_load_nat(ws, dob, b, h, 0, vt, lane, nt); else if (loader) rwkv_load_stage(ws, dob, L, b, h, 0, 0, tid0 - 256);
    __syncthreads();
    for (int n = 0; n < T / 64; ++n) {
        const int stg = n & 1;
        f32x16 Y[2];
        int r32 = r32_, hh = hh_, ltid = tid0 - 256; asm volatile("" : "+v"(r32), "+v"(hh), "+v"(ltid));
        if (chain) {
            const unsigned char* st = L + stg * RSTG; const float* wc = (const float*)(st + 32768);
            f32x16 P[2], dS[2];
            P[0] = unpack16(nt[0][0], nt[0][1]); P[1] = unpack16(nt[1][0], nt[1][1]); Y[0] = unpack16(nt[2][0], nt[2][1]); Y[1] = unpack16(nt[3][0], nt[3][1]);
            dS[0] = unpack16(nt[4][0], nt[4][1]); dS[1] = unpack16(nt[5][0], nt[5][1]);
            if (n + 1 < T / 64) rwkv_load_nat(ws, dob, b, h, n + 1, vt, lane, nt);
            bf16x8s Zb[2][2];
#pragma unroll
            for (int kt = 0; kt < 2; ++kt) { Zb[kt][0] = pack8(Z[kt], 0); Zb[kt][1] = pack8(Z[kt], 1); }
#pragma unroll
            for (int rb = 0; rb < 2; ++rb) { const int t = 32 * rb + r32;
#pragma unroll
                for (int kt = 0; kt < 2; ++kt)
#pragma unroll
                    for (int s = 0; s < 2; ++s) { const int off = t * 128 + (((4 * kt + 2 * s + hh) ^ ((t >> 1) & 7)) << 4);
                        const bf16x8s Aw = *(const bf16x8s*)(st + off), Ar = *(const bf16x8s*)(st + 8192 + off);
                        P[rb] = MFMA32(Aw, Zb[kt][s], P[rb]); Y[rb] = MFMA32(Ar, Zb[kt][s], Y[rb]); } }
            bf16x8s Pb[2][2];
#pragma unroll
            for (int rb = 0; rb < 2; ++rb) { Pb[rb][0] = pack8(P[rb], 0); Pb[rb][1] = pack8(P[rb], 1); }
#pragma unroll
            for (int rb = 0; rb < 2; ++rb) { const int t = 32 * rb + r32;
#pragma unroll
                for (int rb2 = 0; rb2 <= rb; ++rb2)
#pragma unroll
                    for (int s = 0; s < 2; ++s) { const bf16x8s Aa = *(const bf16x8s*)(st + 24576 + t * 128 + (((4 * rb2 + 2 * s + hh) ^ ((t >> 1) & 7)) << 4)); Y[rb] = MFMA32(Aa, Pb[rb2][s], Y[rb]); } }
#pragma unroll
            for (int kt = 0; kt < 2; ++kt) { const int k = 32 * kt + r32;
#pragma unroll
                for (int r = 0; r < 16; ++r) Z[kt][r] = Z[kt][r] * wc[32 * kt + crow(r, hh)] + dS[kt][r];
#pragma unroll
                for (int rb2 = 0; rb2 < 2; ++rb2)
#pragma unroll
                    for (int s = 0; s < 2; ++s) { const bf16x8s Ak = *(const bf16x8s*)(st + 16384 + k * 128 + (((4 * rb2 + 2 * s + hh) ^ ((k >> 1) & 7)) << 4)); Z[kt] = MFMA32(Ak, Pb[rb2][s], Z[kt]); } }
        } else if (loader) {
            if (n + 1 < T / 64) rwkv_load_stage(ws, dob, L, b, h, n + 1, stg ^ 1, ltid);
            if (n > 0) rwkv_post(a, OBf, b, h, n - 1, F.wave - 4, ltid & 63);
        }
        __syncthreads();
        if (chain) {
#pragma unroll
            for (int rb = 0; rb < 2; ++rb)
#pragma unroll
                for (int r = 0; r < 16; ++r) OBf[(32 * rb + crow(r, hh)) * 64 + 32 * vt + r32] = Y[rb][r];
        }
        __syncthreads();
    }
    if (loader) rwkv_post(a, OBf, b, h, T / 64 - 1, F.wave - 4, lane);
    __syncthreads();
}

__device__ __forceinline__ float gelu_tanh(float x) { const float u = 0.7978845608028654f * (x + 0.044715f * x * x * x); return 0.5f * x * (1.0f + tanhf(u)); }

__global__ void __launch_bounds__(NWAVES * 64, 2) fwd(Args args) {
    extern __shared__ __attribute__((aligned(16))) unsigned char lds[];
    Frame F;
    F.lds = (LAS unsigned char*)lds; F.ldsf = (float*)lds;
    F.MISC = (volatile LAS unsigned*)(F.lds + MISC_OFF);
    F.tid = threadIdx.x; F.lane = F.tid & 63; F.wave = __builtin_amdgcn_readfirstlane(F.tid >> 6);
    F.G = gridDim.x; { const int bx = blockIdx.x; F.vcu = (F.G % 8 == 0) ? (bx % 8) * (F.G / 8) + bx / 8 : bx; }
    F.ws = args.ws; F.out = args.out;
    F.ctl = (gu32*)(args.ws + WS_CTL);
    for (int u = F.tid; u < (LDS_BYTES - LDSCTL_OFF) / 4; u += NWAVES * 64) ((LAS unsigned*)(F.lds + LDSCTL_OFF))[u] = 0u;
    __syncthreads();
    XcdBarrier bar; bar.bar = (unsigned*)(F.ctl + CW_BAR); bar.x = 0; bar.st = nullptr;
    if (N_LAUNCHES != PER_PHASE) bar = xcd_barrier_post((unsigned*)(F.ctl + CW_BAR), F.MISC + 8);
#define GRID_BAR() do { if (N_LAUNCHES != PER_PHASE) xcd_barrier(bar); } while (0)
    const int lo = args.ph_lo, hi = args.ph_hi;
#ifndef PHMASK
#define PHMASK 0xFFFFFFFFu
#endif
#define IN(k) (((PHMASK >> (k)) & 1u) && lo <= (k) && (k) < hi)
#define BOTH(k) (IN(k) && IN((k) + 1))
    const int gw = F.vcu * NWAVES + F.wave, NGW = F.G * NWAVES;
    unsigned char* ws0 = args.ws;
#define PHASE_WS unsigned ws_lo_ = __builtin_amdgcn_readfirstlane((unsigned)(unsigned long long)ws0), ws_hi_ = __builtin_amdgcn_readfirstlane((unsigned)((unsigned long long)ws0 >> 32)); asm volatile("" : "+s"(ws_lo_), "+s"(ws_hi_)); unsigned char* ws = (unsigned char*)(((unsigned long long)ws_hi_ << 32) | ws_lo_)

    if (IN(0)) { PHASE_WS;
        float* scr = F.ldsf + F.wave * 4096;
        for (int it = gw; it < N_CONV_ITEMS0 + 384; it += NGW) { if (it < 384) adaln_item(args, it, scr, F.lane); else convert_item0(args, it - 384, scr, F.lane); }
        { bf16* LWt = (bf16*)(ws + RW_LW); for (int i = gw * 64 + F.lane; i < 8 * 64 * 256; i += NGW * 64) { const int ii = i & 255, j = (i >> 8) & 63, hh = i >> 14; const int col = hh * 64 + j;
            const float v = ii < 64 ? args.in[17][ii * 512 + col] : (ii < 128 ? args.in[19][(ii - 64) * 512 + col] : args.in[20][(ii - 128) * 512 + col]); LWt[i] = (bf16)f2bf(v); } }
        { float* WSP = (float*)(ws + WS_WSPEC); for (int i = gw * 64 + F.lane; i < 8 * D; i += NGW * 64) { const int c = i / D, k = i % D; WSP[i] = args.in[9][(size_t)k * WIN_LD + 2048 + c]; } }
        { float* SPL = (float*)(ws + WS_SPL); for (int i = gw * 64 + F.lane; i < D; i += NGW * 64) SPL[i] = -8.0f * softplusf_(-args.in[33][i]); }
        if (BOTH(0)) GRID_BAR();
    }
    if (IN(1)) { PHASE_WS;
        { float* MODS = (float*)(ws + WS_MODS); for (int i = gw * 64 + F.lane; i < 16 * 3072; i += NGW * 64) { const int n = i % 3072, cb = i / 3072; MODS[i] = mod_from_partials(args, cb >> 2, cb & 3, n); } }
        row_pass<0>(args, F, args.in[0], nullptr, 0, nullptr, 0, args.in[2]);
        if (BOTH(1)) GRID_BAR();
    }
    if (IN(2)) { PHASE_WS;
        pg8::Gemm g{(const bf16*)(ws + WS_H), (const bf16*)(ws + WB_IN), D, D, D, 0}; pg8::StaticOrder S; S.init(M, NCOLS, F.G, (int)blockIdx.x);
        pg8::EpiBf16Halo E{(bf16*)(ws + BIG_COLS), NCOLS, (bf16*)(ws + WS_HALO)};
        pg8::gemm_phase<pg8::EpiBf16Halo>(F.lds + RING_OFF, g, S, E);
        if (BOTH(2)) GRID_BAR();
    }
    if (IN(3)) { PHASE_WS;
        for (int u = F.vcu; u < 1024; u += F.G) gdn_prep_unit(args, F, u >> 8, (u >> 2) & 63, u & 3);
        for (int u = F.vcu; u < 2048; u += F.G) rwkv_prep_unit(args, F, u >> 9, (u >> 3) & 63, u & 7);
        GRID_BAR();
        for (int u = F.vcu; u < 48; u += F.G) { if (u < 16) gdn_chain(args, F, u >> 2, u & 3); else rwkv_chain(args, F, (u - 16) >> 3, (u - 16) & 7); }
        if (BOTH(3)) GRID_BAR();
    }
    if (IN(4)) { PHASE_WS;
        pg8::Gemm g{(const bf16*)(ws + WS_H), (const bf16*)(ws + WB_OUT), D, D, D, 0}; pg8::StaticOrder S; S.init(M, D, F.G, (int)blockIdx.x);
        pg8::EpiF32 E{(float*)(ws + BIG_Y0), D};
        pg8::gemm_phase<pg8::EpiF32>(F.lds + RING_OFF, g, S, E);
        if (BOTH(4)) GRID_BAR();
    }
    if (IN(5)) { PHASE_WS; row_pass<1>(args, F, args.in[0], (const float*)(ws + BIG_Y0), 0, args.in[3] + 0 * D, 1, args.in[2] + 1 * D); if (BOTH(5)) GRID_BAR(); }
    if (IN(6)) { PHASE_WS;
        pg8::Gemm g{(const bf16*)(ws + WS_H), (const bf16*)(ws + WB_GU0), D, D, D, 0}; pg8::StaticOrder S; S.init(M, 2 * FF, F.G, (int)blockIdx.x);
        pg8::EpiSwiGLU E{(bf16*)(ws + BIG_ACT), FF};
        pg8::gemm_phase<pg8::EpiSwiGLU>(F.lds + RING_OFF, g, S, E);
        if (BOTH(6)) GRID_BAR();
    }
    if (IN(7)) { PHASE_WS;
        pg8::Gemm g{(const bf16*)(ws + BIG_ACT), (const bf16*)(ws + WB_DN0), FF, FF, FF, 0}; pg8::StaticOrder S; S.init(M, D, F.G, (int)blockIdx.x);
        pg8::EpiF32 E{(float*)(ws + BIG_Y1), D};
        pg8::gemm_phase<pg8::EpiF32>(F.lds + RING_OFF, g, S, E);
        if (BOTH(7)) GRID_BAR();
    }
    if (IN(8)) { PHASE_WS; row_pass<1>(args, F, args.out, (const float*)(ws + BIG_Y1), 1, args.in[3] + 1 * D, 2, args.in[2] + 2 * D);
        __syncthreads(); { float* scr = F.ldsf + F.wave * 4096; for (int it = gw; it < N_CONV_ITEMS1; it += NGW) convert_item1(args, it, scr, F.lane); }
        if (BOTH(8)) GRID_BAR(); }
    if (IN(9)) { PHASE_WS;
        pg8::Gemm g{(const bf16*)(ws + WS_H), (const bf16*)(ws + WB_LIN), D, D, D, 0}; pg8::StaticOrder S; S.init(M, 2048, F.G, (int)blockIdx.x);
        pg8::EpiBf16 E{(bf16*)(ws + BIG_GX), 2048};
        pg8::gemm_phase<pg8::EpiBf16>(F.lds + RING_OFF, g, S, E);
        if (BOTH(9)) GRID_BAR();
    }
    if (IN(10)) { PHASE_WS;
        const bf16* GX = (const bf16*)(ws + BIG_GX); bf16* XC = (bf16*)(ws + BIG_XC); const float* cw = args.in[27]; const float* cb = args.in[28];
        for (int it = gw * 64 + F.lane; it < M * 128; it += NGW * 64) {
            const int row = it >> 7, c8 = (it & 127) * 8, t = row % T;
            float acc[8];
#pragma unroll
            for (int e = 0; e < 8; ++e) acc[e] = cb[c8 + e];
#pragma unroll
            for (int j = 0; j < 4; ++j) { if (t - 3 + j >= 0) { const v4u xw = *(const v4u*)(GX + (size_t)(row - 3 + j) * 2048 + 1024 + c8); const float* w = cw + j * 1024 + c8;
                acc[0] += w[0] * bf_lo(xw.x); acc[1] += w[1] * bf_hi(xw.x); acc[2] += w[2] * bf_lo(xw.y); acc[3] += w[3] * bf_hi(xw.y);
                acc[4] += w[4] * bf_lo(xw.z); acc[5] += w[5] * bf_hi(xw.z); acc[6] += w[6] * bf_lo(xw.w); acc[7] += w[7] * bf_hi(xw.w); } }
            v4u o; o.x = pk2(acc[0], acc[1]); o.y = pk2(acc[2], acc[3]); o.z = pk2(acc[4], acc[5]); o.w = pk2(acc[6], acc[7]);
            *(v4u*)(XC + (size_t)row * D + c8) = o;
        }
        if (BOTH(10)) GRID_BAR();
    }
    if (IN(11)) { PHASE_WS;
        pg8::Gemm g{(const bf16*)(ws + BIG_XC), (const bf16*)(ws + WB_LG), D, 256, 256, 256}; pg8::StaticOrder S; S.init(M, 2048, F.G, (int)blockIdx.x);
        pg8::EpiGates E{(float*)(ws + BIG_A), (bf16*)(ws + WS_H), (const bf16*)(ws + BIG_XC), args.in[30], args.in[32], (const float*)(ws + WS_SPL)};
        pg8::gemm_phase<pg8::EpiGates>(F.lds + RING_OFF, g, S, E);
        if (BOTH(11)) GRID_BAR();
    }
    if (IN(12)) { PHASE_WS;
        const float* Aa = (const float*)(ws + BIG_A); const bf16* U = (const bf16*)(ws + WS_H); float* CA = (float*)(ws + WS_CARRY); float* CH = CA + NB * 64 * D;
        for (int it = gw; it < NB * 64 * 16; it += NGW) { const int cg = it & 15, seg = (it >> 4) & 63, b = it >> 10, ch = cg * 64 + F.lane;
            float hh = 0.f, P = 1.f; const size_t base = (size_t)(b * T + seg * 64) * D + ch;
#pragma unroll 8
            for (int t = 0; t < 64; ++t) { const float av = Aa[base + (size_t)t * D], uv = bf2f(U[base + (size_t)t * D]); hh = av * hh + uv; P *= av; }
            CA[(b * 64 + seg) * D + ch] = P; CH[(b * 64 + seg) * D + ch] = hh; }
        if (BOTH(12)) GRID_BAR();
    }
    if (IN(13)) { PHASE_WS;
        const float* Aa = (const float*)(ws + BIG_A); const bf16* U = (const bf16*)(ws + WS_H); const float* CA = (const float*)(ws + WS_CARRY); const float* CH = CA + NB * 64 * D;
        const bf16* GX = (const bf16*)(ws + BIG_GX); bf16* Y2 = (bf16*)(ws + BIG_XC);
        for (int it = gw; it < NB * 64 * 16; it += NGW) { const int cg = it & 15, seg = (it >> 4) & 63, b = it >> 10, ch = cg * 64 + F.lane;
            float hh = 0.f;
            for (int s2 = 0; s2 < seg; ++s2) hh = CA[(b * 64 + s2) * D + ch] * hh + CH[(b * 64 + s2) * D + ch];
            const size_t base = (size_t)(b * T + seg * 64) * D + ch; const size_t gbase = (size_t)(b * T + seg * 64) * 2048 + ch;
#pragma unroll 8
            for (int t = 0; t < 64; ++t) { const float av = Aa[base + (size_t)t * D], uv = bf2f(U[base + (size_t)t * D]); hh = av * hh + uv;
                const float gt = bf2f(GX[gbase + (size_t)t * 2048]); Y2[base + (size_t)t * D] = (bf16)f2bf(hh * gelu_tanh(gt)); } }
        if (BOTH(13)) GRID_BAR();
    }
    if (IN(14)) { PHASE_WS;
        pg8::Gemm g{(const bf16*)(ws + BIG_XC), (const bf16*)(ws + WB_LOUT), D, D, D, 0}; pg8::StaticOrder S; S.init(M, D, F.G, (int)blockIdx.x);
        pg8::EpiF32 E{(float*)(ws + BIG_A), D};
        pg8::gemm_phase<pg8::EpiF32>(F.lds + RING_OFF, g, S, E);
        if (BOTH(14)) GRID_BAR();
    }
    if (IN(15)) { PHASE_WS; row_pass<1>(args, F, args.out, (const float*)(ws + BIG_A), 2, args.in[3] + 2 * D, 3, args.in[2] + 3 * D); if (BOTH(15)) GRID_BAR(); }
    if (IN(16)) { PHASE_WS;
        pg8::Gemm g{(const bf16*)(ws + WS_H), (const bf16*)(ws + WB_GU1), D, D, D, 0}; pg8::StaticOrder S; S.init(M, 2 * FF, F.G, (int)blockIdx.x);
        pg8::EpiSwiGLU E{(bf16*)(ws + BIG_ACT), FF};
        pg8::gemm_phase<pg8::EpiSwiGLU>(F.lds + RING_OFF, g, S, E);
        if (BOTH(16)) GRID_BAR();
    }
    if (IN(17)) { PHASE_WS;
        pg8::Gemm g{(const bf16*)(ws + BIG_ACT), (const bf16*)(ws + WB_DN1), FF, FF, FF, 0}; pg8::StaticOrder S; S.init(M, D, F.G, (int)blockIdx.x);
        pg8::EpiF32 E{(float*)(ws + BIG_Y1), D};
        pg8::gemm_phase<pg8::EpiF32>(F.lds + RING_OFF, g, S, E);
        if (BOTH(17)) GRID_BAR();
    }
    if (IN(18)) { PHASE_WS; row_pass<2>(args, F, args.out, (const float*)(ws + BIG_Y1), 3, args.in[3] + 3 * D, 0, nullptr); }
#undef IN
#undef BOTH
}

extern "C" void kernel_launch(void* const* d_in, const int* in_sizes, int n_in, void* d_out, int out_size, void* d_ws, size_t ws_size, hipStream_t stream) {
    static int grid = 0;
    if (grid == 0) {
        if (n_in != 35 || out_size != M * D || ws_size < WS_END) { fprintf(stderr, "kernel_launch: unexpected shapes n_in %d out %d ws %zu\n", n_in, out_size, ws_size); grid = -1; return; }
        int dev = 0, cus = 0;
        if (hipGetDevice(&dev) != hipSuccess || hipDeviceGetAttribute(&cus, hipDeviceAttributeMultiprocessorCount, dev) != hipSuccess) { grid = -1; return; }
        if (hipFuncSetAttribute((const void*)fwd, hipFuncAttributeMaxDynamicSharedMemorySize, LDS_BYTES) != hipSuccess) { grid = -1; return; }
        grid = cus;
    }
    if (grid < 0) return;
    (void)hipMemsetAsync((char*)d_ws + WS_CTL, 0, CTL_ZERO_BYTES, stream);
    Args a{};
    for (int i = 0; i < 35; ++i) a.in[i] = (const float*)d_in[i];
    a.out = (float*)d_out; a.ws = (unsigned char*)d_ws;
    constexpr int NPH = 19;
    if (N_LAUNCHES == PER_PHASE) {
        for (int p = 0; p < NPH; ++p) { a.ph_lo = p; a.ph_hi = p + 1; a.li = p; hipLaunchKernelGGL(fwd, dim3(grid), dim3(NWAVES * 64), LDS_BYTES, stream, a); }
    } else {
        a.ph_lo = 0; a.ph_hi = NPH; a.li = 0; hipLaunchKernelGGL(fwd, dim3(grid), dim3(NWAVES * 64), LDS_BYTES, stream, a);
    }
}
```

```cpp
#include <hip/hip_runtime.h>
#include <cstdio>
#include <cstdint>

#ifndef MK_N_LAUNCHES
#define MK_N_LAUNCHES 1
#endif

namespace pg8 {
#define PG8_LAS __attribute__((address_space(3)))
typedef unsigned short bf16_t;
typedef short bf16x8 __attribute__((ext_vector_type(8)));
typedef float f32x4 __attribute__((ext_vector_type(4)));
typedef unsigned u32x4 __attribute__((ext_vector_type(4)));
typedef unsigned u32x2 __attribute__((ext_vector_type(2)));
constexpr int BM = 256, BK = 64, HALF = 128, HTB = HALF * BK * 2, STAGE_BYTES = 8 * HTB, NXCD = 8, WGM = 8;

__host__ __device__ __forceinline__ int lds_byte(int r, int c) { const int st = (r >> 4) * 2 + (c >> 5), rr = r & 15, cc = c & 31, ob = rr * 64 + cc * 2; return st * 1024 + (ob ^ (((ob >> 9) & 1) << 5)); }
__host__ __device__ __forceinline__ void stage_rc(int b, int& R, int& C) { const int st = b / 1024, sb = b % 1024, swz = sb ^ (((sb >> 9) & 1) << 5); R = (st >> 1) * 16 + swz / 64; C = (st & 1) * 32 + (swz % 64) / 2; }
__host__ __device__ __forceinline__ int perm32(int rho) { const int n = rho >> 4, i = rho & 15; return 8 * (i >> 2) + 4 * n + (i & 3); }

struct Unit { int pm, pn; };
struct Gemm { const bf16_t* A; const bf16_t* Bt; int lda, ldb, K, acol_mul; };

struct StaticOrder {
    int nM, nN, nwg, G, c;
    __host__ __device__ void init(int M, int N, int G_, int c_) { nM = M / BM; nN = N / BM; nwg = nM * nN; G = G_; c = c_; }
    __host__ __device__ bool next(int i, Unit& u) const {
        const long L = (long)i * G + c; if (L >= nwg) return false;
        int wgid = (int)L; { const int q = nwg / NXCD, r = nwg % NXCD, xcd = wgid % NXCD, off = wgid / NXCD; wgid = (xcd < r ? xcd * (q + 1) : r * (q + 1) + (xcd - r) * q) + off; }
        const int nig = WGM * nN, gid = wgid / nig, fm = gid * WGM, gsz = (nM - fm) < WGM ? (nM - fm) : WGM;
        u.pm = fm + ((wgid % nig) % gsz); u.pn = (wgid % nig) / gsz; return true;
    }
};

typedef unsigned wtv4_t __attribute__((__vector_size__(16)));
__device__ __forceinline__ __amdgpu_buffer_rsrc_t wt_rs(const void* p) {
    const unsigned long long v = (unsigned long long)p; const unsigned lo = __builtin_amdgcn_readfirstlane((unsigned)v), hi = __builtin_amdgcn_readfirstlane((unsigned)(v >> 32));
    return __builtin_amdgcn_make_buffer_rsrc((void*)(((unsigned long long)hi << 32) | lo), 0, 0x7ffffff0, 0x00020000); }
__device__ __forceinline__ void st16_wt(__amdgpu_buffer_rsrc_t rs, unsigned byte_off, u32x4 v) { __builtin_amdgcn_raw_buffer_store_b128(__builtin_bit_cast(wtv4_t, v), rs, (int)byte_off, 0, 16); }
__device__ __forceinline__ unsigned cvt_pk_bf16(float lo, float hi) { unsigned r; asm volatile("v_cvt_pk_bf16_f32 %0, %1, %2" : "=v"(r) : "v"(lo), "v"(hi)); return r; }
__device__ __forceinline__ float bf_lo(unsigned w) { return __uint_as_float(w << 16); }
__device__ __forceinline__ float bf_hi(unsigned w) { return __uint_as_float(w & 0xffff0000u); }
__device__ __forceinline__ float rsq_(float x) { return __builtin_amdgcn_rsqf(x); }
__device__ __forceinline__ float sigmoidf_(float x) { return __builtin_amdgcn_rcpf(1.0f + __expf(-x)); }
__device__ __forceinline__ float siluf_(float x) { return x * __builtin_amdgcn_rcpf(1.0f + __expf(-x)); }
__device__ __forceinline__ float softplusf_(float x) { return fmaxf(x, 0.f) + log1pf(__expf(-fabsf(x))); }
__device__ __forceinline__ float softplus_fast(float x) { return fmaxf(x, 0.f) + __logf(1.0f + __expf(-fabsf(x))); }
__device__ __forceinline__ float tanh_fast(float x) { const float e = __expf(2.0f * fminf(fmaxf(x, -15.f), 15.f)); return (e - 1.0f) * __builtin_amdgcn_rcpf(e + 1.0f); }

struct EpiF32 {
    static constexpr bool PERM = false;
    float* C; int ldc;
    __device__ __forceinline__ void operator()(const f32x4 (&acc)[2][2][4][2], const Unit& u, int wr, int wc, int fr, int fq) const {
        const int row0 = u.pm * BM + wr * 64 + fr, col0 = u.pn * BM + wc * 32 + 4 * fq;
#pragma unroll
        for (int ai = 0; ai < 2; ++ai)
#pragma unroll
            for (int m = 0; m < 4; ++m) { float* rowp = C + (size_t)(row0 + ai * HALF + m * 16) * ldc + col0;
#pragma unroll
                for (int bj = 0; bj < 2; ++bj)
#pragma unroll
                    for (int n = 0; n < 2; ++n) *(f32x4*)(rowp + bj * HALF + n * 16) = acc[ai][bj][m][n]; }
    }
};
struct EpiBf16 {
    static constexpr bool PERM = true;
    bf16_t* O; int ldc;
    __device__ __forceinline__ void operator()(const f32x4 (&acc)[2][2][4][2], const Unit& u, int wr, int wc, int fr, int fq) const {
        const int row0 = u.pm * BM + wr * 64 + fr, col0 = u.pn * BM + wc * 32 + 8 * fq;
        const __amdgpu_buffer_rsrc_t rs = wt_rs(O);
#pragma unroll
        for (int ai = 0; ai < 2; ++ai)
#pragma unroll
            for (int m = 0; m < 4; ++m) { const unsigned ro = ((unsigned)(row0 + ai * HALF + m * 16) * (unsigned)ldc + (unsigned)col0) * 2u;
#pragma unroll
                for (int bj = 0; bj < 2; ++bj) { const f32x4 v0 = acc[ai][bj][m][0], v1 = acc[ai][bj][m][1];
                    u32x4 w; w.x = cvt_pk_bf16(v0[0], v0[1]); w.y = cvt_pk_bf16(v0[2], v0[3]); w.z = cvt_pk_bf16(v1[0], v1[1]); w.w = cvt_pk_bf16(v1[2], v1[3]);
                    st16_wt(rs, ro + bj * HALF * 2, w); } }
    }
};
struct EpiBf16Halo {
    static constexpr bool PERM = true;
    bf16_t* O; int ldc; bf16_t* Hl;
    __device__ __forceinline__ void operator()(const f32x4 (&acc)[2][2][4][2], const Unit& u, int wr, int wc, int fr, int fq) const {
        const int row0 = u.pm * BM + wr * 64 + fr, col0 = u.pn * BM + wc * 32 + 8 * fq;
        const bool zt = (u.pn == 6 || u.pn == 7);
#pragma unroll
        for (int ai = 0; ai < 2; ++ai)
#pragma unroll
            for (int m = 0; m < 4; ++m) { const int row = row0 + ai * HALF + m * 16; bf16_t* rowp = O + (size_t)row * ldc + col0;
#pragma unroll
                for (int bj = 0; bj < 2; ++bj) { f32x4 v0 = acc[ai][bj][m][0], v1 = acc[ai][bj][m][1];
                    if (zt) {
#pragma unroll
                        for (int e = 0; e < 4; ++e) { v0[e] = siluf_(v0[e]); v1[e] = siluf_(v1[e]); } }
                    u32x4 w; w.x = cvt_pk_bf16(v0[0], v0[1]); w.y = cvt_pk_bf16(v0[2], v0[3]); w.z = cvt_pk_bf16(v1[0], v1[1]); w.w = cvt_pk_bf16(v1[2], v1[3]);
                    *(u32x4*)(rowp + bj * HALF) = w;
                    if (m == 3 && fr >= 13) *(u32x4*)(Hl + ((size_t)(row >> 6) * 3 + (fr - 13)) * ldc + col0 + bj * HALF) = w; } }
    }
};
struct EpiSwiGLU {
    static constexpr bool PERM = true;
    bf16_t* O; int ldc;
    __device__ __forceinline__ void operator()(const f32x4 (&acc)[2][2][4][2], const Unit& u, int wr, int wc, int fr, int fq) const {
        const int row0 = u.pm * BM + wr * 64 + fr, col0 = u.pn * HALF + wc * 32 + 8 * fq;
#pragma unroll
        for (int ai = 0; ai < 2; ++ai)
#pragma unroll
            for (int m = 0; m < 4; ++m) { bf16_t* rowp = O + (size_t)(row0 + ai * HALF + m * 16) * ldc + col0;
                float o[8];
#pragma unroll
                for (int n = 0; n < 2; ++n)
#pragma unroll
                    for (int j = 0; j < 4; ++j) { const float g = acc[ai][0][m][n][j], up = acc[ai][1][m][n][j]; o[n * 4 + j] = siluf_(g) * up; }
                u32x4 w; w.x = cvt_pk_bf16(o[0], o[1]); w.y = cvt_pk_bf16(o[2], o[3]); w.z = cvt_pk_bf16(o[4], o[5]); w.w = cvt_pk_bf16(o[6], o[7]);
                *(u32x4*)rowp = w; }
    }
};
template <int CTRL> __device__ __forceinline__ float dpp_f(float x) { return __int_as_float(__builtin_amdgcn_update_dpp(0, __float_as_int(x), CTRL, 0xF, 0xF, true)); }
__device__ __forceinline__ float row16_scan(float x) { x += dpp_f<0x111>(x); x += dpp_f<0x112>(x); x += dpp_f<0x114>(x); x += dpp_f<0x118>(x); return x; }
__device__ __forceinline__ float row16_sum(float x) { x += dpp_f<0xB1>(x); x += dpp_f<0x4E>(x); x += dpp_f<0x141>(x); x += dpp_f<0x140>(x); return x; }
struct EpiGates {
    static constexpr bool PERM = true, AFTER_DRAIN = false;
    bf16_t* Aout; bf16_t* Uout; const bf16_t* XC; const float* ba; const float* bx; const float* lam; float* CA; float* CH;
    __device__ __forceinline__ void operator()(const f32x4 (&acc)[2][2][4][2], const Unit& u, int wr, int wc, int fr, int fq) const {
        const int ch0 = u.pn * HALF + wc * 32 + 8 * fq;
        const unsigned eo0 = (unsigned)(u.pm * BM + wr * 64 + fr) * 1024u + (unsigned)ch0;
        f32x4 bav[2], bxv[2], spl[2];
#pragma unroll
        for (int n = 0; n < 2; ++n) { bav[n] = *(const f32x4*)(ba + ch0 + 4 * n); bxv[n] = *(const f32x4*)(bx + ch0 + 4 * n); spl[n] = *(const f32x4*)(lam + ch0 + 4 * n); }
#pragma unroll
        for (int ai = 0; ai < 2; ++ai) {
            float lm[4][8], um[4][8];
#pragma unroll
            for (int m = 0; m < 4; ++m) { const unsigned eo = eo0 + (unsigned)((ai * HALF + m * 16) * 1024);
                const u32x4 xw = *(const u32x4*)((const char*)XC + (size_t)(eo * 2u));
                const float xv[8] = {bf_lo(xw.x), bf_hi(xw.x), bf_lo(xw.y), bf_hi(xw.y), bf_lo(xw.z), bf_hi(xw.z), bf_lo(xw.w), bf_hi(xw.w)};
                float uv[8], lav[8];
#pragma unroll
                for (int n = 0; n < 2; ++n) {
#pragma unroll
                    for (int j = 0; j < 4; ++j) { const float r = sigmoidf_(acc[ai][0][m][n][j] + bav[n][j]), ig = sigmoidf_(acc[ai][1][m][n][j] + bxv[n][j]);
                        const float la = spl[n][j] * r, t = 2.0f * la; lav[n * 4 + j] = la;
                        const float om = (t > -0.3f) ? -t * (1.0f + t * (0.5f + t * (0.16666667f + t * (0.041666668f + t * (0.0083333333f + t * 0.0013888889f))))) : 1.0f - __expf(t);
                        uv[n * 4 + j] = xv[n * 4 + j] * ig * __builtin_amdgcn_sqrtf(fmaxf(om, 0.f)); } }
                u32x4 wl; wl.x = cvt_pk_bf16(lav[0], lav[1]); wl.y = cvt_pk_bf16(lav[2], lav[3]); wl.z = cvt_pk_bf16(lav[4], lav[5]); wl.w = cvt_pk_bf16(lav[6], lav[7]);
                *(u32x4*)((char*)Aout + (size_t)(eo * 2u)) = wl;
                u32x4 w; w.x = cvt_pk_bf16(uv[0], uv[1]); w.y = cvt_pk_bf16(uv[2], uv[3]); w.z = cvt_pk_bf16(uv[4], uv[5]); w.w = cvt_pk_bf16(uv[6], uv[7]);
                *(u32x4*)((char*)Uout + (size_t)(eo * 2u)) = w;
                lm[m][0] = bf_lo(wl.x); lm[m][1] = bf_hi(wl.x); lm[m][2] = bf_lo(wl.y); lm[m][3] = bf_hi(wl.y); lm[m][4] = bf_lo(wl.z); lm[m][5] = bf_hi(wl.z); lm[m][6] = bf_lo(wl.w); lm[m][7] = bf_hi(wl.w);
                um[m][0] = bf_lo(w.x); um[m][1] = bf_hi(w.x); um[m][2] = bf_lo(w.y); um[m][3] = bf_hi(w.y); um[m][4] = bf_lo(w.z); um[m][5] = bf_hi(w.z); um[m][6] = bf_lo(w.w); um[m][7] = bf_hi(w.w);
                asm volatile("" ::: "memory"); }
            float cav[8], chv[8];
#pragma unroll
            for (int c = 0; c < 8; ++c) {
                float off = 0.f, L[4];
#pragma unroll
                for (int m = 0; m < 4; ++m) { L[m] = row16_scan(lm[m][c]) + off; off += row16_sum(lm[m][c]); }
                float hsum = 0.f;
#pragma unroll
                for (int m = 0; m < 4; ++m) hsum += um[m][c] * __expf(off - L[m]);
                chv[c] = row16_sum(hsum); cav[c] = __expf(off); }
            if (fr == 0) { const size_t o = (size_t)((u.pm >> 4) * 64 + (u.pm & 15) * 4 + 2 * ai + wr) * 1024 + ch0;
                *(f32x4*)(CA + o) = (f32x4){cav[0], cav[1], cav[2], cav[3]}; *(f32x4*)(CA + o + 4) = (f32x4){cav[4], cav[5], cav[6], cav[7]};
                *(f32x4*)(CH + o) = (f32x4){chv[0], chv[1], chv[2], chv[3]}; *(f32x4*)(CH + o + 4) = (f32x4){chv[4], chv[5], chv[6], chv[7]}; }
        }
    }
};

template <class Epi, bool ALIGN_EPI = true>
__device__ __forceinline__ void gemm_phase(PG8_LAS unsigned char* lds, const Gemm g, const StaticOrder& S, const Epi& E) {
    const int tid = threadIdx.x, wid = __builtin_amdgcn_readfirstlane(tid >> 6), lane = tid & 63, wr = wid >> 2, wc = wid & 3, fr = lane & 15, fq = lane >> 4;
    const int K = g.K, nt = K / BK;
    unsigned voffA[2], voffB[2];
#pragma unroll
    for (int i = 0; i < 2; ++i) { int R, C; stage_rc(tid * 16 + i * 8192, R, C); const int Rb = Epi::PERM ? ((R & ~31) + perm32(R & 31)) : R;
        voffA[i] = (unsigned)(R * g.lda + C) * 2u; voffB[i] = (unsigned)(Rb * g.ldb + C) * 2u; }
    const size_t kstep = (size_t)(BK * 2);
    const size_t hstepA = (size_t)HALF * g.lda * 2, hstepB = (size_t)HALF * g.ldb * 2;
    const size_t tstepA = 2 * hstepA, tstepB = 2 * hstepB;
    const unsigned ldsw = (unsigned)wid * 1024u;
    const int aoff = lds_byte(wr * 64 + fr, fq * 8), boff = lds_byte(wc * 32 + fr, fq * 8);
#define PG8_SA(b, h) (((b) * 2 + (h)) * HTB)
#define PG8_SB(b, h) ((4 + (b) * 2 + (h)) * HTB)
#define PG8_STAGE(bufoff, gbase, voff) do { _Pragma("unroll") for (int _i = 0; _i < 2; ++_i) \
        __builtin_amdgcn_global_load_lds((const unsigned*)((const char*)(gbase) + (voff)[_i]), (PG8_LAS unsigned*)(lds + (bufoff) + ldsw + _i * 8192), 16, 0, 0); } while (0)
#define PG8_LDA(dst, b, h) do { _Pragma("unroll") for (int m = 0; m < 4; ++m) _Pragma("unroll") for (int k = 0; k < 2; ++k) dst[m][k] = *(const PG8_LAS bf16x8*)(lds + PG8_SA(b, h) + aoff + m * 2048 + k * 1024); } while (0)
#define PG8_LDB(dst, b, h) do { _Pragma("unroll") for (int n = 0; n < 2; ++n) _Pragma("unroll") for (int k = 0; k < 2; ++k) dst[n][k] = *(const PG8_LAS bf16x8*)(lds + PG8_SB(b, h) + boff + n * 2048 + k * 1024); } while (0)
#define PG8_MMA(ai, bj, At, Bt) do { __builtin_amdgcn_s_setprio(1); _Pragma("unroll") for (int m = 0; m < 4; ++m) _Pragma("unroll") for (int n = 0; n < 2; ++n) _Pragma("unroll") for (int k = 0; k < 2; ++k) \
        acc[ai][bj][m][n] = __builtin_amdgcn_mfma_f32_16x16x32_bf16(Bt[n][k], At[m][k], acc[ai][bj][m][n], 0, 0, 0); __builtin_amdgcn_s_setprio(0); } while (0)
#define PG8_WAIT_V(n) asm volatile("s_waitcnt vmcnt(" #n ")" ::: "memory")
#define PG8_WAIT_L(n) asm volatile("s_waitcnt lgkmcnt(" #n ")" ::: "memory")
#define PG8_BAR __builtin_amdgcn_s_barrier()
#define PG8_SCHED __builtin_amdgcn_sched_barrier(0)
    Unit cur, nxt; int ui = 0;
    if (!S.next(0, cur)) return;
    f32x4 acc[2][2][4][2];
#pragma unroll
    for (int a = 0; a < 2; ++a)
#pragma unroll
        for (int b = 0; b < 2; ++b)
#pragma unroll
            for (int m = 0; m < 4; ++m)
#pragma unroll
                for (int n = 0; n < 2; ++n) acc[a][b][m][n] = (f32x4){0.f, 0.f, 0.f, 0.f};
    bf16x8 At[4][2], B0[2][2], B1[2][2];
    const char* cA = (const char*)g.A + (size_t)cur.pm * tstepA + (size_t)((cur.pn >> 1) * g.acol_mul) * 2; const char* cB = (const char*)g.Bt + (size_t)cur.pn * tstepB;
    PG8_STAGE(PG8_SB(0, 0), cB, voffB); PG8_STAGE(PG8_SB(0, 1), cB + hstepB, voffB); PG8_STAGE(PG8_SA(0, 0), cA, voffA); PG8_STAGE(PG8_SA(0, 1), cA + hstepA, voffA);
    if (wr == 1) PG8_BAR;
    PG8_WAIT_V(2); PG8_BAR;
    PG8_STAGE(PG8_SB(1, 0), cB + kstep, voffB); PG8_STAGE(PG8_SA(1, 0), cA + kstep, voffA); PG8_STAGE(PG8_SB(1, 1), cB + hstepB + kstep, voffB);
    PG8_WAIT_V(6); PG8_BAR;
    for (;;) {
        const bool has_next = S.next(ui + 1, nxt);
        const char* nA = has_next ? (const char*)g.A + (size_t)nxt.pm * tstepA + (size_t)((nxt.pn >> 1) * g.acol_mul) * 2 : cA; const char* nB = has_next ? (const char*)g.Bt + (size_t)nxt.pn * tstepB : cB;
#pragma nounroll
        for (int t = 0; t < nt; t += 2) {
            const bool last = (t == nt - 2);
            const char* a1 = cA + (size_t)(t + 1) * kstep;
            const char* a2 = last ? nA : cA + (size_t)(t + 2) * kstep; const char* b2 = last ? nB : cB + (size_t)(t + 2) * kstep;
            const char* a3 = a2 + kstep; const char* b3 = b2 + kstep;
            PG8_LDB(B0, 0, 0); PG8_LDB(B1, 0, 1); PG8_SCHED; PG8_LDA(At, 0, 0); PG8_STAGE(PG8_SA(1, 1), a1 + hstepA, voffA);
            PG8_WAIT_V(8); PG8_WAIT_L(0); PG8_BAR; PG8_MMA(0, 0, At, B0); PG8_MMA(0, 1, At, B1); PG8_BAR; PG8_SCHED;
            PG8_LDA(At, 0, 1); PG8_STAGE(PG8_SB(0, 0), b2, voffB); PG8_STAGE(PG8_SB(0, 1), b2 + hstepB, voffB); PG8_STAGE(PG8_SA(0, 0), a2, voffA);
            PG8_WAIT_V(8); PG8_WAIT_L(0); PG8_BAR; PG8_MMA(1, 0, At, B0); PG8_MMA(1, 1, At, B1); PG8_BAR; PG8_SCHED;
            PG8_LDB(B0, 1, 0); PG8_LDB(B1, 1, 1); PG8_SCHED; PG8_LDA(At, 1, 0); PG8_STAGE(PG8_SA(0, 1), a2 + hstepA, voffA);
            PG8_WAIT_V(8); PG8_WAIT_L(0); PG8_BAR; PG8_MMA(0, 0, At, B0); PG8_MMA(0, 1, At, B1); PG8_BAR; PG8_SCHED;
            PG8_LDA(At, 1, 1); PG8_STAGE(PG8_SB(1, 0), b3, voffB); PG8_STAGE(PG8_SB(1, 1), b3 + hstepB, voffB); PG8_STAGE(PG8_SA(1, 0), a3, voffA);
            PG8_WAIT_V(8); PG8_WAIT_L(0); PG8_BAR; PG8_MMA(1, 0, At, B0); PG8_MMA(1, 1, At, B1); PG8_BAR; PG8_SCHED;
        }
        if constexpr (ALIGN_EPI) { if (wr == 0) PG8_BAR; }
        E(acc, cur, wr, wc, fr, fq);
        if (!has_next) break;
#pragma unroll
        for (int a = 0; a < 2; ++a)
#pragma unroll
            for (int b = 0; b < 2; ++b)
#pragma unroll
                for (int m = 0; m < 4; ++m)
#pragma unroll
                    for (int n = 0; n < 2; ++n) acc[a][b][m][n] = (f32x4){0.f, 0.f, 0.f, 0.f};
        cur = nxt; cA = nA; cB = nB; ++ui;
        if constexpr (ALIGN_EPI) { if (wr == 1) PG8_BAR; }
    }
    PG8_WAIT_V(0);
    if constexpr (!ALIGN_EPI) { if (wr == 0) PG8_BAR; }
    PG8_BAR;
#undef PG8_SA
#undef PG8_SB
#undef PG8_STAGE
#undef PG8_LDA
#undef PG8_LDB
#undef PG8_MMA
#undef PG8_WAIT_V
#undef PG8_WAIT_L
#undef PG8_BAR
#undef PG8_SCHED
}
}

using pg8::bf_lo; using pg8::bf_hi; using pg8::cvt_pk_bf16; using pg8::sigmoidf_; using pg8::rsq_; using pg8::siluf_; using pg8::softplusf_; using pg8::softplus_fast; using pg8::tanh_fast;

constexpr int NWAVES = 8;
constexpr int N_LAUNCHES = MK_N_LAUNCHES;
constexpr int PER_PHASE = 18;
constexpr int NB = 4, T = 4096, D = 1024, M = NB * T, FF = 2816;
constexpr int NCOLS = 3840;
constexpr int WIN_LD = 3848;
constexpr float EPS = 1e-6f;

constexpr size_t MiB = 1u << 20;
constexpr size_t WS_CTL = 0, CTL_ZERO_BYTES = 64 * 1024;
constexpr size_t WS_MODS = 256 * 1024;
constexpr size_t WS_WSPEC = 512 * 1024;
constexpr size_t WS_SPL = 576 * 1024;
constexpr size_t WS_CARRY = 1 * MiB;
constexpr size_t WS_MODP = 3 * MiB;
constexpr int NKC = 16;
constexpr size_t WS_GB = 6 * MiB;
constexpr size_t WS_W = 8 * MiB;
constexpr size_t WB_IN = WS_W;
constexpr size_t WB_OUT = WB_IN + (size_t)NCOLS * D * 2;
constexpr size_t WB_GU0 = WB_OUT + (size_t)D * D * 2;
constexpr size_t WB_DN0 = WB_GU0 + (size_t)2 * FF * D * 2;
constexpr size_t WB_GU1 = WB_DN0 + (size_t)D * FF * 2;
constexpr size_t WB_DN1 = WB_GU1 + (size_t)2 * FF * D * 2;
constexpr size_t WB_LIN = WB_DN1 + (size_t)D * FF * 2;
constexpr size_t WB_LG = WB_LIN + (size_t)2048 * D * 2;
constexpr size_t WB_LOUT = WB_LG + (size_t)2048 * 256 * 2;
constexpr size_t WB_END = WB_LOUT + (size_t)D * D * 2;
constexpr size_t WS_H = 58 * MiB;
constexpr size_t WS_BIG = 90 * MiB;
constexpr size_t WS_END = 256 * MiB;
static_assert(WB_END <= WS_H, "weights fit");
static_assert(WS_BIG + (size_t)M * NCOLS * 2 <= WS_END, "cols fit");
constexpr size_t BIG_COLS = WS_BIG;
constexpr size_t BIG_Y0 = WS_BIG;
constexpr size_t BIG_ACT = WS_BIG;
constexpr size_t BIG_Y1 = WS_BIG + 88 * MiB;
constexpr size_t BIG_GX = WS_BIG;
constexpr size_t BIG_XC = WS_BIG + 64 * MiB;
constexpr size_t BIG_A = WS_BIG + 96 * MiB;
static_assert(BIG_A + (size_t)M * D * 4 <= WS_END, "lru buffers fit");

constexpr int CW_TMO = 0;
constexpr int CW_BAR = 1024;
constexpr int RING_OFF = 0, RING_BYTES = 131072;
constexpr int LDSCTL_OFF = 150528, MISC_OFF = LDSCTL_OFF + 320;
constexpr int LDS_BYTES = 158720;
constexpr size_t GDN_WP = 34 * MiB;
constexpr size_t WS_HALO = 50 * MiB;
constexpr size_t RW_YL = 210 * MiB;
constexpr size_t GDN_ATT = 226 * MiB;
constexpr size_t RW_DS = 234 * MiB;
constexpr size_t GDN_GL = 250 * MiB;
constexpr size_t RW_WC = 251 * MiB;
constexpr size_t WS_XR = 218 * MiB;
constexpr size_t RW_LW = 7 * MiB;
constexpr size_t DO_WM = 0, DO_BT = 16 * MiB, DO_ARB = 32 * MiB, DO_U = 48 * MiB;

#define GAS __attribute__((address_space(1)))
#define LAS __attribute__((address_space(3)))
typedef unsigned short bf16;
typedef unsigned v4u __attribute__((ext_vector_type(4)));
typedef unsigned v2u __attribute__((ext_vector_type(2)));
typedef float f32x4 __attribute__((ext_vector_type(4)));
typedef GAS unsigned gu32;
#define RLX_AGENT __ATOMIC_RELAXED, __HIP_MEMORY_SCOPE_AGENT
#define LDS_WAIT() asm volatile("s_waitcnt lgkmcnt(0)" ::: "memory")
#define VM_WAIT() asm volatile("s_waitcnt vmcnt(0)" ::: "memory")
__device__ __forceinline__ unsigned f2bf(float f) { unsigned u = __builtin_bit_cast(unsigned, f); return (u + 0x7fffu + ((u >> 16) & 1u)) >> 16; }
__device__ __forceinline__ unsigned pk2(float lo, float hi) { typedef float f2_t __attribute__((ext_vector_type(2))); typedef __bf16 b2_t __attribute__((ext_vector_type(2))); const f2_t v = {lo, hi}; return __builtin_bit_cast(unsigned, __builtin_convertvector(v, b2_t)); }
__device__ __forceinline__ float bf2f(bf16 v) { return __uint_as_float(((unsigned)v) << 16); }

#define XB_TMO      128
#define XB_XCNT(j)  (256  + 64 * (j))
#define XB_XSUB(j)  (1280 + 64 * (j))
#define XB_XGEN(j)  (2304 + 64 * (j))
#define XB_TOP      3328
#define XB_TOPGEN   3392
#define XCD_BAR_WORDS 3456
#define XB_SPIN_CAP (1u << 22)
__device__ __forceinline__ unsigned xb_ld(unsigned* p)              { return __hip_atomic_load(p, __ATOMIC_RELAXED, __HIP_MEMORY_SCOPE_AGENT); }
__device__ __forceinline__ unsigned xb_add(unsigned* p, unsigned v) { return __hip_atomic_fetch_add(p, v, __ATOMIC_RELAXED, __HIP_MEMORY_SCOPE_AGENT); }
__device__ __forceinline__ unsigned xb_xcc_id() { return (unsigned)__builtin_amdgcn_s_getreg((3 << 11) | 20) & 0xFu; }
#define XB_SPIN(cond, bar) do { unsigned _sp = 0; while (cond) { __builtin_amdgcn_s_sleep(1); \
    if ((++_sp & 255u) == 0u) { if (xb_ld(&(bar)[XB_TMO])) break; if (_sp > XB_SPIN_CAP) { atomicAdd(&(bar)[XB_TMO], 1u); break; } } } } while (0)
struct XcdBarrier { unsigned* bar; unsigned x; volatile LAS unsigned* st; };
__device__ __forceinline__ XcdBarrier xcd_barrier_post(unsigned* bar, volatile LAS unsigned* st) {
    XcdBarrier b; b.bar = bar; b.x = xb_xcc_id(); b.st = st;
    if (threadIdx.x == 0) (void)xb_add(&bar[XB_XCNT(b.x)], 1u);
    return b;
}
__device__ __forceinline__ void xcd_barrier_complete(unsigned* bar, unsigned x, unsigned& nloc, unsigned& nx) {
    const unsigned G = gridDim.x * gridDim.y * gridDim.z;
    unsigned sum, cnt, mine, sp = 0u;
    for (;;) {
        sum = 0u; cnt = 0u; mine = 0u;
#pragma unroll
        for (unsigned j = 0; j < 16; ++j) { const unsigned c = xb_ld(&bar[XB_XCNT(j)]); sum += c; cnt += (c > 0u) ? 1u : 0u; mine = (j == x) ? c : mine; }
        if (sum == G) break;
        __builtin_amdgcn_s_sleep(1);
        if ((++sp & 255u) == 0u) { if (xb_ld(&bar[XB_TMO])) break; if (sp > XB_SPIN_CAP) { atomicAdd(&bar[XB_TMO], 1u); break; } }
    }
    nloc = mine > 0u ? mine : 1u; nx = cnt > 0u ? cnt : 1u;
}
__device__ __forceinline__ void xcd_barrier(const XcdBarrier& b) {
    asm volatile("s_waitcnt vmcnt(0)" ::: "memory");
    __syncthreads();
    if (threadIdx.x == 0) {
        unsigned* bar = b.bar;
        __builtin_amdgcn_s_waitcnt(0);
        unsigned nloc = b.st[0], nx = b.st[1];
        if (nloc == 0u) { xcd_barrier_complete(bar, b.x, nloc, nx); b.st[0] = nloc; b.st[1] = nx; }
        const unsigned old = xb_add(&bar[XB_XSUB(b.x)], 1u);
        const unsigned gen = old / nloc;
        if (old + 1u == (gen + 1u) * nloc) {
            __builtin_amdgcn_fence(__ATOMIC_RELEASE, "agent");
            asm volatile("s_waitcnt vmcnt(0)" ::: "memory");
            const unsigned og = xb_add(&bar[XB_TOP], 1u);
            const unsigned tg = og / nx;
            if (og + 1u == (tg + 1u) * nx) xb_add(&bar[XB_TOPGEN], 1u);
            else XB_SPIN(xb_ld(&bar[XB_TOPGEN]) == tg, bar);
            __builtin_amdgcn_fence(__ATOMIC_ACQUIRE, "agent");
            asm volatile("s_waitcnt vmcnt(0)" ::: "memory");
        } else {
            XB_SPIN(xb_ld(&bar[XB_TOPGEN]) == gen, bar);
            __builtin_amdgcn_fence(__ATOMIC_ACQUIRE, "agent");
            asm volatile("s_waitcnt vmcnt(0)" ::: "memory");
        }
    }
    __syncthreads();
}

struct Frame {
    LAS unsigned char* lds;
    float* ldsf;
    volatile LAS unsigned* MISC;
    gu32* ctl;
    int tid, lane, wave;
    int vcu, G;
    const float* const* in;
    unsigned char* ws;
    float* out;
};
struct Args { const float* in[35]; float* out; unsigned char* ws; int ph_lo, ph_hi, li, pad; };

template <int CTRL, int ROWMASK = 0xF> __device__ __forceinline__ float dppg(float x) { return __int_as_float(__builtin_amdgcn_update_dpp(0, __float_as_int(x), CTRL, ROWMASK, 0xF, true)); }
__device__ __forceinline__ float quad_sum(float x) { x += dppg<0xB1>(x); x += dppg<0x4E>(x); return x; }
__device__ __forceinline__ float oct_sum(float x) { x = quad_sum(x); x += dppg<0x141>(x); return x; }
__device__ __forceinline__ float hex_sum(float x) { x = oct_sum(x); x += dppg<0x140>(x); return x; }
__device__ __forceinline__ float wave_sum(float v) {
    v = hex_sum(v); v += dppg<0x142, 0xA>(v); v += dppg<0x143, 0xC>(v);
    return __int_as_float(__builtin_amdgcn_readlane(__float_as_int(v), 63));
}
__device__ __forceinline__ float wave_scan(float x) {
    x += dppg<0x111>(x); x += dppg<0x112>(x); x += dppg<0x114>(x); x += dppg<0x118>(x);
    x += dppg<0x142, 0xA>(x); x += dppg<0x143, 0xC>(x);
    return x;
}

__device__ __forceinline__ void transpose_tile(const float* W, int ld, bf16* WT, int Kdst, float* scr, int lane, const float* ks = nullptr) {
    const float* Wl = W + (size_t)(lane >> 5) * ld + (lane & 31);
#pragma unroll
    for (int hb = 0; hb < 2; ++hb) { float tv[16];
#pragma unroll
        for (int i = 0; i < 16; ++i) tv[i] = Wl[(size_t)(2 * (16 * hb + i)) * ld];
        if (ks) {
#pragma unroll
            for (int i = 0; i < 16; ++i) tv[i] *= ks[2 * (16 * hb + i) + (lane >> 5)]; }
#pragma unroll
        for (int i = 0; i < 16; ++i) scr[(2 * (16 * hb + i) + (lane >> 5)) * 33 + (lane & 31)] = tv[i];
        asm volatile("" ::: "memory"); }
    LDS_WAIT(); asm volatile("" ::: "memory");
    const int c = lane & 7;
#pragma unroll
    for (int j = 0; j < 4; ++j) { const int n = (lane >> 3) + 8 * j; const float* s = scr + (8 * c) * 33 + n;
        v4u o; o.x = pk2(s[0 * 33], s[1 * 33]); o.y = pk2(s[2 * 33], s[3 * 33]); o.z = pk2(s[4 * 33], s[5 * 33]); o.w = pk2(s[6 * 33], s[7 * 33]);
        *(v4u*)(WT + (size_t)n * Kdst + 8 * c) = o; }
    LDS_WAIT(); asm volatile("" ::: "memory");
}

__device__ __forceinline__ void convert_item0(const Args& a, int it, float* scr, int lane) {
    unsigned char* ws = a.ws;
    if (it < 1024) { const int kb = it / 64, nb = it % 64; transpose_tile(a.in[9] + (size_t)(64 * kb) * WIN_LD + 32 * nb, WIN_LD, (bf16*)(ws + WB_IN) + (size_t)(32 * nb) * D + 64 * kb, D, scr, lane); return; } it -= 1024;
    if (it < 896) { const int kb = it / 56, nb = it % 56; transpose_tile(a.in[9] + (size_t)(64 * kb) * WIN_LD + 2056 + 32 * nb, WIN_LD, (bf16*)(ws + WB_IN) + (size_t)(2048 + 32 * nb) * D + 64 * kb, D, scr, lane); return; } it -= 896;
    if (it < 512) { const int kb = it / 32, nb = it % 32; transpose_tile(a.in[10] + (size_t)(64 * kb) * D + 32 * nb, D, (bf16*)(ws + WB_OUT) + (size_t)(32 * nb) * D + 64 * kb, D, scr, lane, kb < 8 ? a.in[14] + (64 * kb) % 128 : nullptr); return; }        it -= 512;
    if (it < 2 * 1408) { const int gu = it / 1408, r = it % 1408, kb = r / 88, nb = r % 88, n0 = 32 * nb;
        const float* W = a.in[gu ? 7 : 6]; bf16* dst = (bf16*)(ws + WB_GU0);
        const int drow = (n0 / 128) * 256 + gu * 128 + (n0 % 128);
        transpose_tile(W + (size_t)(64 * kb) * FF + n0, FF, dst + (size_t)drow * D + 64 * kb, D, scr, lane); return; } it -= 2 * 1408;
    { const int kb = it / 32, nb = it % 32;
        transpose_tile(a.in[8] + (size_t)(64 * kb) * D + 32 * nb, D, (bf16*)(ws + WB_DN0) + (size_t)(32 * nb) * FF + 64 * kb, FF, scr, lane); }
}
constexpr int N_CONV_ITEMS0 = 1024 + 896 + 512 + 2 * 1408 + 1408;
__device__ __forceinline__ void convert_item1(const Args& a, int it, float* scr, int lane) {
    unsigned char* ws = a.ws;
    if (it < 2 * 1408) { const int gu = it / 1408, r = it % 1408, kb = r / 88, nb = r % 88, n0 = 32 * nb;
        const float* W = a.in[gu ? 7 : 6] + (size_t)D * FF; bf16* dst = (bf16*)(ws + WB_GU1);
        const int drow = (n0 / 128) * 256 + gu * 128 + (n0 % 128);
        transpose_tile(W + (size_t)(64 * kb) * FF + n0, FF, dst + (size_t)drow * D + 64 * kb, D, scr, lane); return; } it -= 2 * 1408;
    if (it < 1408) { const int kb = it / 32, nb = it % 32;
        transpose_tile(a.in[8] + (size_t)FF * D + (size_t)(64 * kb) * D + 32 * nb, D, (bf16*)(ws + WB_DN1) + (size_t)(32 * nb) * FF + 64 * kb, FF, scr, lane); return; } it -= 1408;
    if (it < 1024) { const int kb = it / 64, nb = it % 64; transpose_tile(a.in[26] + (size_t)(64 * kb) * 2048 + 32 * nb, 2048, (bf16*)(ws + WB_LIN) + (size_t)(32 * nb) * D + 64 * kb, D, scr, lane); return; } it -= 1024;
    if (it < 256) { const int mt = it / 32, r = it % 32, ax = mt & 1, n = mt >> 1, kb = r / 8, nb = r % 8, e0 = 32 * nb;
        const float* W = a.in[ax ? 31 : 29] + (size_t)n * 256 * 256;
        const int drow = (2 * n + e0 / 128) * 256 + ax * 128 + (e0 % 128);
        transpose_tile(W + (size_t)(64 * kb) * 256 + e0, 256, (bf16*)(ws + WB_LG) + (size_t)drow * 256 + 64 * kb, 256, scr, lane); return; } it -= 256;
    { const int kb = it / 32, nb = it % 32; transpose_tile(a.in[34] + (size_t)(64 * kb) * D + 32 * nb, D, (bf16*)(ws + WB_LOUT) + (size_t)(32 * nb) * D + 64 * kb, D, scr, lane); }
}
constexpr int N_CONV_ITEMS1 = 2 * 1408 + 1408 + 1024 + 256 + 512;

__device__ __forceinline__ void adaln_item(const Args& a, int it, float* scr, int lane) {
    const int kc = it & (NKC - 1), cg = (it / NKC) % 12, combo = it / (12 * NKC);
    const float* cin = a.in[1];
#pragma unroll
    for (int i = 0; i < 4; ++i) { const int idx = lane + 64 * i, b = idx >> 6, kk = idx & 63; const float c = cin[b * D + kc * 64 + kk]; scr[idx] = siluf_(c); }
    LDS_WAIT(); asm volatile("" ::: "memory");
    const float* W = a.in[4] + ((size_t)combo * D + kc * 64) * 3072 + cg * 256 + lane * 4;
    f32x4 acc[4] = {{0.f, 0.f, 0.f, 0.f}, {0.f, 0.f, 0.f, 0.f}, {0.f, 0.f, 0.f, 0.f}, {0.f, 0.f, 0.f, 0.f}};
#pragma unroll 1
    for (int k0 = 0; k0 < 64; k0 += 16) { f32x4 w[16];
#pragma unroll
        for (int i = 0; i < 16; ++i) w[i] = *(const f32x4*)(W + (size_t)(k0 + i) * 3072);
        asm volatile("" ::: "memory");
#pragma unroll
        for (int i = 0; i < 16; ++i) {
#pragma unroll
            for (int b = 0; b < 4; ++b) acc[b] += w[i] * scr[b * 64 + k0 + i]; }
        asm volatile("" ::: "memory"); }
    float* P = (float*)(a.ws + WS_MODP);
#pragma unroll
    for (int b = 0; b < 4; ++b) *(f32x4*)(P + ((size_t)((kc * 4 + combo) * 4 + b)) * 3072 + cg * 256 + lane * 4) = acc[b];
    LDS_WAIT(); asm volatile("" ::: "memory");
}

__device__ __forceinline__ float mod_from_partials(const Args& a, int combo, int b, int n) {
    const float* P = (const float*)(a.ws + WS_MODP);
    float s = a.in[5][combo * 3072 + n];
#pragma unroll
    for (int kc = 0; kc < NKC; ++kc) s += P[((size_t)((kc * 4 + combo) * 4 + b)) * 3072 + n];
    return s;
}

__device__ __forceinline__ void st8_wt(void* p, v2u v) { __hip_atomic_store((unsigned long long*)p, ((unsigned long long)v.y << 32) | v.x, __ATOMIC_RELAXED, __HIP_MEMORY_SCOPE_AGENT); }
template <int MODE, bool XIN_BF = false, bool XOUT_BF = false>
__device__ __forceinline__ void row_pass(const Args& a, Frame& F, const void* xres_v, void* xout_v, const bf16* y, int combo_res, const float* npost, int combo_h, const float* npre) {
    float* tab = F.ldsf;
    const float* xres = (const float*)xres_v; const bf16* xres_b = (const bf16*)xres_v; float* xout = (float*)xout_v; bf16* xout_b = (bf16*)xout_v;
    const bool from_partials = (MODE == 0);
    const float* MODS = (const float*)(a.ws + WS_MODS);
    for (int rb = F.vcu; rb < M / 64; rb += F.G) {
        const int b = rb / (T / 64);
        __syncthreads();
        for (int k = F.tid; k < D; k += NWAVES * 64) {
            if (MODE != 2) {
                float sh, sc;
                if (from_partials) { sh = mod_from_partials(a, combo_h, b, k); sc = mod_from_partials(a, combo_h, b, D + k); }
                else { sh = MODS[(combo_h * 4 + b) * 3072 + k]; sc = MODS[(combo_h * 4 + b) * 3072 + D + k]; }
                tab[k] = npre[k] * (1.0f + sc); tab[D + k] = sh;
            }
            if (MODE != 0) tab[2 * D + k] = MODS[(combo_res * 4 + b) * 3072 + 2 * D + k] * npost[k];
        }
        if (MODE == 0) { const float* WSP = (const float*)(a.ws + WS_WSPEC); for (int i = F.tid * 4; i < 8 * D; i += NWAVES * 64 * 4) *(f32x4*)(tab + 3 * D + i) = *(const f32x4*)(WSP + i); }
        __syncthreads();
        constexpr int RB = 4;
#pragma unroll 1
        for (int r0 = 0; r0 < 64 / NWAVES; r0 += RB) {
            asm volatile("" ::: "memory");
            const size_t ro = (size_t)(rb * 64 + F.wave + NWAVES * r0) * D + 4 * F.lane;
            f32x4 v[RB][4];
            if (MODE == 0) {
#pragma unroll
                for (int q = 0; q < RB; ++q)
#pragma unroll
                    for (int j = 0; j < 4; ++j) v[q][j] = *(const f32x4*)(xres + ro + (size_t)q * NWAVES * D + 256 * j);
            } else {
                v2u yw[RB][4]; v2u xw[RB][4];
#pragma unroll
                for (int q = 0; q < RB; ++q)
#pragma unroll
                    for (int j = 0; j < 4; ++j) { yw[q][j] = *(const v2u*)(y + ro + (size_t)q * NWAVES * D + 256 * j);
                        if (XIN_BF) xw[q][j] = *(const v2u*)(xres_b + ro + (size_t)q * NWAVES * D + 256 * j); else v[q][j] = *(const f32x4*)(xres + ro + (size_t)q * NWAVES * D + 256 * j); }
                float rs[RB];
#pragma unroll
                for (int q = 0; q < RB; ++q) { float ss = 0.f;
#pragma unroll
                    for (int j = 0; j < 4; ++j) { const float y0 = bf_lo(yw[q][j].x), y1 = bf_hi(yw[q][j].x), y2 = bf_lo(yw[q][j].y), y3 = bf_hi(yw[q][j].y); ss += (y0 * y0 + y1 * y1) + (y2 * y2 + y3 * y3); }
                    rs[q] = rsq_(wave_sum(ss) * (1.0f / D) + EPS); }
#pragma unroll
                for (int q = 0; q < RB; ++q)
#pragma unroll
                    for (int j = 0; j < 4; ++j) asm volatile("" : "+v"(yw[q][j].x), "+v"(yw[q][j].y));
#pragma unroll
                for (int j = 0; j < 4; ++j) { const f32x4 gp = *(const f32x4*)(tab + 2 * D + 256 * j + 4 * F.lane);
#pragma unroll
                    for (int q = 0; q < RB; ++q) { f32x4 xr; if (XIN_BF) xr = (f32x4){bf_lo(xw[q][j].x), bf_hi(xw[q][j].x), bf_lo(xw[q][j].y), bf_hi(xw[q][j].y)}; else xr = v[q][j];
                        const f32x4 yv = (f32x4){bf_lo(yw[q][j].x), bf_hi(yw[q][j].x), bf_lo(yw[q][j].y), bf_hi(yw[q][j].y)};
                        v[q][j] = xr + gp * (yv * rs[q]);
#ifdef PROBE_A0
                        if (MODE == 2) { const float* pv = (const float*)(a.ws + 49152); v[q][j] = v[q][j] * (1.0f + pv[0]); if (rb == 0 && F.wave == 0 && r0 == 0 && q == 0 && j == 0 && F.lane == 0) v[q][j].x += pv[1]; }
#endif
                        if (XOUT_BF) { v2u o; o.x = pk2(v[q][j].x, v[q][j].y); o.y = pk2(v[q][j].z, v[q][j].w); st8_wt(xout_b + ro + (size_t)q * NWAVES * D + 256 * j, o); } else *(f32x4*)(xout + ro + (size_t)q * NWAVES * D + 256 * j) = v[q][j]; } }
            }
            if (MODE != 2) {
                float rs[RB];
#pragma unroll
                for (int q = 0; q < RB; ++q) { float ss = 0.f;
#pragma unroll
                    for (int j = 0; j < 4; ++j) ss += (v[q][j].x * v[q][j].x + v[q][j].y * v[q][j].y) + (v[q][j].z * v[q][j].z + v[q][j].w * v[q][j].w);
                    rs[q] = rsq_(wave_sum(ss) * (1.0f / D) + EPS); }
                bf16* H = (bf16*)(a.ws + WS_H);
#pragma unroll
                for (int j = 0; j < 4; ++j) { const f32x4 g = *(const f32x4*)(tab + 256 * j + 4 * F.lane), sh = *(const f32x4*)(tab + D + 256 * j + 4 * F.lane);
#pragma unroll
                    for (int q = 0; q < RB; ++q) { v[q][j] = v[q][j] * rs[q] * g + sh;
                        v2u o; o.x = pk2(v[q][j].x, v[q][j].y); o.y = pk2(v[q][j].z, v[q][j].w); st8_wt(H + ro + (size_t)q * NWAVES * D + 256 * j, o); } }
                if (MODE == 0) {
                    const float* WSP = tab + 3 * D;
                    const int hh = F.lane & 3;
                    float al[RB], bb[RB];
#pragma unroll
                    for (int q = 0; q < RB; ++q) { al[q] = 0.f; bb[q] = 0.f; }
#pragma unroll
                    for (int c = 0; c < 8; ++c) { float sq[RB];
#pragma unroll
                        for (int q = 0; q < RB; ++q) sq[q] = 0.f;
#pragma unroll
                        for (int j = 0; j < 4; ++j) { const f32x4 w = *(const f32x4*)(WSP + c * D + 256 * j + 4 * F.lane);
#pragma unroll
                            for (int q = 0; q < RB; ++q) sq[q] += (v[q][j].x * w.x + v[q][j].y * w.y) + (v[q][j].z * w.z + v[q][j].w * w.w); }
#pragma unroll
                        for (int q = 0; q < RB; ++q) { const float d = wave_sum(sq[q]); if (c < 4) al[q] = (hh == c) ? d : al[q]; else bb[q] = (hh == c - 4) ? d : bb[q]; } }
                    if (F.lane < 4) { float* GB = (float*)(a.ws + WS_GB); const float ea = -__expf(a.in[12][hh]), ab = a.in[13][hh];
#pragma unroll
                        for (int q = 0; q < RB; ++q) { const size_t row = (size_t)(rb * 64 + F.wave + NWAVES * (r0 + q));
                            GB[row * 8 + hh] = ea * softplusf_(al[q] + ab);
                            GB[row * 8 + 4 + hh] = sigmoidf_(bb[q]); } }
                }
            }
        }
    }
}

typedef float f32x16 __attribute__((ext_vector_type(16)));
typedef short bf16x8s __attribute__((ext_vector_type(8)));
typedef float f32x2_t __attribute__((ext_vector_type(2))); typedef __bf16 bf16x2_t __attribute__((ext_vector_type(2)));
#define MFMA32(a, b, c) __builtin_amdgcn_mfma_f32_32x32x16_bf16((a), (b), (c), 0, 0, 0)
__device__ __forceinline__ unsigned cvtpk(float lo, float hi) { f32x2_t v = {lo, hi}; bf16x2_t b = __builtin_convertvector(v, bf16x2_t); return __builtin_bit_cast(unsigned, b); }
__device__ __forceinline__ bf16 bf1(float x) { return (bf16)cvtpk(x, x); }
__device__ __forceinline__ int pi_(int k) { return (k & ~12) | ((k & 4) << 1) | ((k & 8) >> 1); }
__device__ __forceinline__ int img256(int row, int pos) { return row * 256 + ((((pos >> 3) ^ (row & 15))) << 4) + ((pos & 7) << 1); }
__device__ __forceinline__ int img128(int row, int pos) { return row * 128 + ((((pos >> 3) ^ ((row >> 1) & 7))) << 4) + ((pos & 7) << 1); }
__device__ __forceinline__ int crow(int r, int hh) { return (r & 3) + 8 * (r >> 2) + 4 * hh; }
__device__ __forceinline__ bf16x8s pack8(const f32x16& x, int s) { v4u p; p.x = cvtpk(x[8 * s], x[8 * s + 1]); p.y = cvtpk(x[8 * s + 2], x[8 * s + 3]); p.z = cvtpk(x[8 * s + 4], x[8 * s + 5]); p.w = cvtpk(x[8 * s + 6], x[8 * s + 7]); return __builtin_bit_cast(bf16x8s, p); }
__device__ __forceinline__ f32x16 unpack16(const v4u x0, const v4u x1) { f32x16 v;
    v[0] = bf_lo(x0.x); v[1] = bf_hi(x0.x); v[2] = bf_lo(x0.y); v[3] = bf_hi(x0.y); v[4] = bf_lo(x0.z); v[5] = bf_hi(x0.z); v[6] = bf_lo(x0.w); v[7] = bf_hi(x0.w);
    v[8] = bf_lo(x1.x); v[9] = bf_hi(x1.x); v[10] = bf_lo(x1.y); v[11] = bf_hi(x1.y); v[12] = bf_lo(x1.z); v[13] = bf_hi(x1.z); v[14] = bf_lo(x1.w); v[15] = bf_hi(x1.w); return v; }
__device__ __forceinline__ f32x16 zero16() { f32x16 z;
#pragma unroll
    for (int i = 0; i < 16; ++i) z[i] = 0.f; return z; }


typedef unsigned wtv4 __attribute__((__vector_size__(16)));
__device__ __forceinline__ __amdgpu_buffer_rsrc_t wt_rsrc(const void* p, unsigned bytes) {
    const unsigned long long v = (unsigned long long)p; const unsigned lo = __builtin_amdgcn_readfirstlane((unsigned)v), hi = __builtin_amdgcn_readfirstlane((unsigned)(v >> 32));
    return __builtin_amdgcn_make_buffer_rsrc((void*)(((unsigned long long)hi << 32) | lo), 0, (int)bytes, 0x00020000); }
__device__ __forceinline__ void wt16(__amdgpu_buffer_rsrc_t rs, unsigned off, v4u v) { __builtin_amdgcn_raw_buffer_store_b128(__builtin_bit_cast(wtv4, v), rs, (int)off, 0, 16); }
__device__ __forceinline__ void wt8(void* p, v2u v) { __hip_atomic_store((unsigned long long*)p, ((unsigned long long)v.y << 32) | v.x, __ATOMIC_RELAXED, __HIP_MEMORY_SCOPE_AGENT); }
__device__ __forceinline__ void wt4(void* p, float v) { __hip_atomic_store((unsigned*)p, __float_as_uint(v), __ATOMIC_RELAXED, __HIP_MEMORY_SCOPE_AGENT); }

constexpr size_t WS_QCTR = 18432;
constexpr size_t WS_RDY = 20480;
__device__ __forceinline__ void unit_arrive(unsigned char* ws, int pq, int lane) {
    if (pq >= 0) { asm volatile("s_waitcnt vmcnt(0)" ::: "memory");
        if (lane == 0) __hip_atomic_fetch_add((unsigned*)(ws + WS_RDY) + (pq % 48) * 64 + pq / 48, 1u, __ATOMIC_RELAXED, __HIP_MEMORY_SCOPE_AGENT); }
}
__device__ __forceinline__ void tri_inverse64(float* MTf_in, int lane) {
    LAS float* MTf; { unsigned a32 = (unsigned)(unsigned long long)((LAS float*)MTf_in); asm volatile("" : "+v"(a32)); MTf = (LAS float*)(unsigned long long)a32; }
    const int c = lane & 31, hb = lane >> 5;
    LAS float* Mb = MTf + hb * (32 * 68 + 32);
    float Tc[32];
#pragma unroll
    for (int i = 0; i < 32; ++i) Tc[i] = 0.f;
#pragma unroll
    for (int i = 0; i < 32; ++i) {
        float a0 = 0.f, a1 = 0.f, a2 = 0.f, a3 = 0.f;
#pragma unroll
        for (int j = 0; j < i; j += 4) { const f32x4 m4 = *(const LAS f32x4*)(Mb + i * 68 + j); a0 += m4.x * Tc[j]; a1 += m4.y * Tc[j + 1]; a2 += m4.z * Tc[j + 2]; a3 += m4.w * Tc[j + 3]; }
        Tc[i] = (c == i ? 1.0f : 0.0f) - ((a0 + a1) + (a2 + a3));
        Mb[i * 68 + c] = Tc[i];
        asm volatile("" ::: "memory");
    }
    f32x16 X = zero16();
#pragma unroll
    for (int q = 0; q < 16; ++q) { const float av = MTf[(32 + c) * 68 + 2 * q + hb], bv = MTf[(2 * q + hb) * 68 + c]; X = __builtin_amdgcn_mfma_f32_32x32x2f32(av, bv, X, 0, 0, 0); }
    f32x16 Y = zero16();
#pragma unroll
    for (int r = 0; r < 16; ++r) { const float av = MTf[(32 + c) * 68 + 32 + (r & 3) + 8 * (r >> 2) + 4 * hb]; Y = __builtin_amdgcn_mfma_f32_32x32x2f32(av, X[r], Y, 0, 0, 0); }
    asm volatile("" ::: "memory");
#pragma unroll
    for (int r = 0; r < 16; ++r) MTf[(32 + (r & 3) + 8 * (r >> 2) + 4 * hb) * 68 + c] = -Y[r];
}

struct UnitPF { v4u r[14]; float g, be; };
__device__ __forceinline__ void unit_issue_main(const Args& a, int tid_, int q, UnitPF& P) {
    if (q < 0) return;
    const int n = q / 48, rr = q % 48, wave = tid_ >> 6, lane = tid_ & 63;
    const bf16* COLS = (const bf16*)(a.ws + BIG_COLS); const bf16* HALO = (const bf16*)(a.ws + WS_HALO);
    if (rr < 16) { const int b = rr >> 2, h = rr & 3, R0 = b * T + n * 64;
        const int cpart = wave < 2 ? 0 : (wave < 4 ? 1 : 2), cm = tid_ & 15, cwcol = cpart * 512 + h * 128 + cm * 8;
        const int ct0 = cpart < 2 ? ((tid_ >> 4) & 7) * 8 : ((tid_ - 256) >> 4) * 4;
#pragma unroll
        for (int r = 0; r < 11; ++r) { const int tau = ct0 + r - 3; P.r[r] = (v4u){0u, 0u, 0u, 0u};
            if (r < 7 || cpart < 2) {
                if (tau >= 0) P.r[r] = *(const v4u*)(COLS + (size_t)(R0 + tau) * NCOLS + cwcol);
                else if (n > 0) P.r[r] = *(const v4u*)(HALO + ((size_t)((b * 64 + n - 1) * 3) + (3 + tau)) * NCOLS + cwcol); } }
        if (wave == 0) { const float* GB = (const float*)(a.ws + WS_GB); P.g = GB[(size_t)(R0 + lane) * 8 + h]; P.be = GB[(size_t)(R0 + lane) * 8 + 4 + h]; }
    } else { const int b = (rr - 16) >> 3, h = (rr - 16) & 7, R0 = b * T + n * 64, hc0 = h * 64;
#pragma unroll
        for (int i = 0; i < 7; ++i) {
            const int wi = wave + 8 * i, g8b = wi >> 3, tok = (wi & 7) * 8 + (lane >> 3), lc = (g8b * 8 + (lane & 7)) * 8;
            const int rc = g8b < 3 ? g8b * 512 + hc0 + (lc & 63) : 1536 + (lc - 192);
            P.r[2 * i] = *(const v4u*)(COLS + (size_t)(R0 + tok) * NCOLS + 2048 + rc);
            v4u pw = {0u, 0u, 0u, 0u};
            if (tok > 0) pw = *(const v4u*)(COLS + (size_t)(R0 + tok - 1) * NCOLS + 2048 + rc);
            else if (n > 0) pw = *(const v4u*)(HALO + ((size_t)((b * 64 + n - 1) * 3) + 2) * NCOLS + 2048 + rc);
            P.r[2 * i + 1] = pw; }
    }
}
__device__ __forceinline__ void gdn_prep_unit(const Args& a, Frame& F, int b, int n, int h, int pq, UnitPF& P, int qn, unsigned claim, volatile LAS unsigned* slot) {
    unsigned char* L = (unsigned char*)F.ldsf;
    constexpr int QH = 0, KH = 16384, VT = 32768, KBT = 49152, KDT = 65536, MT = 81920, GS = MT + 17408, ATTI = GS + 1024, WPI = ATTI + 8192;
    float* Gs = (float*)(L + GS); float* MTf = (float*)(L + MT);
    int tid_ = F.tid; asm volatile("" : "+v"(tid_));
    const int R0 = b * T + n * 64, uid = (b * 64 + n) * 4 + h, lane = tid_ & 63, r32 = lane & 31, hh = lane >> 5;
    unsigned char* ws = a.ws;
    const bf16* COLS = (const bf16*)(ws + BIG_COLS); const bf16* HALO = (const bf16*)(ws + WS_HALO); const float* GB = (const float*)(ws + WS_GB); const float* cw = a.in[11];
    unsigned char* colsb = ws + BIG_COLS;
    const __amdgpu_buffer_rsrc_t wrs = wt_rsrc(ws, 0x10000000u);
#define SLOT(part, o) (colsb + (size_t)(R0 + ((o) >> 8)) * (NCOLS * 2) + ((part) * 512 + h * 128) * 2 + ((o) & 255))
    const int cpart = F.wave < 2 ? 0 : (F.wave < 4 ? 1 : 2), cm = tid_ & 15, cwcol = cpart * 512 + h * 128 + cm * 8;
    const int ct0 = cpart < 2 ? ((tid_ >> 4) & 7) * 8 : ((tid_ - 256) >> 4) * 4;
    v4u xr[11]; f32x4 wa[4], wb[4];
#pragma unroll
    for (int r = 0; r < 11; ++r) xr[r] = P.r[r];
#pragma unroll
    for (int j = 0; j < 4; ++j) { wa[j] = *(const f32x4*)(cw + j * 1536 + cwcol); wb[j] = *(const f32x4*)(cw + j * 1536 + cwcol + 4); }
    if (F.wave == 0) {
        const float g = P.g, be = P.be;
        float G = g;
        G = wave_scan(G);
        const float Gl = __int_as_float(__builtin_amdgcn_readlane(__float_as_int(G), 63));
        Gs[lane] = G; Gs[64 + lane] = be; Gs[128 + lane] = __expf(G); Gs[192 + lane] = __expf(Gl - G);
        if (lane == 0) wt4((float*)(ws + GDN_GL) + uid, __expf(Gl));
    }
    __syncthreads();
    unsigned qdpk[8][4];
    { const int part = cpart, m = cm, c8 = m * 8;
      if (part < 2) {
          const int run = (tid_ >> 4) & 7, t0 = run * 8;
          unsigned kbt[8][4], kdt[8][4];
#pragma unroll
          for (int r = 0; r < 8; ++r) { const int tok = t0 + r;
              float v[8];
#pragma unroll
              for (int e = 0; e < 8; ++e) v[e] = 0.f;
#pragma unroll
              for (int j = 0; j < 4; ++j) { const v4u xw = xr[r + j];
                  v[0] += wa[j].x * bf_lo(xw.x); v[1] += wa[j].y * bf_hi(xw.x); v[2] += wa[j].z * bf_lo(xw.y); v[3] += wa[j].w * bf_hi(xw.y);
                  v[4] += wb[j].x * bf_lo(xw.z); v[5] += wb[j].y * bf_hi(xw.z); v[6] += wb[j].z * bf_lo(xw.w); v[7] += wb[j].w * bf_hi(xw.w); }
              float ss = 0.f;
#pragma unroll
              for (int e = 0; e < 8; ++e) { v[e] = siluf_(v[e]); ss += v[e] * v[e]; }
              ss = hex_sum(ss);
              const float sc = rsq_(ss + EPS) * (part == 0 ? 0.08838834764831845f : 1.0f);
#pragma unroll
              for (int e = 0; e < 8; ++e) v[e] *= sc;
              v4u o; o.x = cvtpk(v[0], v[1]); o.y = cvtpk(v[2], v[3]); o.z = cvtpk(v[4], v[5]); o.w = cvtpk(v[6], v[7]);
              *(v4u*)(L + (part == 0 ? QH : KH) + tok * 256 + ((m ^ (tok & 15)) << 4)) = o;
              if (part == 0) { const float eg = Gs[128 + tok];
                  qdpk[r][0] = cvtpk(v[0] * eg, v[1] * eg); qdpk[r][1] = cvtpk(v[2] * eg, v[3] * eg); qdpk[r][2] = cvtpk(v[4] * eg, v[5] * eg); qdpk[r][3] = cvtpk(v[6] * eg, v[7] * eg);
              } else { const float sb = Gs[64 + tok] * Gs[128 + tok], sd = Gs[192 + tok];
#pragma unroll
                  for (int e = 0; e < 8; ++e) { const unsigned xb = cvtpk(v[e] * sb, v[e] * sb) & 0xffffu, xd = cvtpk(v[e] * sd, v[e] * sd) & 0xffffu;
                      if (r & 1) { kbt[e][r >> 1] |= xb << 16; kdt[e][r >> 1] |= xd << 16; } else { kbt[e][r >> 1] = xb; kdt[e][r >> 1] = xd; } } }
          }
          if (part == 1) { const int ab = run >> 1, bb = run & 1;
#pragma unroll
              for (int e = 0; e < 8; ++e) { const int ch = c8 + e, sw = (ch >> 1) & 7;
                  *(v4u*)(L + KBT + ch * 128 + ((run ^ sw) << 4)) = (v4u){kbt[e][0], kbt[e][1], kbt[e][2], kbt[e][3]};
                  *(v2u*)(L + KDT + ch * 128 + (((2 * ab) ^ sw) << 4) + 8 * bb) = (v2u){kdt[e][0], kdt[e][1]};
                  *(v2u*)(L + KDT + ch * 128 + (((2 * ab + 1) ^ sw) << 4) + 8 * bb) = (v2u){kdt[e][2], kdt[e][3]}; } }
      } else {
          const int run = (tid_ - 256) >> 4, t0 = run * 4;
          unsigned vbt[8][2];
#pragma unroll
          for (int r = 0; r < 4; ++r) { const int tok = t0 + r;
              float v[8];
#pragma unroll
              for (int e = 0; e < 8; ++e) v[e] = 0.f;
#pragma unroll
              for (int j = 0; j < 4; ++j) { const v4u xw = xr[r + j];
                  v[0] += wa[j].x * bf_lo(xw.x); v[1] += wa[j].y * bf_hi(xw.x); v[2] += wa[j].z * bf_lo(xw.y); v[3] += wa[j].w * bf_hi(xw.y);
                  v[4] += wb[j].x * bf_lo(xw.z); v[5] += wb[j].y * bf_hi(xw.z); v[6] += wb[j].z * bf_lo(xw.w); v[7] += wb[j].w * bf_hi(xw.w); }
              const float be = Gs[64 + tok];
#pragma unroll
              for (int e = 0; e < 8; ++e) { const float y = siluf_(v[e]) * be; const unsigned xb = cvtpk(y, y) & 0xffffu; if (r & 1) vbt[e][r >> 1] |= xb << 16; else vbt[e][r >> 1] = xb; } }
#pragma unroll
          for (int e = 0; e < 8; ++e) { const int ch = c8 + e; *(v2u*)(L + VT + ch * 128 + ((((t0 >> 3)) ^ ((ch >> 1) & 7)) << 4) + (t0 & 7) * 2) = (v2u){vbt[e][0], vbt[e][1]}; }
      }
    }
    unit_arrive(ws, pq, lane);
    __syncthreads();
    if (F.wave < 2) { const int m = tid_ & 15, cA = 2 * (m >> 1), t0 = ((tid_ >> 4) & 7) * 8;
#pragma unroll
        for (int r = 0; r < 8; ++r) { const int tok = t0 + r;
            wt8(SLOT(0, tok * 256 + ((cA ^ (tok & 15)) << 4) + (m & 1) * 8), (v2u){qdpk[r][0], qdpk[r][1]});
            wt8(SLOT(0, tok * 256 + (((cA + 1) ^ (tok & 15)) << 4) + (m & 1) * 8), (v2u){qdpk[r][2], qdpk[r][3]}); } }
    { const int o = tid_ * 32; const v4u x0 = *(const v4u*)(L + KDT + o), x1 = *(const v4u*)(L + KDT + o + 16); wt16(wrs, (unsigned)(SLOT(1, o) - ws), x0); wt16(wrs, (unsigned)(SLOT(1, o + 16) - ws), x1); }
    { const int p = F.wave >> 2, ti = (F.wave >> 1) & 1, tj = F.wave & 1;
      f32x16 acc = zero16();
      if (!(ti == 0 && tj == 1)) {
          const int i = 32 * ti + r32, j = 32 * tj + r32; const unsigned char* Ab = L + (p ? QH : KH) + i * 256; const unsigned char* Bb = L + KH + j * 256;
#pragma unroll
          for (int ks = 0; ks < 8; ++ks) { const bf16x8s A = *(const bf16x8s*)(Ab + (((2 * ks + hh) ^ (i & 15)) << 4)); const bf16x8s B = *(const bf16x8s*)(Bb + (((2 * ks + hh) ^ (j & 15)) << 4)); acc = MFMA32(A, B, acc); }
      }
      const int j = 32 * tj + r32; const float Gj = Gs[j]; const int pj = pi_(j);
      unsigned char* att = L + ATTI;
#pragma unroll
      for (int r = 0; r < 16; ++r) { const int i = 32 * ti + crow(r, hh); const float e = __expf(fminf(Gs[i] - Gj, 0.f));
          if (p == 0) MTf[i * 68 + j] = (i > j) ? Gs[64 + i] * acc[r] * e : 0.f;
          else *(bf16*)(att + img128(i, pj)) = bf1((i >= j) ? acc[r] * e : 0.f); }
    }
    __syncthreads();
    { const v4u x = *(const v4u*)(L + ATTI + tid_ * 16); wt16(wrs, (unsigned)(GDN_ATT + (size_t)uid * 8192 + tid_ * 16), x); }
    if (tid_ == 0) *slot = claim;
    unit_issue_main(a, tid_, qn, P);
    if (F.wave == 0) tri_inverse64(MTf, lane);
    __syncthreads();
    { const int ti = F.wave >> 2, cj = F.wave & 3, t = 32 * ti + r32, ch = 32 * cj + r32;
      f32x16 au = zero16(), aw = zero16();
#pragma unroll
      for (int ks = 0; ks < 4; ++ks) { const f32x4 t0 = *(const f32x4*)(MTf + t * 68 + 16 * ks + 8 * hh), t1 = *(const f32x4*)(MTf + t * 68 + 16 * ks + 8 * hh + 4);
          v4u pa; pa.x = cvtpk(t0.x, t0.y); pa.y = cvtpk(t0.z, t0.w); pa.z = cvtpk(t1.x, t1.y); pa.w = cvtpk(t1.z, t1.w); const bf16x8s A = __builtin_bit_cast(bf16x8s, pa);
          const int sw = ((2 * ks + hh) ^ ((ch >> 1) & 7)) << 4;
          const bf16x8s Bu = *(const bf16x8s*)(L + VT + ch * 128 + sw), Bw = *(const bf16x8s*)(L + KBT + ch * 128 + sw);
          au = MFMA32(A, Bu, au); aw = MFMA32(A, Bw, aw); }
      v4u u0, u1; u0.x = cvtpk(au[0], au[1]); u0.y = cvtpk(au[2], au[3]); u0.z = cvtpk(au[4], au[5]); u0.w = cvtpk(au[6], au[7]);
      u1.x = cvtpk(au[8], au[9]); u1.y = cvtpk(au[10], au[11]); u1.z = cvtpk(au[12], au[13]); u1.w = cvtpk(au[14], au[15]);
      const int o = ((ti * 4 + cj) * 64 + lane) * 32;
      wt16(wrs, (unsigned)(SLOT(2, o) - ws), u0); wt16(wrs, (unsigned)(SLOT(2, o + 16) - ws), u1);
      unsigned char* wp = L + WPI; const int pk = pi_(ch);
#pragma unroll
      for (int r = 0; r < 16; ++r) { const int tt = 32 * ti + crow(r, hh); *(bf16*)(wp + img256(tt, pk)) = bf1(-aw[r]); }
    }
    __syncthreads();
    { const int o = tid_ * 32; const v4u x0 = *(const v4u*)(L + WPI + o), x1 = *(const v4u*)(L + WPI + o + 16); wt16(wrs, (unsigned)(GDN_WP + (size_t)uid * 16384 + o), x0); wt16(wrs, (unsigned)(GDN_WP + (size_t)uid * 16384 + o + 16), x1); }
#undef SLOT
}


__device__ __forceinline__ void unit_publish(unsigned char* ws, int q) {
    asm volatile("s_waitcnt vmcnt(0)" ::: "memory");
    __syncthreads();
    if (threadIdx.x == 0) __hip_atomic_store((unsigned*)(ws + WS_RDY) + (q % 48) * 64 + q / 48, 1u, __ATOMIC_RELAXED, __HIP_MEMORY_SCOPE_AGENT);
}
__device__ __forceinline__ void unit_wait4(unsigned char* ws, int r, int k) {
    unsigned* f = (unsigned*)(ws + WS_RDY) + r * 64 + 4 * k; unsigned spins = 0;
    for (;;) { unsigned ok = 1u;
#pragma unroll
        for (int i = 0; i < 4; ++i) ok &= (__hip_atomic_load(f + i, __ATOMIC_RELAXED, __HIP_MEMORY_SCOPE_AGENT) >= 8u) ? 1u : 0u;
        if (__builtin_amdgcn_readfirstlane(ok)) break;
        __builtin_amdgcn_s_sleep(8); if (++spins > (1u << 13)) break; }
    __builtin_amdgcn_fence(__ATOMIC_ACQUIRE, "agent");
    asm volatile("s_waitcnt vmcnt(0)" ::: "memory");
}
__device__ __forceinline__ __amdgpu_buffer_rsrc_t mk_rsrc(const void* p, unsigned bytes) {
    const unsigned long long v = (unsigned long long)p; const unsigned lo = __builtin_amdgcn_readfirstlane((unsigned)v), hi = __builtin_amdgcn_readfirstlane((unsigned)(v >> 32));
    return __builtin_amdgcn_make_buffer_rsrc((void*)(((unsigned long long)hi << 32) | lo), 0, (int)bytes, 0x00020000); }
__device__ __forceinline__ void aload16(v4u& dst, __amdgpu_buffer_rsrc_t rs, unsigned voff, unsigned soff) {
    const unsigned so = __builtin_amdgcn_readfirstlane(soff);
    asm volatile("s_nop 4\n\tbuffer_load_dwordx4 %0, %1, %2, %3 offen" : "=v"(dst) : "v"(voff), "s"(rs), "s"(so) : "memory"); }
__device__ __forceinline__ void aload4(float& dst, __amdgpu_buffer_rsrc_t rs, unsigned voff, unsigned soff) {
    const unsigned so = __builtin_amdgcn_readfirstlane(soff);
    asm volatile("s_nop 4\n\tbuffer_load_dword %0, %1, %2, %3 offen" : "=v"(dst) : "v"(voff), "s"(rs), "s"(so) : "memory"); }
#define VMW4(N, A) asm volatile("s_waitcnt vmcnt(" #N ")" : "+v"((A)[0]), "+v"((A)[1]), "+v"((A)[2]), "+v"((A)[3]) :: "memory")
constexpr int GSTG = 57600;
constexpr int GUB = 2 * GSTG;
constexpr int GOB = GUB + 16384;
constexpr int GOBS = 136;
struct GdnSet { v4u sx[14]; float sg; };
struct GdnAux { v4u su[4]; v4u z[4]; };
__device__ __forceinline__ void gdn_ld_sx(__amdgpu_buffer_rsrc_t rs, int b, int h, int n, int ltid, GdnSet& S) {
    const int R0 = b * T + n * 64, uid = (b * 64 + n) * 4 + h;
    const unsigned ow = (unsigned)(GDN_WP + (size_t)uid * 16384), os = (unsigned)(BIG_COLS + (size_t)R0 * (NCOLS * 2) + (h * 128) * 2), oa = (unsigned)(GDN_ATT + (size_t)uid * 8192);
    const unsigned l16 = (unsigned)ltid * 16u, lsl = (l16 >> 8) * (unsigned)(NCOLS * 2) + (l16 & 255u);
#pragma unroll
    for (int i = 0; i < 4; ++i) aload16(S.sx[i], rs, l16, ow + 4096u * i);
#pragma unroll
    for (int i = 4; i < 12; ++i) aload16(S.sx[i], rs, lsl, os + (i < 8 ? 0u : 1024u) + (unsigned)((i & 3) * 16 * NCOLS * 2));
#pragma unroll
    for (int i = 12; i < 14; ++i) aload16(S.sx[i], rs, l16, oa + 4096u * (i - 12));
    aload4(S.sg, rs, 0u, (unsigned)(GDN_GL + (size_t)uid * 4));
}
__device__ __forceinline__ void gdn_ld_su(__amdgpu_buffer_rsrc_t rs, int b, int h, int n, int ltid, GdnAux& S) {
    const unsigned os = (unsigned)(BIG_COLS + (size_t)(b * T + n * 64) * (NCOLS * 2) + (2 * 512 + h * 128) * 2);
    const unsigned l16 = (unsigned)ltid * 16u, lsl = (l16 >> 8) * (unsigned)(NCOLS * 2) + (l16 & 255u);
#pragma unroll
    for (int i = 0; i < 4; ++i) aload16(S.su[i], rs, lsl, os + (unsigned)(i * 16 * NCOLS * 2));
}
__device__ __forceinline__ void gdn_ld_z(__amdgpu_buffer_rsrc_t rs, int b, int h, int n, int lw, int lane, GdnAux& S) {
    const unsigned voff = (unsigned)((lw * 16 + (lane >> 2)) * (NCOLS * 2) + (lane & 3) * 16);
    const unsigned so = (unsigned)(BIG_COLS + (size_t)(b * T + n * 64) * (NCOLS * 2) + (1536 + h * 128) * 2);
#pragma unroll
    for (int q = 0; q < 4; ++q) aload16(S.z[q], rs, voff, so + 64u * q);
}
#define GDN_WAIT_SX(N, S) asm volatile("s_waitcnt vmcnt(" #N ")" : "+v"((S).sx[0]), "+v"((S).sx[1]), "+v"((S).sx[2]), "+v"((S).sx[3]), "+v"((S).sx[4]), "+v"((S).sx[5]), "+v"((S).sx[6]), "+v"((S).sx[7]), \
    "+v"((S).sx[8]), "+v"((S).sx[9]), "+v"((S).sx[10]), "+v"((S).sx[11]), "+v"((S).sx[12]), "+v"((S).sx[13]), "+v"((S).sg) :: "memory")
__device__ __forceinline__ void gdn_st_sx(unsigned char* L, int stg, int ltid, const GdnSet& S) {
#pragma unroll
    for (int i = 0; i < 14; ++i) { const int q = ltid + 256 * i; *(v4u*)(L + stg * GSTG + q * 16) = S.sx[i]; }
    if (ltid == 0) *(float*)(L + stg * GSTG + 57344) = S.sg;
}
__device__ __forceinline__ void gdn_st_su(unsigned char* L, int ltid, const GdnAux& S) {
#pragma unroll
    for (int i = 0; i < 4; ++i) *(v4u*)(L + GUB + (ltid + 256 * i) * 16) = S.su[i];
}
constexpr int GNW = GOB + 17408;
__device__ __forceinline__ void gdn_post(unsigned char* ws, const unsigned char* L, int b, int h, int n, int lw, int lane, const GdnAux& S) {
    const int tok = lw * 16 + (lane >> 2), part = lane & 3; const size_t row = (size_t)(b * T + n * 64 + tok);
    bf16* op = (bf16*)(ws + WS_H) + row * D + h * 128 + 8 * part;
    float ss = 0.f;
    v4u xv[4];
#pragma unroll
    for (int q = 0; q < 4; ++q) { xv[q] = *(const v4u*)(L + GOB + (tok * GOBS + 8 * (4 * q + part)) * 2); const v4u xq = xv[q];
        const float a0 = bf_lo(xq.x), a1 = bf_hi(xq.x), a2 = bf_lo(xq.y), a3 = bf_hi(xq.y), a4 = bf_lo(xq.z), a5 = bf_hi(xq.z), a6 = bf_lo(xq.w), a7 = bf_hi(xq.w);
        ss += ((a0 * a0 + a1 * a1) + (a2 * a2 + a3 * a3)) + ((a4 * a4 + a5 * a5) + (a6 * a6 + a7 * a7)); }
    ss = quad_sum(ss);
    const float rstd = rsq_(ss * (1.0f / 128.0f) + EPS);
#pragma unroll
    for (int q = 0; q < 4; ++q) { const v4u z = S.z[q]; const v4u x = xv[q];
        v4u r; r.x = cvtpk(bf_lo(x.x) * rstd * bf_lo(z.x), bf_hi(x.x) * rstd * bf_hi(z.x)); r.y = cvtpk(bf_lo(x.y) * rstd * bf_lo(z.y), bf_hi(x.y) * rstd * bf_hi(z.y));
        r.z = cvtpk(bf_lo(x.z) * rstd * bf_lo(z.z), bf_hi(x.z) * rstd * bf_hi(z.z)); r.w = cvtpk(bf_lo(x.w) * rstd * bf_lo(z.w), bf_hi(x.w) * rstd * bf_hi(z.w));
        *(v4u*)(op + 32 * q) = r; }
}
#define SB0() __builtin_amdgcn_sched_barrier(0)
__device__ __forceinline__ bf16x8s ldfrag(const unsigned char* p) { return *(const bf16x8s*)p; }
__device__ __forceinline__ void gdn_chain_step(unsigned char* L, int stg, int vt, int lane, int r32, int hh, f32x16 (&S)[4]) {
    const unsigned char* st = L + stg * GSTG;
    f32x16 o[2], vn[2];
#pragma unroll
    for (int rb = 0; rb < 2; ++rb) { const unsigned char* up = L + GUB + ((rb * 4 + vt) * 64 + lane) * 32; vn[rb] = unpack16(*(const v4u*)up, *(const v4u*)(up + 16)); }
    const float glc = *(const float*)(st + 57344);
#define G_OFF1(j) ((32 * ((j) >> 3) + r32) * 256 + (((4 * (((j) >> 1) & 3) + 2 * ((j) & 1) + hh) ^ ((32 * ((j) >> 3) + r32) & 15)) << 4))
    bf16x8s aw[4], aq[4];
#pragma unroll
    for (int j = 0; j < 3; ++j) { aw[j] = ldfrag(st + G_OFF1(j)); aq[j] = ldfrag(st + 16384 + G_OFF1(j)); }
    bf16x8s Sb[4][2];
#pragma unroll
    for (int kt = 0; kt < 4; ++kt) { Sb[kt][0] = pack8(S[kt], 0); Sb[kt][1] = pack8(S[kt], 1); }
    o[0] = zero16(); o[1] = zero16();
    SB0();
#pragma unroll
    for (int j = 0; j < 16; ++j) { const int rb = j >> 3, kt = (j >> 1) & 3, s2 = j & 1;
        if (j + 3 < 16) { aw[(j + 3) & 3] = ldfrag(st + G_OFF1(j + 3)); aq[(j + 3) & 3] = ldfrag(st + 16384 + G_OFF1(j + 3)); }
        SB0();
        vn[rb] = MFMA32(aw[j & 3], Sb[kt][s2], vn[rb]); o[rb] = MFMA32(aq[j & 3], Sb[kt][s2], o[rb]);
        SB0(); }
#define G_OFF2(c, q) (49152 + (c) * 128 + ((((q) + hh) ^ (((c) >> 1) & 7)) << 4))
#define G_OFF3(k, q) (32768 + (k) * 128 + ((((q) + hh) ^ (((k) >> 1) & 7)) << 4))
    bf16x8s at[6];
    { const int c0 = r32, c1 = 32 + r32;
      at[0] = ldfrag(st + G_OFF2(c0, 0)); at[1] = ldfrag(st + G_OFF2(c0, 2)); at[2] = ldfrag(st + G_OFF2(c1, 0)); at[3] = ldfrag(st + G_OFF2(c1, 2)); at[4] = ldfrag(st + G_OFF2(c1, 4)); at[5] = ldfrag(st + G_OFF2(c1, 6)); }
    bf16x8s ak[4];
#pragma unroll
    for (int j = 0; j < 3; ++j) ak[j] = ldfrag(st + G_OFF3(32 * (j >> 2) + r32, 2 * (j & 3)));
    bf16x8s Vb[2][2];
#pragma unroll
    for (int rb = 0; rb < 2; ++rb) { Vb[rb][0] = pack8(vn[rb], 0); Vb[rb][1] = pack8(vn[rb], 1); }
#pragma unroll
    for (int kt = 0; kt < 4; ++kt)
#pragma unroll
        for (int r = 0; r < 16; ++r) S[kt][r] *= glc;
    o[0] = MFMA32(at[0], Vb[0][0], o[0]); o[0] = MFMA32(at[1], Vb[0][1], o[0]);
    o[1] = MFMA32(at[2], Vb[0][0], o[1]); o[1] = MFMA32(at[3], Vb[0][1], o[1]); o[1] = MFMA32(at[4], Vb[1][0], o[1]); o[1] = MFMA32(at[5], Vb[1][1], o[1]);
    SB0();
#pragma unroll
    for (int j = 0; j < 16; ++j) { const int kt = j >> 2, rb2 = (j >> 1) & 1, s2 = j & 1;
        if (j + 3 < 16) ak[(j + 3) & 3] = ldfrag(st + G_OFF3(32 * ((j + 3) >> 2) + r32, 2 * ((j + 3) & 3)));
        SB0();
        S[kt] = MFMA32(ak[j & 3], Vb[rb2][s2], S[kt]);
        SB0(); }
    __syncthreads();
#pragma unroll
    for (int rb = 0; rb < 2; ++rb)
#pragma unroll
        for (int r = 0; r < 16; ++r) *(bf16*)(L + GOB + ((32 * rb + crow(r, hh)) * GOBS + 32 * vt + r32) * 2) = bf1(o[rb][r]);
    __syncthreads();
#undef G_OFF1
#undef G_OFF2
#undef G_OFF3
}
template <bool FAST>
__device__ __forceinline__ void gdn_loader_step(__amdgpu_buffer_rsrc_t rs, unsigned char* ws, unsigned char* L, int b, int h, int n, int lw, int ltid, GdnSet& P, GdnAux& X) {
    if (FAST) GDN_WAIT_SX(31, P); else GDN_WAIT_SX(0, P);
    if (n + 1 < T / 64) gdn_st_sx(L, (n + 1) & 1, ltid, P);
    if (((n + 3) & 3) == 0 && n + 3 < T / 64) unit_wait4(ws, b * 4 + h, (n + 3) >> 2);
    gdn_ld_sx(rs, b, h, n + 3 < T / 64 ? n + 3 : T / 64 - 1, ltid, P);
    if (FAST) VMW4(19, X.z); else VMW4(0, X.z);
    if (n > 0) gdn_post(ws, L, b, h, n - 1, lw, ltid & 63, X);
    gdn_ld_z(rs, b, h, n, lw, ltid & 63, X);
    __syncthreads();
    if (FAST) VMW4(19, X.su); else VMW4(0, X.su);
    if (n + 1 < T / 64) gdn_st_su(L, ltid, X);
    gdn_ld_su(rs, b, h, n + 2 < T / 64 ? n + 2 : T / 64 - 1, ltid, X);
    __syncthreads();
}
__device__ __forceinline__ void gdn_chain(const Args& a, Frame& F, int b, int h) {
    unsigned char* L = (unsigned char*)F.ldsf;
    unsigned char* ws = a.ws;
    int tid0 = F.tid; asm volatile("" : "+v"(tid0));
    const int lane = tid0 & 63, r32_ = lane & 31, hh_ = lane >> 5;
    const bool chain = F.wave < 4; const int vt = F.wave & 3;
    if (chain) {
        f32x16 S[4];
#pragma unroll
        for (int kt = 0; kt < 4; ++kt) S[kt] = zero16();
        __syncthreads();
        for (int n = 0; n < T / 64; n += 2) {
            int r32 = r32_, hh = hh_; asm volatile("" : "+v"(r32), "+v"(hh));
            gdn_chain_step(L, 0, vt, lane, r32, hh, S);
            gdn_chain_step(L, 1, vt, lane, r32, hh, S);
        }
        __syncthreads();
    } else {
        GdnSet A, B; GdnAux X;
        const int lt = tid0 - 256, lw = F.wave - 4;
        const __amdgpu_buffer_rsrc_t rs = mk_rsrc(ws, 0x10000000u);
        if (lt < 128) *(float*)(L + GNW + lt * 4) = a.in[14][lt];
        unit_wait4(ws, b * 4 + h, 0);
        gdn_ld_sx(rs, b, h, 0, lt, A); gdn_ld_su(rs, b, h, 0, lt, X); GDN_WAIT_SX(0, A); VMW4(0, X.su); gdn_st_sx(L, 0, lt, A); gdn_st_su(L, lt, X);
        gdn_ld_sx(rs, b, h, 1, lt, B); gdn_ld_sx(rs, b, h, 2, lt, A); gdn_ld_su(rs, b, h, 1, lt, X); gdn_ld_z(rs, b, h, 0, lw, lane, X);
        __syncthreads();
        for (int n = 0; n < 4; n += 2) {
            int ltid = lt; asm volatile("" : "+v"(ltid));
            gdn_loader_step<false>(rs, ws, L, b, h, n, lw, ltid, B, X);
            gdn_loader_step<false>(rs, ws, L, b, h, n + 1, lw, ltid, A, X);
        }
        for (int n = 4; n < T / 64; n += 2) {
            int ltid = lt; asm volatile("" : "+v"(ltid));
            gdn_loader_step<true>(rs, ws, L, b, h, n, lw, ltid, B, X);
            gdn_loader_step<true>(rs, ws, L, b, h, n + 1, lw, ltid, A, X);
        }
        VMW4(0, X.z);
        gdn_post(ws, L, b, h, T / 64 - 1, lw, lane, X);
        asm volatile("s_waitcnt vmcnt(0)" ::: "memory");
        __syncthreads();
    }
}

__device__ __forceinline__ void rwkv_prep_unit(const Args& a, Frame& F, int b, int n, int h, int pq, UnitPF& P, int qn, unsigned claim, volatile LAS unsigned* slot) {
    unsigned char* L = (unsigned char*)F.ldsf;
    constexpr int RM = 0, KM = 16384, VM = 32768;
    constexpr int KT = 0, KTT = 8192, BTI = 16384, KTIL = 24576, RT = 32768, VT = 40960;
    constexpr int LWI = 49152, LAI = 57344, LGI = 65536;
    constexpr int KHT = 49152, BHT = 57344, AKK = 65536, ARK = 73728;
    constexpr int LOGW = 81920, AA = 98560, CLS = 114944, MT = 115456;
    constexpr int LWS = 65;
    constexpr int GI = MT, ARBI = LOGW, WMI = AA;
    float* MTf = (float*)(L + MT); float* LOGWf = (float*)(L + LOGW); float* AAf = (float*)(L + AA); float* CLf = (float*)(L + CLS);
    int tid_ = F.tid; asm volatile("" : "+v"(tid_));
    const int R0 = b * T + n * 64, uid = ((b * 64 + n) << 3) + h, lane = tid_ & 63, r32 = lane & 31, hh = lane >> 5, hc0 = h * 64;
    unsigned char* ws = a.ws; unsigned char* dob = (unsigned char*)a.out;
    const bf16* COLS = (const bf16*)(ws + BIG_COLS); const bf16* HALO = (const bf16*)(ws + WS_HALO);
    unsigned char* colsb = ws + BIG_COLS;
    const __amdgpu_buffer_rsrc_t wrs = wt_rsrc(ws, 0x10000000u), wrd = wt_rsrc(dob, 0x04000000u);
    const float* mu = a.in[15]; const float* w0 = a.in[16]; const float* a0 = a.in[18]; const float* k_k = a.in[21]; const float* k_a = a.in[22]; const float* r_k = a.in[23];
#define SLOTR(part, o) (colsb + (size_t)(R0 + ((o) >> 7)) * (NCOLS * 2) + (2048 + (part) * 512 + hc0) * 2 + ((o) & 127))
#pragma unroll
    for (int i = 0; i < 7; ++i) {
        const int wi = F.wave + 8 * i, g8b = wi >> 3, tok = (wi & 7) * 8 + (lane >> 3), lc = (g8b * 8 + (lane & 7)) * 8;
        const int rc = g8b < 3 ? g8b * 512 + hc0 + (lc & 63) : 1536 + (lc - 192);
        const v4u cw = P.r[2 * i], pw = P.r[2 * i + 1];
        const float cur[8] = {bf_lo(cw.x), bf_hi(cw.x), bf_lo(cw.y), bf_hi(cw.y), bf_lo(cw.z), bf_hi(cw.z), bf_lo(cw.w), bf_hi(cw.w)};
        const float prv[8] = {bf_lo(pw.x), bf_hi(pw.x), bf_lo(pw.y), bf_hi(pw.y), bf_lo(pw.z), bf_hi(pw.z), bf_lo(pw.w), bf_hi(pw.w)};
        float v[8];
        { const f32x4 m0 = *(const f32x4*)(mu + rc), m1 = *(const f32x4*)(mu + rc + 4); const float mm[8] = {m0.x, m0.y, m0.z, m0.w, m1.x, m1.y, m1.z, m1.w};
#pragma unroll
          for (int e = 0; e < 8; ++e) v[e] = cur[e] + mm[e] * (prv[e] - cur[e]); }
        if (g8b < 3) { float* dst = (float*)(L + (g8b == 0 ? RM : (g8b == 1 ? KM : VM))) + tok * 64 + (lc & 63);
            *(f32x4*)dst = (f32x4){v[0], v[1], v[2], v[3]}; *(f32x4*)(dst + 4) = (f32x4){v[4], v[5], v[6], v[7]}; }
        else { const int idx = lc - 192;
            if (g8b == 3) {
#pragma unroll
                for (int e = 0; e < 8; ++e) v[e] = tanh_fast(v[e]);
            } else if (g8b >= 5) {
#pragma unroll
                for (int e = 0; e < 8; ++e) v[e] = sigmoidf_(v[e]);
            }
            v4u o; o.x = cvtpk(v[0], v[1]); o.y = cvtpk(v[2], v[3]); o.z = cvtpk(v[4], v[5]); o.w = cvtpk(v[6], v[7]);
            if (g8b == 3) *(v4u*)(L + LWI + tok * 128 + (((idx >> 3) ^ ((tok >> 1) & 7)) << 4)) = o;
            else if (g8b == 4) *(v4u*)(L + LAI + tok * 128 + ((((idx - 64) >> 3) ^ ((tok >> 1) & 7)) << 4)) = o;
            else *(v4u*)(L + LGI + tok * 256 + ((((idx - 128) >> 3) ^ (tok & 15)) << 4)) = o; }
    }
    unit_arrive(ws, pq, lane);
    __syncthreads();
    { const int wq = F.wave & 3, ti = wq >> 1, tj = wq & 1, t = 32 * ti + r32, j = 32 * tj + r32;
      const unsigned char* lwb = ws + RW_LW + ((size_t)(h * 64 + j) * 256) * 2;
      if (F.wave < 4) {
          f32x16 aw = zero16(), aa = zero16();
#pragma unroll
          for (int ks = 0; ks < 4; ++ks) { const int sw = ((2 * ks + hh) ^ ((t >> 1) & 7)) << 4;
              const bf16x8s Aw = *(const bf16x8s*)(L + LWI + t * 128 + sw), Aa = *(const bf16x8s*)(L + LAI + t * 128 + sw);
              const bf16x8s Bw = *(const bf16x8s*)(lwb + (16 * ks + 8 * hh) * 2), Ba = *(const bf16x8s*)(lwb + (64 + 16 * ks + 8 * hh) * 2);
              aw = MFMA32(Aw, Bw, aw); aa = MFMA32(Aa, Ba, aa); }
          const float w0j = w0[hc0 + j], a0j = a0[hc0 + j];
#pragma unroll
          for (int r = 0; r < 16; ++r) { const int tt = 32 * ti + crow(r, hh);
              LOGWf[j * LWS + tt] = -__expf(-softplus_fast(-(w0j + aw[r])) - 0.5f); AAf[tt * 64 + j] = sigmoidf_(a0j + aa[r]); }
      } else {
          f32x16 ag = zero16();
#pragma unroll
          for (int ks = 0; ks < 8; ++ks) { const bf16x8s Ag = *(const bf16x8s*)(L + LGI + t * 256 + (((2 * ks + hh) ^ (t & 15)) << 4));
              const bf16x8s Bg = *(const bf16x8s*)(lwb + (128 + 16 * ks + 8 * hh) * 2); ag = MFMA32(Ag, Bg, ag); }
#pragma unroll
          for (int r = 0; r < 16; ++r) { const int tt = 32 * ti + crow(r, hh); *(bf16*)(L + GI + tt * 128 + j * 2) = bf1(ag[r]); }
      }
    }
    __syncthreads();
    { const int o = tid_ * 16; const v4u x = *(const v4u*)(L + GI + o); wt16(wrs, (unsigned)(SLOTR(1, o) - ws), x); }
    {
#pragma unroll
      for (int q = 0; q < 8; ++q) { const int j = F.wave * 8 + q; float x = LOGWf[j * LWS + lane];
          x = wave_scan(x);
          LOGWf[j * LWS + lane] = x; if (lane == 63) CLf[j] = x; }
    }
    __syncthreads();
    const int et = tid_ >> 3, em = tid_ & 7, ej0 = em * 8;
    unsigned pk_kt[4], pk_bt[4], pk_ktil[4], pk_rt[4], pk_bh[4], pk_kh[4], pk_v[4], pk_bv[4];
    {
        float rr[8], kk_[8], vv[8], aa[8], cu[8], cp[8], cl[8];
        { const f32x4 x0 = *(const f32x4*)(L + RM + (et * 64 + ej0) * 4), x1 = *(const f32x4*)(L + RM + (et * 64 + ej0 + 4) * 4); rr[0] = x0.x; rr[1] = x0.y; rr[2] = x0.z; rr[3] = x0.w; rr[4] = x1.x; rr[5] = x1.y; rr[6] = x1.z; rr[7] = x1.w; }
        { const f32x4 x0 = *(const f32x4*)(L + KM + (et * 64 + ej0) * 4), x1 = *(const f32x4*)(L + KM + (et * 64 + ej0 + 4) * 4); kk_[0] = x0.x; kk_[1] = x0.y; kk_[2] = x0.z; kk_[3] = x0.w; kk_[4] = x1.x; kk_[5] = x1.y; kk_[6] = x1.z; kk_[7] = x1.w; }
        { const f32x4 x0 = *(const f32x4*)(L + VM + (et * 64 + ej0) * 4), x1 = *(const f32x4*)(L + VM + (et * 64 + ej0 + 4) * 4); vv[0] = x0.x; vv[1] = x0.y; vv[2] = x0.z; vv[3] = x0.w; vv[4] = x1.x; vv[5] = x1.y; vv[6] = x1.z; vv[7] = x1.w; }
        { const f32x4 x0 = *(const f32x4*)(AAf + et * 64 + ej0), x1 = *(const f32x4*)(AAf + et * 64 + ej0 + 4); aa[0] = x0.x; aa[1] = x0.y; aa[2] = x0.z; aa[3] = x0.w; aa[4] = x1.x; aa[5] = x1.y; aa[6] = x1.z; aa[7] = x1.w; }
#pragma unroll
        for (int e = 0; e < 8; ++e) { cu[e] = LOGWf[(ej0 + e) * LWS + et]; const float pv_ = LOGWf[(ej0 + e) * LWS + (et > 0 ? et - 1 : 0)]; cp[e] = et > 0 ? pv_ : 0.f; }
        { const f32x4 x0 = *(const f32x4*)(CLf + ej0), x1 = *(const f32x4*)(CLf + ej0 + 4); cl[0] = x0.x; cl[1] = x0.y; cl[2] = x0.z; cl[3] = x0.w; cl[4] = x1.x; cl[5] = x1.y; cl[6] = x1.z; cl[7] = x1.w; }
        float kkr[8], km2[8]; float ss = 0.f, bs = 0.f;
#pragma unroll
        for (int e = 0; e < 8; e += 4) { const int c = hc0 + ej0 + e; const f32x4 kk4 = *(const f32x4*)(k_k + c), ka4 = *(const f32x4*)(k_a + c), rk4 = *(const f32x4*)(r_k + c);
#pragma unroll
            for (int q = 0; q < 4; ++q) { kkr[e + q] = kk_[e + q] * kk4[q]; ss += kkr[e + q] * kkr[e + q]; km2[e + q] = kk_[e + q] * (1.0f + (aa[e + q] - 1.0f) * ka4[q]); bs += rr[e + q] * km2[e + q] * rk4[q]; } }
        ss = oct_sum(ss); bs = oct_sum(bs);
        const float rn = rsq_(ss + EPS);
        float o_kt[8], o_bt[8], o_ktil[8], o_rt[8], o_bh[8], o_kh[8], o_bv[8];
#pragma unroll
        for (int e = 0; e < 8; ++e) { const float kkn = kkr[e] * rn, kka = kkn * aa[e];
            const float eW = __expf(cu[e]), eWm1 = __expf(cp[e]), eWi = __expf(-cu[e]), eWC = __expf(cl[e] - cu[e]);
            o_kt[e] = kkn * eWm1; o_bt[e] = kka * eWi; o_ktil[e] = km2[e] * eWi; o_rt[e] = rr[e] * eW; o_bh[e] = kka * eWC; o_kh[e] = km2[e] * eWC; o_bv[e] = bs * vv[e]; }
#pragma unroll
        for (int q = 0; q < 4; ++q) { pk_kt[q] = cvtpk(o_kt[2 * q], o_kt[2 * q + 1]); pk_bt[q] = cvtpk(o_bt[2 * q], o_bt[2 * q + 1]); pk_ktil[q] = cvtpk(o_ktil[2 * q], o_ktil[2 * q + 1]); pk_rt[q] = cvtpk(o_rt[2 * q], o_rt[2 * q + 1]);
            pk_bh[q] = cvtpk(o_bh[2 * q], o_bh[2 * q + 1]); pk_kh[q] = cvtpk(o_kh[2 * q], o_kh[2 * q + 1]); pk_v[q] = cvtpk(vv[2 * q], vv[2 * q + 1]); pk_bv[q] = cvtpk(o_bv[2 * q], o_bv[2 * q + 1]); }
        if (tid_ < 64) wt4((float*)(ws + RW_WC) + (size_t)uid * 64 + tid_, __expf(CLf[tid_]));
    }
    __syncthreads();
    { const int sw = (em ^ ((et >> 1) & 7)) << 4;
      *(v4u*)(L + KT + et * 128 + sw) = (v4u){pk_kt[0], pk_kt[1], pk_kt[2], pk_kt[3]};
      *(v4u*)(L + BTI + et * 128 + sw) = (v4u){pk_bt[0], pk_bt[1], pk_bt[2], pk_bt[3]};
      *(v4u*)(L + KTIL + et * 128 + sw) = (v4u){pk_ktil[0], pk_ktil[1], pk_ktil[2], pk_ktil[3]};
      *(v4u*)(L + RT + et * 128 + sw) = (v4u){pk_rt[0], pk_rt[1], pk_rt[2], pk_rt[3]};
      const int pt = pi_(et);
#pragma unroll
      for (int e = 0; e < 8; ++e) { const int j = ej0 + e; const int sh = (e & 1) * 16; const int q = e >> 1;
          const int ad = j * 128 + (((et >> 3) ^ ((j >> 1) & 7)) << 4) + (et & 7) * 2;
          *(bf16*)(L + KTT + ad) = (bf16)(pk_kt[q] >> sh); *(bf16*)(L + VT + ad) = (bf16)(pk_v[q] >> sh); *(bf16*)(L + KHT + ad) = (bf16)(pk_kh[q] >> sh);
          *(bf16*)(L + BHT + j * 128 + (((pt >> 3) ^ ((j >> 1) & 7)) << 4) + (pt & 7) * 2) = (bf16)(pk_bh[q] >> sh); }
      const int cA = 2 * (em >> 1), swr = (et >> 1) & 7;
      wt8(SLOTR(0, et * 128 + ((cA ^ swr) << 4) + (em & 1) * 8), (v2u){pk_rt[0], pk_rt[1]});
      wt8(SLOTR(0, et * 128 + (((cA + 1) ^ swr) << 4) + (em & 1) * 8), (v2u){pk_rt[2], pk_rt[3]});
      wt16(wrs, (unsigned)(SLOTR(2, et * 128 + ej0 * 2) - ws), (v4u){pk_bv[0], pk_bv[1], pk_bv[2], pk_bv[3]});
    }
    __syncthreads();
    { const v4u x = *(const v4u*)(L + BHT + tid_ * 16); wt16(wrd, (unsigned)(DO_BT + (size_t)uid * 8192 + tid_ * 16), x); }
#pragma unroll
    for (int rep = 0; rep < 2; ++rep) { const int q = F.wave + 8 * rep, pr = q >> 2, ti = (q >> 1) & 1, tj = q & 1, t = 32 * ti + r32, s2 = 32 * tj + r32;
        f32x16 acc = zero16();
        if (!(ti == 0 && tj == 1)) {
            const unsigned char* Ab = L + (pr < 2 ? KT : RT) + t * 128; const unsigned char* Bb = L + ((pr & 1) ? KTIL : BTI) + s2 * 128;
#pragma unroll
            for (int ks = 0; ks < 4; ++ks) { const bf16x8s A = *(const bf16x8s*)(Ab + (((2 * ks + hh) ^ ((t >> 1) & 7)) << 4)); const bf16x8s B = *(const bf16x8s*)(Bb + (((2 * ks + hh) ^ ((s2 >> 1) & 7)) << 4)); acc = MFMA32(A, B, acc); }
        }
        const int ps = pi_(s2);
#pragma unroll
        for (int r = 0; r < 16; ++r) { const int tt = 32 * ti + crow(r, hh);
            if (pr == 0) MTf[tt * 68 + s2] = (tt > s2) ? acc[r] : 0.f;
            else if (pr == 1) *(bf16*)(L + AKK + img128(tt, s2)) = bf1((tt > s2) ? acc[r] : 0.f);
            else if (pr == 2) *(bf16*)(L + ARBI + img128(tt, ps)) = bf1((tt >= s2) ? acc[r] : 0.f);
            else *(bf16*)(L + ARK + img128(tt, s2)) = bf1((tt >= s2) ? acc[r] : 0.f); }
    }
    __syncthreads();
    { const v4u x = *(const v4u*)(L + ARBI + tid_ * 16); wt16(wrd, (unsigned)(DO_ARB + (size_t)uid * 8192 + tid_ * 16), x); }
    f32x16 x1a = zero16(), x1b = zero16();
    if (tid_ == 0) *slot = claim;
    unit_issue_main(a, tid_, qn, P);
    if (F.wave == 0) tri_inverse64(MTf, lane);
    else if (F.wave < 5) { const int tj = (F.wave - 1) & 1, vcol = 32 * tj + r32;
#pragma unroll
        for (int ks = 0; ks < 4; ++ks) { const bf16x8s B = *(const bf16x8s*)(L + VT + vcol * 128 + (((2 * ks + hh) ^ ((vcol >> 1) & 7)) << 4));
            const int ta = r32, tb = 32 + r32;
            const bf16x8s Aa = *(const bf16x8s*)(L + AKK + ta * 128 + (((2 * ks + hh) ^ ((ta >> 1) & 7)) << 4)), Ab = *(const bf16x8s*)(L + AKK + tb * 128 + (((2 * ks + hh) ^ ((tb >> 1) & 7)) << 4));
            x1a = MFMA32(Aa, B, x1a); x1b = MFMA32(Ab, B, x1b); }
    } else {
#pragma unroll
        for (int rep = 0; rep < 3; ++rep) { const int idx = (F.wave - 5) + 3 * rep;
            if (idx < 8) { const bool isds = idx >= 4; const int q = idx & 3, ti = q >> 1, tj = q & 1, arow = 32 * ti + r32, vcol = 32 * tj + r32;
                const unsigned char* Ab = L + (isds ? KHT : ARK) + arow * 128; const unsigned char* Bb = L + VT + vcol * 128;
                f32x16 acc = zero16();
#pragma unroll
                for (int ks = 0; ks < 4; ++ks) { const bf16x8s A = *(const bf16x8s*)(Ab + (((2 * ks + hh) ^ ((arow >> 1) & 7)) << 4)); const bf16x8s B = *(const bf16x8s*)(Bb + (((2 * ks + hh) ^ ((vcol >> 1) & 7)) << 4)); acc = MFMA32(A, B, acc); }
                v4u u0, u1; u0.x = cvtpk(acc[0], acc[1]); u0.y = cvtpk(acc[2], acc[3]); u0.z = cvtpk(acc[4], acc[5]); u0.w = cvtpk(acc[6], acc[7]);
                u1.x = cvtpk(acc[8], acc[9]); u1.y = cvtpk(acc[10], acc[11]); u1.z = cvtpk(acc[12], acc[13]); u1.w = cvtpk(acc[14], acc[15]);
                const unsigned dst = (unsigned)((isds ? RW_DS : RW_YL) + (size_t)uid * 8192 + ((ti * 2 + tj) * 64 + lane) * 32);
                wt16(wrs, dst, u0); wt16(wrs, dst + 16, u1); } }
    }
    __syncthreads();
    if (F.wave >= 1 && F.wave < 5) { const int ti = (F.wave - 1) >> 1, tj = (F.wave - 1) & 1, t = 32 * ti + r32;
        f32x16 acc = zero16();
#pragma unroll
        for (int ts = 0; ts < 2; ++ts)
#pragma unroll
            for (int s = 0; s < 2; ++s) { const float* tp = MTf + t * 68 + 32 * ts + 16 * s + 4 * hh; const f32x4 t0 = *(const f32x4*)tp, t1 = *(const f32x4*)(tp + 8);
                v4u pa; pa.x = cvtpk(t0.x, t0.y); pa.y = cvtpk(t0.z, t0.w); pa.z = cvtpk(t1.x, t1.y); pa.w = cvtpk(t1.z, t1.w);
                const bf16x8s Bx = ts ? pack8(x1b, s) : pack8(x1a, s);
                acc = MFMA32(__builtin_bit_cast(bf16x8s, pa), Bx, acc); }
        v4u u0, u1; u0.x = cvtpk(-acc[0], -acc[1]); u0.y = cvtpk(-acc[2], -acc[3]); u0.z = cvtpk(-acc[4], -acc[5]); u0.w = cvtpk(-acc[6], -acc[7]);
        u1.x = cvtpk(-acc[8], -acc[9]); u1.y = cvtpk(-acc[10], -acc[11]); u1.z = cvtpk(-acc[12], -acc[13]); u1.w = cvtpk(-acc[14], -acc[15]);
        const unsigned dst = (unsigned)(DO_U + (size_t)uid * 8192 + ((ti * 2 + tj) * 64 + lane) * 32);
        wt16(wrd, dst, u0); wt16(wrd, dst + 16, u1);
    } else { const int idx = F.wave == 0 ? 3 : F.wave - 5, ti = idx >> 1, tj = idx & 1, t = 32 * ti + r32, j = 32 * tj + r32;
        f32x16 acc = zero16();
#pragma unroll
        for (int ks = 0; ks < 4; ++ks) { const float* tp = MTf + t * 68 + 16 * ks + 8 * hh; const f32x4 t0 = *(const f32x4*)tp, t1 = *(const f32x4*)(tp + 4);
            v4u pa; pa.x = cvtpk(t0.x, t0.y); pa.y = cvtpk(t0.z, t0.w); pa.z = cvtpk(t1.x, t1.y); pa.w = cvtpk(t1.z, t1.w);
            const bf16x8s B = *(const bf16x8s*)(L + KTT + j * 128 + (((2 * ks + hh) ^ ((j >> 1) & 7)) << 4));
            acc = MFMA32(__builtin_bit_cast(bf16x8s, pa), B, acc); }
        unsigned char* wm = L + WMI; const int pj = pi_(j);
#pragma unroll
        for (int r = 0; r < 16; ++r) { const int tt = 32 * ti + crow(r, hh); *(bf16*)(wm + img128(tt, pj)) = bf1(-acc[r]); }
    }
    __syncthreads();
    { const v4u x = *(const v4u*)(L + WMI + tid_ * 16); wt16(wrd, (unsigned)(DO_WM + (size_t)uid * 8192 + tid_ * 16), x); }
#undef SLOTR
}

constexpr int RSTG = 57600;
constexpr int ROB = 2 * RSTG, ROBS = 68, RLN = ROB + 17408;
struct RwSet { v4u sx[15]; };
__device__ __forceinline__ void rwkv_ld_sx(__amdgpu_buffer_rsrc_t rs, __amdgpu_buffer_rsrc_t rd, int b, int h, int n, int ltid, RwSet& S) {
    const int R0 = b * T + n * 64, uid = ((b * 64 + n) << 3) + h;
    const unsigned uo = (unsigned)uid * 8192u, os = (unsigned)(BIG_COLS + (size_t)R0 * (NCOLS * 2) + (2048 + h * 64) * 2);
    const unsigned l16 = (unsigned)ltid * 16u, lsl = (l16 >> 7) * (unsigned)(NCOLS * 2) + (l16 & 127u);
#pragma unroll
    for (int i = 0; i < 2; ++i) { const unsigned c = 4096u * i;
        aload16(S.sx[i], rd, l16, (unsigned)DO_WM + uo + c); aload16(S.sx[2 + i], rs, lsl, os + (unsigned)(i * 32 * NCOLS * 2)); aload16(S.sx[4 + i], rd, l16, (unsigned)DO_BT + uo + c); aload16(S.sx[6 + i], rd, l16, (unsigned)DO_ARB + uo + c);
        aload16(S.sx[8 + i], rd, l16, (unsigned)DO_U + uo + c); aload16(S.sx[10 + i], rs, l16, (unsigned)RW_YL + uo + c); aload16(S.sx[12 + i], rs, l16, (unsigned)RW_DS + uo + c); }
    aload16(S.sx[14], rs, (unsigned)((ltid & 15) * 16), (unsigned)RW_WC + (unsigned)uid * 256u);
}
#define RW_WAIT_SX(N, S) asm volatile("s_waitcnt vmcnt(" #N ")" : "+v"((S).sx[0]), "+v"((S).sx[1]), "+v"((S).sx[2]), "+v"((S).sx[3]), "+v"((S).sx[4]), "+v"((S).sx[5]), "+v"((S).sx[6]), "+v"((S).sx[7]), \
    "+v"((S).sx[8]), "+v"((S).sx[9]), "+v"((S).sx[10]), "+v"((S).sx[11]), "+v"((S).sx[12]), "+v"((S).sx[13]), "+v"((S).sx[14]) :: "memory")
__device__ __forceinline__ void rwkv_st_sx(unsigned char* L, int stg, int ltid, const RwSet& S) {
#pragma unroll
    for (int i = 0; i < 14; ++i) *(v4u*)(L + stg * RSTG + (ltid + 256 * i) * 16) = S.sx[i];
    if (ltid < 16) *(v4u*)(L + stg * RSTG + 57344 + ltid * 16) = S.sx[14];
}
__device__ __forceinline__ void rwkv_ld_gb(__amdgpu_buffer_rsrc_t rs, int b, int h, int n, int lw, int lane, v4u (&gb)[4]) {
    const unsigned voff = (unsigned)((lw * 16 + (lane >> 2)) * (NCOLS * 2) + (lane & 3) * 16);
    const unsigned so = (unsigned)(BIG_COLS + (size_t)(b * T + n * 64) * (NCOLS * 2) + (2048 + 512 + h * 64) * 2);
    aload16(gb[0], rs, voff, so); aload16(gb[1], rs, voff, so + 64u); aload16(gb[2], rs, voff, so + 1024u); aload16(gb[3], rs, voff, so + 1088u);
}
__device__ __forceinline__ void rwkv_post(unsigned char* ws, const float* OBf, int b, int h, int n, int lw, int lane, const v4u (&gbv)[4]) {
    const int tok = lw * 16 + (lane >> 2), part = lane & 3, hc = h * 64 + 8 * part; const size_t row = (size_t)(b * T + n * 64 + tok);
    bf16* op = (bf16*)(ws + WS_H) + row * D + 512 + hc;
    const v4u g0 = gbv[0], g1 = gbv[1], b0 = gbv[2], b1 = gbv[3];
    f32x4 y[4]; float sm = 0.f;
#pragma unroll
    for (int q = 0; q < 4; ++q) { y[q] = *(const f32x4*)(OBf + tok * ROBS + 8 * part + 32 * (q >> 1) + 4 * (q & 1)); sm += (y[q].x + y[q].y) + (y[q].z + y[q].w); }
    sm = quad_sum(sm);
    const float mean = sm * (1.0f / 64.0f); float sq = 0.f;
#pragma unroll
    for (int q = 0; q < 4; ++q) { y[q] = y[q] - mean; sq += (y[q].x * y[q].x + y[q].y * y[q].y) + (y[q].z * y[q].z + y[q].w * y[q].w); }
    sq = quad_sum(sq);
    const float rs = rsq_(sq * (1.0f / 64.0f) + 64e-5f);
    const float gg[16] = {bf_lo(g0.x), bf_hi(g0.x), bf_lo(g0.y), bf_hi(g0.y), bf_lo(g0.z), bf_hi(g0.z), bf_lo(g0.w), bf_hi(g0.w), bf_lo(g1.x), bf_hi(g1.x), bf_lo(g1.y), bf_hi(g1.y), bf_lo(g1.z), bf_hi(g1.z), bf_lo(g1.w), bf_hi(g1.w)};
    const float bb[16] = {bf_lo(b0.x), bf_hi(b0.x), bf_lo(b0.y), bf_hi(b0.y), bf_lo(b0.z), bf_hi(b0.z), bf_lo(b0.w), bf_hi(b0.w), bf_lo(b1.x), bf_hi(b1.x), bf_lo(b1.y), bf_hi(b1.y), bf_lo(b1.z), bf_hi(b1.z), bf_lo(b1.w), bf_hi(b1.w)};
    float ov[16];
#pragma unroll
    for (int q = 0; q < 4; ++q) { const int co = 8 * part + 32 * (q >> 1) + 4 * (q & 1); const f32x4 lw4 = *(const f32x4*)(OBf + 64 * ROBS + co), lb4 = *(const f32x4*)(OBf + 64 * ROBS + 64 + co);
        ov[4 * q] = (y[q].x * rs * lw4.x + lb4.x + bb[4 * q]) * gg[4 * q]; ov[4 * q + 1] = (y[q].y * rs * lw4.y + lb4.y + bb[4 * q + 1]) * gg[4 * q + 1];
        ov[4 * q + 2] = (y[q].z * rs * lw4.z + lb4.z + bb[4 * q + 2]) * gg[4 * q + 2]; ov[4 * q + 3] = (y[q].w * rs * lw4.w + lb4.w + bb[4 * q + 3]) * gg[4 * q + 3]; }
    v4u r0, r1; r0.x = cvtpk(ov[0], ov[1]); r0.y = cvtpk(ov[2], ov[3]); r0.z = cvtpk(ov[4], ov[5]); r0.w = cvtpk(ov[6], ov[7]); r1.x = cvtpk(ov[8], ov[9]); r1.y = cvtpk(ov[10], ov[11]); r1.z = cvtpk(ov[12], ov[13]); r1.w = cvtpk(ov[14], ov[15]);
    *(v4u*)op = r0; *(v4u*)(op + 32) = r1;
}
__device__ __forceinline__ void rwkv_chain_step(unsigned char* L, int stg, int vt, int lane, int r32, int hh, f32x16 (&Z)[2]) {
    const unsigned char* st = L + stg * RSTG; const float* wc = (const float*)(st + 57344); float* OBf = (float*)(L + ROB);
    f32x16 P[2], Y[2];
#pragma unroll
    for (int rb = 0; rb < 2; ++rb) { const int o = ((rb * 2 + vt) * 64 + lane) * 32;
        P[rb] = unpack16(*(const v4u*)(st + 32768 + o), *(const v4u*)(st + 32768 + o + 16)); Y[rb] = unpack16(*(const v4u*)(st + 40960 + o), *(const v4u*)(st + 40960 + o + 16)); }
#define R_OFF(row, q) ((row) * 128 + ((((q) + hh) ^ (((row) >> 1) & 7)) << 4))
    bf16x8s aw[4], ar[4];
#pragma unroll
    for (int j = 0; j < 3; ++j) { aw[j] = ldfrag(st + R_OFF(32 * (j >> 2) + r32, 2 * (j & 3))); ar[j] = ldfrag(st + 8192 + R_OFF(32 * (j >> 2) + r32, 2 * (j & 3))); }
    bf16x8s Zb[2][2];
#pragma unroll
    for (int kt = 0; kt < 2; ++kt) { Zb[kt][0] = pack8(Z[kt], 0); Zb[kt][1] = pack8(Z[kt], 1); }
    SB0();
#pragma unroll
    for (int j = 0; j < 8; ++j) { const int rb = j >> 2, kt = (j >> 1) & 1, s2 = j & 1;
        if (j + 3 < 8) { aw[(j + 3) & 3] = ldfrag(st + R_OFF(32 * ((j + 3) >> 2) + r32, 2 * ((j + 3) & 3))); ar[(j + 3) & 3] = ldfrag(st + 8192 + R_OFF(32 * ((j + 3) >> 2) + r32, 2 * ((j + 3) & 3))); }
        SB0();
        P[rb] = MFMA32(aw[j & 3], Zb[kt][s2], P[rb]); Y[rb] = MFMA32(ar[j & 3], Zb[kt][s2], Y[rb]);
        SB0(); }
    bf16x8s at[6];
    { const int t0 = r32, t1 = 32 + r32;
      at[0] = ldfrag(st + 24576 + R_OFF(t0, 0)); at[1] = ldfrag(st + 24576 + R_OFF(t0, 2)); at[2] = ldfrag(st + 24576 + R_OFF(t1, 0)); at[3] = ldfrag(st + 24576 + R_OFF(t1, 2)); at[4] = ldfrag(st + 24576 + R_OFF(t1, 4)); at[5] = ldfrag(st + 24576 + R_OFF(t1, 6)); }
    bf16x8s ak[4];
#pragma unroll
    for (int j = 0; j < 3; ++j) ak[j] = ldfrag(st + 16384 + R_OFF(32 * (j >> 2) + r32, 2 * (j & 3)));
    bf16x8s Pb[2][2];
#pragma unroll
    for (int rb = 0; rb < 2; ++rb) { Pb[rb][0] = pack8(P[rb], 0); Pb[rb][1] = pack8(P[rb], 1); }
#pragma unroll
    for (int kt = 0; kt < 2; ++kt) { const int o = ((kt * 2 + vt) * 64 + lane) * 32;
        const f32x16 dS = unpack16(*(const v4u*)(st + 49152 + o), *(const v4u*)(st + 49152 + o + 16));
#pragma unroll
        for (int r = 0; r < 16; ++r) Z[kt][r] = Z[kt][r] * wc[32 * kt + crow(r, hh)] + dS[r]; }
    Y[0] = MFMA32(at[0], Pb[0][0], Y[0]); Y[0] = MFMA32(at[1], Pb[0][1], Y[0]);
    Y[1] = MFMA32(at[2], Pb[0][0], Y[1]); Y[1] = MFMA32(at[3], Pb[0][1], Y[1]); Y[1] = MFMA32(at[4], Pb[1][0], Y[1]); Y[1] = MFMA32(at[5], Pb[1][1], Y[1]);
    SB0();
#pragma unroll
    for (int j = 0; j < 8; ++j) { const int kt = j >> 2, rb2 = (j >> 1) & 1, s2 = j & 1;
        if (j + 3 < 8) ak[(j + 3) & 3] = ldfrag(st + 16384 + R_OFF(32 * ((j + 3) >> 2) + r32, 2 * ((j + 3) & 3)));
        SB0();
        Z[kt] = MFMA32(ak[j & 3], Pb[rb2][s2], Z[kt]);
        SB0(); }
    __syncthreads();
#pragma unroll
    for (int rb = 0; rb < 2; ++rb)
#pragma unroll
        for (int r = 0; r < 16; ++r) OBf[(32 * rb + crow(r, hh)) * ROBS + 32 * vt + r32] = Y[rb][r];
    __syncthreads();
#undef R_OFF
}
template <bool FAST>
__device__ __forceinline__ void rwkv_loader_step(__amdgpu_buffer_rsrc_t rs, __amdgpu_buffer_rsrc_t rd, unsigned char* ws, unsigned char* L, int b, int h, int n, int lw, int ltid, RwSet& P, v4u (&gb)[4]) {
    if (FAST) RW_WAIT_SX(23, P); else RW_WAIT_SX(0, P);
    if (n + 1 < T / 64) rwkv_st_sx(L, (n + 1) & 1, ltid, P);
    if (((n + 3) & 3) == 0 && n + 3 < T / 64) unit_wait4(ws, 16 + b * 8 + h, (n + 3) >> 2);
    rwkv_ld_sx(rs, rd, b, h, n + 3 < T / 64 ? n + 3 : T / 64 - 1, ltid, P);
    if (FAST) VMW4(15, gb); else VMW4(0, gb);
    if (n > 0) rwkv_post(ws, (const float*)(L + ROB), b, h, n - 1, lw, ltid & 63, gb);
    rwkv_ld_gb(rs, b, h, n, lw, ltid & 63, gb);
    __syncthreads();
    __syncthreads();
}
__device__ __forceinline__ void rwkv_chain(const Args& a, Frame& F, int b, int h) {
    unsigned char* L = (unsigned char*)F.ldsf;
    unsigned char* ws = a.ws; unsigned char* dob = (unsigned char*)a.out;
    int tid0 = F.tid; asm volatile("" : "+v"(tid0));
    const int lane = tid0 & 63, r32_ = lane & 31, hh_ = lane >> 5;
    const bool chain = F.wave < 2, loader = F.wave >= 4; const int vt = F.wave & 1;
    if (chain) {
        f32x16 Z[2]; Z[0] = zero16(); Z[1] = zero16();
        __syncthreads();
        for (int n = 0; n < T / 64; n += 2) {
            int r32 = r32_, hh = hh_; asm volatile("" : "+v"(r32), "+v"(hh));
            rwkv_chain_step(L, 0, vt, lane, r32, hh, Z);
            rwkv_chain_step(L, 1, vt, lane, r32, hh, Z);
        }
        __syncthreads();
    } else if (loader) {
        RwSet A, B; v4u gb[4];
        const int lt = tid0 - 256, lw = F.wave - 4;
        const __amdgpu_buffer_rsrc_t rs = mk_rsrc(ws, 0x10000000u), rd = mk_rsrc(dob, 0x04000000u);
        if (lt < 128) *(float*)(L + RLN + lt * 4) = lt < 64 ? a.in[24][h * 64 + lt] : a.in[25][h * 64 + lt - 64];
        unit_wait4(ws, 16 + b * 8 + h, 0);
        rwkv_ld_sx(rs, rd, b, h, 0, lt, A); RW_WAIT_SX(0, A); rwkv_st_sx(L, 0, lt, A);
        rwkv_ld_sx(rs, rd, b, h, 1, lt, B); rwkv_ld_sx(rs, rd, b, h, 2, lt, A); rwkv_ld_gb(rs, b, h, 0, lw, lane, gb);
        __syncthreads();
        for (int n = 0; n < 4; n += 2) {
            int ltid = lt; asm volatile("" : "+v"(ltid));
            rwkv_loader_step<false>(rs, rd, ws, L, b, h, n, lw, ltid, B, gb);
            rwkv_loader_step<false>(rs, rd, ws, L, b, h, n + 1, lw, ltid, A, gb);
        }
        for (int n = 4; n < T / 64; n += 2) {
            int ltid = lt; asm volatile("" : "+v"(ltid));
            rwkv_loader_step<true>(rs, rd, ws, L, b, h, n, lw, ltid, B, gb);
            rwkv_loader_step<true>(rs, rd, ws, L, b, h, n + 1, lw, ltid, A, gb);
        }
        VMW4(0, gb);
        rwkv_post(ws, (const float*)(L + ROB), b, h, T / 64 - 1, lw, lane, gb);
        asm volatile("s_waitcnt vmcnt(0)" ::: "memory");
        __syncthreads();
    } else {
        __syncthreads();
        for (int n = 0; n < T / 64; ++n) { __syncthreads(); __syncthreads(); }
        __syncthreads();
    }
}

__device__ __forceinline__ float gelu_tanh_fast(float x) { const float u = 0.7978845608028654f * (x + 0.044715f * x * x * x); return 0.5f * x * (1.0f + tanh_fast(u)); }
__device__ __forceinline__ float gelu_tanh(float x) { const float u = 0.7978845608028654f * (x + 0.044715f * x * x * x); return 0.5f * x * (1.0f + tanhf(u)); }

__global__ void __launch_bounds__(NWAVES * 64, 2) fwd(Args args) {
    extern __shared__ __attribute__((aligned(16))) unsigned char lds[];
    Frame F;
    F.lds = (LAS unsigned char*)lds; F.ldsf = (float*)lds;
    F.MISC = (volatile LAS unsigned*)(F.lds + MISC_OFF);
    F.tid = threadIdx.x; F.lane = F.tid & 63; F.wave = __builtin_amdgcn_readfirstlane(F.tid >> 6);
    F.G = gridDim.x; { const int bx = blockIdx.x; F.vcu = (F.G % 8 == 0) ? (bx % 8) * (F.G / 8) + bx / 8 : bx; }
    F.ws = args.ws; F.out = args.out;
    F.ctl = (gu32*)(args.ws + WS_CTL);
    for (int u = F.tid; u < (LDS_BYTES - LDSCTL_OFF) / 4; u += NWAVES * 64) ((LAS unsigned*)(F.lds + LDSCTL_OFF))[u] = 0u;
    __syncthreads();
    XcdBarrier bar; bar.bar = (unsigned*)(F.ctl + CW_BAR); bar.x = 0; bar.st = nullptr;
    if (N_LAUNCHES != PER_PHASE) bar = xcd_barrier_post((unsigned*)(F.ctl + CW_BAR), F.MISC + 8);
#define GRID_BAR() do { if (N_LAUNCHES != PER_PHASE) xcd_barrier(bar); } while (0)
    const int lo = args.ph_lo, hi = args.ph_hi;
#ifdef PROBE_A0
    unsigned long long* tsb = (unsigned long long*)(args.ws + 32768);
#define STAMP(k) do { if (blockIdx.x == 0 && threadIdx.x == 0) tsb[k] = __builtin_amdgcn_s_memrealtime(); } while (0)
#else
#define STAMP(k) do {} while (0)
#endif
#ifndef PHMASK
#define PHMASK 0xFFFFFFFFu
#endif
#define IN(k) (((PHMASK >> (k)) & 1u) && lo <= (k) && (k) < hi)
#define BOTH(k) (IN(k) && IN((k) + 1))
    const int gw = F.vcu * NWAVES + F.wave, NGW = F.G * NWAVES;
    unsigned char* ws0 = args.ws;
#define PHASE_WS unsigned ws_lo_ = __builtin_amdgcn_readfirstlane((unsigned)(unsigned long long)ws0), ws_hi_ = __builtin_amdgcn_readfirstlane((unsigned)((unsigned long long)ws0 >> 32)); asm volatile("" : "+s"(ws_lo_), "+s"(ws_hi_)); unsigned char* ws = (unsigned char*)(__attribute__((address_space(1))) unsigned char*)(((unsigned long long)ws_hi_ << 32) | ws_lo_)
#define PHASE_WS_FLAT unsigned ws_lo_ = __builtin_amdgcn_readfirstlane((unsigned)(unsigned long long)ws0), ws_hi_ = __builtin_amdgcn_readfirstlane((unsigned)((unsigned long long)ws0 >> 32)); asm volatile("" : "+s"(ws_lo_), "+s"(ws_hi_)); unsigned char* ws = (unsigned char*)(((unsigned long long)ws_hi_ << 32) | ws_lo_)

    const bool adaln_split = (args.ph_lo == 0 && args.ph_hi > 5 && F.G == 256);
    const int n_ad0 = adaln_split ? 12 * NKC : 48 * NKC;
    bool conv1_done = false;
    if (IN(0)) { PHASE_WS; STAMP(0);
        float* scr = F.ldsf + F.wave * 4096;
        for (int it = gw; it < 1920 + n_ad0; it += NGW) { if (it < n_ad0) adaln_item(args, it, scr, F.lane); else convert_item0(args, it - n_ad0, scr, F.lane); }
        { bf16* LWt = (bf16*)(ws + RW_LW); for (int i = gw * 64 + F.lane; i < 8 * 64 * 256; i += NGW * 64) { const int ii = i & 255, j = (i >> 8) & 63, hh = i >> 14; const int col = hh * 64 + j;
            const float v = ii < 64 ? args.in[17][ii * 512 + col] : (ii < 128 ? args.in[19][(ii - 64) * 512 + col] : args.in[20][(ii - 128) * 512 + col]); LWt[i] = bf1(v); } }
        { float* WSP = (float*)(ws + WS_WSPEC); for (int i = gw * 64 + F.lane; i < 8 * D; i += NGW * 64) { const int c = i / D, k = i % D; WSP[i] = args.in[9][(size_t)k * WIN_LD + 2048 + c]; } }
        { float* SPL = (float*)(ws + WS_SPL); for (int i = gw * 64 + F.lane; i < D; i += NGW * 64) SPL[i] = -8.0f * softplusf_(-args.in[33][i]); }
        if (BOTH(0)) GRID_BAR();
    }
    if (IN(1)) { PHASE_WS; STAMP(1);
        { float* MODS = (float*)(ws + WS_MODS); for (int i = gw * 64 + F.lane; i < (adaln_split ? 4 : 16) * 3072; i += NGW * 64) { const int n = i % 3072, cb = i / 3072; MODS[i] = mod_from_partials(args, cb >> 2, cb & 3, n); } }
        row_pass<0>(args, F, args.in[0], nullptr, nullptr, 0, nullptr, 0, args.in[2]);
        if (BOTH(1)) GRID_BAR();
    }
    if (IN(2)) { PHASE_WS; STAMP(2);
        pg8::Gemm g{(const bf16*)(ws + WS_H), (const bf16*)(ws + WB_IN), D, D, D, 0}; pg8::StaticOrder S; S.init(M, NCOLS, F.G, (int)blockIdx.x);
        pg8::EpiBf16Halo E{(bf16*)(ws + BIG_COLS), NCOLS, (bf16*)(ws + WS_HALO)};
        pg8::gemm_phase<pg8::EpiBf16Halo>(F.lds + RING_OFF, g, S, E);
        if (adaln_split && blockIdx.x >= 192) { __syncthreads(); float* scr = F.ldsf + F.wave * 4096;
            for (int it = 12 * NKC + ((int)blockIdx.x - 192) * NWAVES + F.wave; it < 48 * NKC; it += 64 * NWAVES) adaln_item(args, it, scr, F.lane); }
        if (BOTH(2)) GRID_BAR();
    }
    if (IN(3)) { PHASE_WS_FLAT; STAMP(3);
        {
            const int limit = F.vcu < 16 ? 1 : (F.vcu < 48 ? 4 : (1 << 30));
            int pq = -1;
            unsigned* qc = (unsigned*)(ws + WS_QCTR);
            if (F.tid == 0) { const unsigned c0 = __hip_atomic_fetch_add(qc, 1u, __ATOMIC_RELAXED, __HIP_MEMORY_SCOPE_AGENT), c1 = limit > 1 ? __hip_atomic_fetch_add(qc, 1u, __ATOMIC_RELAXED, __HIP_MEMORY_SCOPE_AGENT) : 0x7fffffffu; F.MISC[32] = c0; F.MISC[33] = c1; }
            __syncthreads();
            int q = (int)__builtin_amdgcn_readfirstlane(F.MISC[32]), qn = (int)__builtin_amdgcn_readfirstlane(F.MISC[33]);
            UnitPF P; unit_issue_main(args, F.tid, q < 3072 ? q : -1, P);
            for (int i = 0; q < 3072; ++i) { const int n = q / 48, r = q % 48;
                unsigned claim = 0x7fffffffu; if (F.tid == 0 && i + 2 < limit) claim = __hip_atomic_fetch_add(qc, 1u, __ATOMIC_RELAXED, __HIP_MEMORY_SCOPE_AGENT);
                if (r < 16) gdn_prep_unit(args, F, r >> 2, n, r & 3, pq, P, qn < 3072 ? qn : -1, claim, F.MISC + 32 + (i & 1)); else rwkv_prep_unit(args, F, (r - 16) >> 3, n, (r - 16) & 7, pq, P, qn < 3072 ? qn : -1, claim, F.MISC + 32 + (i & 1));
                pq = q; q = qn; qn = (int)__builtin_amdgcn_readfirstlane(F.MISC[32 + (i & 1)]); }
            unit_arrive(ws, pq, F.lane);
        }
        if (F.vcu < 48) { __syncthreads(); STAMP(19); if (F.vcu < 16) gdn_chain(args, F, F.vcu >> 2, F.vcu & 3); else rwkv_chain(args, F, (F.vcu - 16) >> 3, (F.vcu - 16) & 7); }
        else { float* scr = F.ldsf + F.wave * 4096; for (int it = (F.vcu - 48) * NWAVES + F.wave; it < N_CONV_ITEMS0 - 1920; it += (F.G - 48) * NWAVES) convert_item0(args, 1920 + it, scr, F.lane);
            if (adaln_split) { float* MODS = (float*)(ws + WS_MODS); for (int i = 4 * 3072 + (F.vcu - 48) * (NWAVES * 64) + F.tid; i < 16 * 3072; i += (F.G - 48) * (NWAVES * 64)) { const int n = i % 3072, cb = i / 3072; MODS[i] = mod_from_partials(args, cb >> 2, cb & 3, n); } } }
        if (BOTH(3)) GRID_BAR();
    }
    if (IN(4)) { PHASE_WS; STAMP(4);
        pg8::Gemm g{(const bf16*)(ws + WS_H), (const bf16*)(ws + WB_OUT), D, D, D, 0}; pg8::StaticOrder S; S.init(M, D, F.G, (int)blockIdx.x);
        pg8::EpiBf16 E{(bf16*)(ws + BIG_Y0), D};
        pg8::gemm_phase<pg8::EpiBf16>(F.lds + RING_OFF, g, S, E);
        if (BOTH(4)) GRID_BAR();
    }
    if (IN(5)) { PHASE_WS; STAMP(5); row_pass<1, false, true>(args, F, args.in[0], ws + WS_XR, (const bf16*)(ws + BIG_Y0), 0, args.in[3] + 0 * D, 1, args.in[2] + 1 * D); if (BOTH(5)) GRID_BAR(); }
    if (IN(6)) { PHASE_WS; STAMP(6);
        pg8::Gemm g{(const bf16*)(ws + WS_H), (const bf16*)(ws + WB_GU0), D, D, D, 0}; pg8::StaticOrder S; S.init(M, 2 * FF, F.G, (int)blockIdx.x);
        pg8::EpiSwiGLU E{(bf16*)(ws + BIG_ACT), FF};
        pg8::gemm_phase<pg8::EpiSwiGLU>(F.lds + RING_OFF, g, S, E);
        if (args.ph_lo <= 6 && args.ph_hi > 8 && F.G == 256) {
            conv1_done = true;
            if (blockIdx.x >= 128) { __syncthreads(); float* scr = F.ldsf + F.wave * 4096; for (int it = ((int)blockIdx.x - 128) * NWAVES + F.wave; it < N_CONV_ITEMS1; it += 128 * NWAVES) convert_item1(args, it, scr, F.lane); }
        }
        if (BOTH(6)) GRID_BAR();
    }
    if (IN(7)) { PHASE_WS; STAMP(7);
        pg8::Gemm g{(const bf16*)(ws + BIG_ACT), (const bf16*)(ws + WB_DN0), FF, FF, FF, 0}; pg8::StaticOrder S; S.init(M, D, F.G, (int)blockIdx.x);
        pg8::EpiBf16 E{(bf16*)(ws + BIG_Y1), D};
        pg8::gemm_phase<pg8::EpiBf16>(F.lds + RING_OFF, g, S, E);
        if (BOTH(7)) GRID_BAR();
    }
    if (IN(8)) { PHASE_WS; STAMP(8); row_pass<1, true, true>(args, F, ws + WS_XR, ws + WS_XR, (const bf16*)(ws + BIG_Y1), 1, args.in[3] + 1 * D, 2, args.in[2] + 2 * D);
        if (!conv1_done) { __syncthreads(); float* scr = F.ldsf + F.wave * 4096; for (int it = gw; it < N_CONV_ITEMS1; it += NGW) convert_item1(args, it, scr, F.lane); }
        if (BOTH(8)) GRID_BAR(); }
    if (IN(9)) { PHASE_WS; STAMP(9);
        pg8::Gemm g{(const bf16*)(ws + WS_H), (const bf16*)(ws + WB_LIN), D, D, D, 0}; pg8::StaticOrder S; S.init(M, 2048, F.G, (int)blockIdx.x);
        pg8::EpiBf16 E{(bf16*)(ws + BIG_GX), 2048};
        pg8::gemm_phase<pg8::EpiBf16>(F.lds + RING_OFF, g, S, E);
        if (BOTH(9)) GRID_BAR();
    }
    if (IN(10)) { PHASE_WS; STAMP(10);
        const bf16* GX = (const bf16*)(ws + BIG_GX); bf16* XC = (bf16*)(ws + BIG_XC); const float* cw = args.in[27]; const float* cb = args.in[28];
        for (int it = gw * 64 + F.lane; it < (M / 16) * 128; it += NGW * 64) {
            const int c8 = (it & 127) * 8, row0 = (it >> 7) * 16, t0 = row0 % T;
            v4u xr[19];
#pragma unroll
            for (int r = 0; r < 19; ++r) { xr[r] = (v4u){0u, 0u, 0u, 0u}; if (t0 + r - 3 >= 0) xr[r] = *(const v4u*)(GX + (size_t)(row0 + r - 3) * 2048 + 1024 + c8); }
            f32x4 wa[4], wb[4];
#pragma unroll
            for (int j = 0; j < 4; ++j) { wa[j] = *(const f32x4*)(cw + j * 1024 + c8); wb[j] = *(const f32x4*)(cw + j * 1024 + c8 + 4); }
            const f32x4 ba = *(const f32x4*)(cb + c8), bb = *(const f32x4*)(cb + c8 + 4);
#pragma unroll
            for (int r = 0; r < 16; ++r) { f32x4 a0 = ba, a1 = bb;
#pragma unroll
                for (int j = 0; j < 4; ++j) { const v4u xw = xr[r + j];
                    a0.x += wa[j].x * bf_lo(xw.x); a0.y += wa[j].y * bf_hi(xw.x); a0.z += wa[j].z * bf_lo(xw.y); a0.w += wa[j].w * bf_hi(xw.y);
                    a1.x += wb[j].x * bf_lo(xw.z); a1.y += wb[j].y * bf_hi(xw.z); a1.z += wb[j].z * bf_lo(xw.w); a1.w += wb[j].w * bf_hi(xw.w); }
                v4u o; o.x = pk2(a0.x, a0.y); o.y = pk2(a0.z, a0.w); o.z = pk2(a1.x, a1.y); o.w = pk2(a1.z, a1.w);
                *(v4u*)(XC + (size_t)(row0 + r) * D + c8) = o; }
        }
        if (BOTH(10)) GRID_BAR();
    }
    if (IN(11)) { PHASE_WS; STAMP(11);
        pg8::Gemm g{(const bf16*)(ws + BIG_XC), (const bf16*)(ws + WB_LG), D, 256, 256, 256}; pg8::StaticOrder S; S.init(M, 2048, F.G, (int)blockIdx.x);
        pg8::EpiGates E{(bf16*)(ws + BIG_A), (bf16*)(ws + WS_H), (const bf16*)(ws + BIG_XC), args.in[30], args.in[32], (const float*)(ws + WS_SPL), (float*)(ws + WS_CARRY), (float*)(ws + WS_CARRY) + NB * 64 * D};
        pg8::gemm_phase<pg8::EpiGates>(F.lds + RING_OFF, g, S, E);
        if (BOTH(11)) GRID_BAR();
    }
    if (IN(13)) { PHASE_WS; STAMP(13);
        const bf16* Aa = (const bf16*)(ws + BIG_A); const bf16* U = (const bf16*)(ws + WS_H); const float* CA = (const float*)(ws + WS_CARRY); const float* CH = CA + NB * 64 * D;
        const bf16* GX = (const bf16*)(ws + BIG_GX); bf16* Y2 = (bf16*)(ws + BIG_XC);
        for (int it = gw; it < NB * 64 * 8; it += NGW) { const int cg = it & 7, seg = (it >> 3) & 63, b = it >> 9, ch = cg * 128 + F.lane * 2;
            const size_t base = (size_t)(b * T + seg * 64) * D + ch;
            const unsigned* Ap = (const unsigned*)(Aa + base); const unsigned* Up = (const unsigned*)(U + base); const unsigned* Gp = (const unsigned*)(GX + (size_t)(b * T + seg * 64) * 2048 + ch); unsigned* Yp = (unsigned*)(Y2 + base);
            unsigned av[16], uv[16], gv[16], an[16], un[16], gn[16];
#pragma unroll
            for (int i = 0; i < 16; ++i) { av[i] = Ap[(size_t)i * (D / 2)]; uv[i] = Up[(size_t)i * (D / 2)]; gv[i] = Gp[(size_t)i * 1024]; }
            float h0 = 0.f, h1 = 0.f;
            for (int s2 = 0; s2 < seg; s2 += 16) { float2 ca[16], cx[16];
#pragma unroll
                for (int i = 0; i < 16; ++i) { const int sq = (s2 + i) & 63; ca[i] = *(const float2*)(CA + (size_t)(b * 64 + sq) * D + ch); cx[i] = *(const float2*)(CH + (size_t)(b * 64 + sq) * D + ch); }
#pragma unroll
                for (int i = 0; i < 16; ++i) { const bool on = (s2 + i) < seg; h0 = on ? ca[i].x * h0 + cx[i].x : h0; h1 = on ? ca[i].y * h1 + cx[i].y : h1; } }
#pragma unroll 1
            for (int t0 = 0; t0 < 64; t0 += 16) {
                if (t0 < 48) {
#pragma unroll
                    for (int i = 0; i < 16; ++i) { an[i] = Ap[(size_t)(t0 + 16 + i) * (D / 2)]; un[i] = Up[(size_t)(t0 + 16 + i) * (D / 2)]; gn[i] = Gp[(size_t)(t0 + 16 + i) * 1024]; } }
#pragma unroll
                for (int i = 0; i < 16; ++i) {
                    h0 = __expf(__uint_as_float(av[i] << 16)) * h0 + __uint_as_float(uv[i] << 16); h1 = __expf(__uint_as_float(av[i] & 0xffff0000u)) * h1 + __uint_as_float(uv[i] & 0xffff0000u);
                    Yp[(size_t)(t0 + i) * (D / 2)] = cvtpk(h0 * gelu_tanh_fast(__uint_as_float(gv[i] << 16)), h1 * gelu_tanh_fast(__uint_as_float(gv[i] & 0xffff0000u))); }
#pragma unroll
                for (int i = 0; i < 16; ++i) { av[i] = an[i]; uv[i] = un[i]; gv[i] = gn[i]; }
            }
        }
        if (BOTH(13)) GRID_BAR();
    }
    if (IN(14)) { PHASE_WS; STAMP(14);
        pg8::Gemm g{(const bf16*)(ws + BIG_XC), (const bf16*)(ws + WB_LOUT), D, D, D, 0}; pg8::StaticOrder S; S.init(M, D, F.G, (int)blockIdx.x);
        pg8::EpiBf16 E{(bf16*)(ws + BIG_A), D};
        pg8::gemm_phase<pg8::EpiBf16>(F.lds + RING_OFF, g, S, E);
        if (BOTH(14)) GRID_BAR();
    }
    if (IN(15)) { PHASE_WS; STAMP(15); row_pass<1, true, true>(args, F, ws + WS_XR, ws + WS_XR, (const bf16*)(ws + BIG_A), 2, args.in[3] + 2 * D, 3, args.in[2] + 3 * D); if (BOTH(15)) GRID_BAR(); }
    if (IN(16)) { PHASE_WS; STAMP(16);
        pg8::Gemm g{(const bf16*)(ws + WS_H), (const bf16*)(ws + WB_GU1), D, D, D, 0}; pg8::StaticOrder S; S.init(M, 2 * FF, F.G, (int)blockIdx.x);
        pg8::EpiSwiGLU E{(bf16*)(ws + BIG_ACT), FF};
        pg8::gemm_phase<pg8::EpiSwiGLU>(F.lds + RING_OFF, g, S, E);
        if (BOTH(16)) GRID_BAR();
    }
    if (IN(17)) { PHASE_WS; STAMP(17);
        pg8::Gemm g{(const bf16*)(ws + BIG_ACT), (const bf16*)(ws + WB_DN1), FF, FF, FF, 0}; pg8::StaticOrder S; S.init(M, D, F.G, (int)blockIdx.x);
        pg8::EpiBf16 E{(bf16*)(ws + BIG_Y1), D};
        pg8::gemm_phase<pg8::EpiBf16>(F.lds + RING_OFF, g, S, E);
#ifdef PROBE_A0
        if (blockIdx.x == 0 && threadIdx.x == 0) { const unsigned long long te = __builtin_amdgcn_s_memrealtime(); tsb[20] = te;
            const float tot = (float)(te - tsb[0]); const float fa = (float)(tsb[PROBE_A1] - tsb[PROBE_A0]) / tot; const float usb = (float)(tsb[PROBE_B1] - tsb[PROBE_B0]) * 0.01f;
            float* pv = (float*)(args.ws + 49152); pv[0] = sqrtf(fa * 1e-2f); pv[1] = usb * 0.01f; }
#endif
        if (BOTH(17)) GRID_BAR();
    }
    if (IN(18)) { PHASE_WS; STAMP(18); row_pass<2, true, false>(args, F, ws + WS_XR, args.out, (const bf16*)(ws + BIG_Y1), 3, args.in[3] + 3 * D, 0, nullptr); }
#undef IN
#undef BOTH
}

extern "C" void kernel_launch(void* const* d_in, const int* in_sizes, int n_in, void* d_out, int out_size, void* d_ws, size_t ws_size, hipStream_t stream) {
    static int grid = 0;
    if (grid == 0) {
        if (n_in != 35 || out_size != M * D || ws_size < WS_END) { fprintf(stderr, "kernel_launch: unexpected shapes n_in %d out %d ws %zu\n", n_in, out_size, ws_size); grid = -1; return; }
        int dev = 0, cus = 0;
        if (hipGetDevice(&dev) != hipSuccess || hipDeviceGetAttribute(&cus, hipDeviceAttributeMultiprocessorCount, dev) != hipSuccess) { grid = -1; return; }
        if (hipFuncSetAttribute((const void*)fwd, hipFuncAttributeMaxDynamicSharedMemorySize, LDS_BYTES) != hipSuccess) { grid = -1; return; }
        grid = cus;
    }
    if (grid < 0) return;
    (void)hipMemsetAsync((char*)d_ws + WS_CTL, 0, CTL_ZERO_BYTES, stream);
    Args a{};
    for (int i = 0; i < 35; ++i) a.in[i] = (const float*)d_in[i];
    a.out = (float*)d_out; a.ws = (unsigned char*)d_ws;
    constexpr int NPH = 19;
    if (N_LAUNCHES == PER_PHASE) {
        for (int p = 0; p < NPH; ++p) { a.ph_lo = p; a.ph_hi = p + 1; a.li = p; hipLaunchKernelGGL(fwd, dim3(grid), dim3(NWAVES * 64), LDS_BYTES, stream, a); }
    } else {
        a.ph_lo = 0; a.ph_hi = NPH; a.li = 0; hipLaunchKernelGGL(fwd, dim3(grid), dim3(NWAVES * 64), LDS_BYTES, stream, a);
    }
}
```

```cpp
#include <hip/hip_runtime.h>
#include <cstdio>
#include <cstdint>

#ifndef MK_N_LAUNCHES
#define MK_N_LAUNCHES 1
#endif

namespace pg8 {
#define PG8_LAS __attribute__((address_space(3)))
typedef unsigned short bf16_t;
typedef short bf16x8 __attribute__((ext_vector_type(8)));
typedef float f32x4 __attribute__((ext_vector_type(4)));
typedef unsigned u32x4 __attribute__((ext_vector_type(4)));
typedef unsigned u32x2 __attribute__((ext_vector_type(2)));
constexpr int BM = 256, BK = 64, HALF = 128, HTB = HALF * BK * 2, STAGE_BYTES = 8 * HTB, NXCD = 8, WGM = 8;

__host__ __device__ __forceinline__ int lds_byte(int r, int c) { const int st = (r >> 4) * 2 + (c >> 5), rr = r & 15, cc = c & 31, ob = rr * 64 + cc * 2; return st * 1024 + (ob ^ (((ob >> 9) & 1) << 5)); }
__host__ __device__ __forceinline__ void stage_rc(int b, int& R, int& C) { const int st = b / 1024, sb = b % 1024, swz = sb ^ (((sb >> 9) & 1) << 5); R = (st >> 1) * 16 + swz / 64; C = (st & 1) * 32 + (swz % 64) / 2; }
__host__ __device__ __forceinline__ int perm32(int rho) { const int n = rho >> 4, i = rho & 15; return 8 * (i >> 2) + 4 * n + (i & 3); }

struct Unit { int pm, pn; };
struct Gemm { const bf16_t* A; const bf16_t* Bt; int lda, ldb, K, acol_mul; };

struct StaticOrder {
    int nM, nN, nwg, G, c;
    __host__ __device__ void init(int M, int N, int G_, int c_) { nM = M / BM; nN = N / BM; nwg = nM * nN; G = G_; c = c_; }
    __host__ __device__ bool next(int i, Unit& u) const {
        const long L = (long)i * G + c; if (L >= nwg) return false;
        int wgid = (int)L; { const int q = nwg / NXCD, r = nwg % NXCD, xcd = wgid % NXCD, off = wgid / NXCD; wgid = (xcd < r ? xcd * (q + 1) : r * (q + 1) + (xcd - r) * q) + off; }
        const int nig = WGM * nN, gid = wgid / nig, fm = gid * WGM, gsz = (nM - fm) < WGM ? (nM - fm) : WGM;
        u.pm = fm + ((wgid % nig) % gsz); u.pn = (wgid % nig) / gsz; return true;
    }
};

typedef unsigned wtv4_t __attribute__((__vector_size__(16)));
__device__ __forceinline__ __amdgpu_buffer_rsrc_t wt_rs(const void* p) {
    const unsigned long long v = (unsigned long long)p; const unsigned lo = __builtin_amdgcn_readfirstlane((unsigned)v), hi = __builtin_amdgcn_readfirstlane((unsigned)(v >> 32));
    return __builtin_amdgcn_make_buffer_rsrc((void*)(((unsigned long long)hi << 32) | lo), 0, 0x7ffffff0, 0x00020000); }
__device__ __forceinline__ void st16_wt(__amdgpu_buffer_rsrc_t rs, unsigned byte_off, u32x4 v) { __builtin_amdgcn_raw_buffer_store_b128(__builtin_bit_cast(wtv4_t, v), rs, (int)byte_off, 0, 16); }
__device__ __forceinline__ unsigned cvt_pk_bf16(float lo, float hi) { unsigned r; asm volatile("v_cvt_pk_bf16_f32 %0, %1, %2" : "=v"(r) : "v"(lo), "v"(hi)); return r; }
__device__ __forceinline__ float bf_lo(unsigned w) { return __uint_as_float(w << 16); }
__device__ __forceinline__ float bf_hi(unsigned w) { return __uint_as_float(w & 0xffff0000u); }
__device__ __forceinline__ float rsq_(float x) { return __builtin_amdgcn_rsqf(x); }
__device__ __forceinline__ float sigmoidf_(float x) { return __builtin_amdgcn_rcpf(1.0f + __expf(-x)); }
__device__ __forceinline__ float siluf_(float x) { return x * __builtin_amdgcn_rcpf(1.0f + __expf(-x)); }
__device__ __forceinline__ float softplusf_(float x) { return fmaxf(x, 0.f) + log1pf(__expf(-fabsf(x))); }
__device__ __forceinline__ float softplus_fast(float x) { return fmaxf(x, 0.f) + __logf(1.0f + __expf(-fabsf(x))); }
__device__ __forceinline__ float tanh_fast(float x) { const float e = __expf(2.0f * fminf(fmaxf(x, -15.f), 15.f)); return (e - 1.0f) * __builtin_amdgcn_rcpf(e + 1.0f); }

struct EpiF32 {
    static constexpr bool PERM = false;
    float* C; int ldc;
    __device__ __forceinline__ void operator()(const f32x4 (&acc)[2][2][4][2], const Unit& u, int wr, int wc, int fr, int fq) const {
        const int row0 = u.pm * BM + wr * 64 + fr, col0 = u.pn * BM + wc * 32 + 4 * fq;
#pragma unroll
        for (int ai = 0; ai < 2; ++ai)
#pragma unroll
            for (int m = 0; m < 4; ++m) { float* rowp = C + (size_t)(row0 + ai * HALF + m * 16) * ldc + col0;
#pragma unroll
                for (int bj = 0; bj < 2; ++bj)
#pragma unroll
                    for (int n = 0; n < 2; ++n) *(f32x4*)(rowp + bj * HALF + n * 16) = acc[ai][bj][m][n]; }
    }
};
struct EpiBf16 {
    static constexpr bool PERM = true;
    bf16_t* O; int ldc;
    __device__ __forceinline__ void operator()(const f32x4 (&acc)[2][2][4][2], const Unit& u, int wr, int wc, int fr, int fq) const {
        const int row0 = u.pm * BM + wr * 64 + fr, col0 = u.pn * BM + wc * 32 + 8 * fq;
        const __amdgpu_buffer_rsrc_t rs = wt_rs(O);
#pragma unroll
        for (int ai = 0; ai < 2; ++ai)
#pragma unroll
            for (int m = 0; m < 4; ++m) { const unsigned ro = ((unsigned)(row0 + ai * HALF + m * 16) * (unsigned)ldc + (unsigned)col0) * 2u;
#pragma unroll
                for (int bj = 0; bj < 2; ++bj) { const f32x4 v0 = acc[ai][bj][m][0], v1 = acc[ai][bj][m][1];
                    u32x4 w; w.x = cvt_pk_bf16(v0[0], v0[1]); w.y = cvt_pk_bf16(v0[2], v0[3]); w.z = cvt_pk_bf16(v1[0], v1[1]); w.w = cvt_pk_bf16(v1[2], v1[3]);
                    st16_wt(rs, ro + bj * HALF * 2, w); } }
    }
};
struct EpiBf16Halo {
    static constexpr bool PERM = true;
    bf16_t* O; int ldc; bf16_t* Hl;
    __device__ __forceinline__ void operator()(const f32x4 (&acc)[2][2][4][2], const Unit& u, int wr, int wc, int fr, int fq) const {
        const int row0 = u.pm * BM + wr * 64 + fr, col0 = u.pn * BM + wc * 32 + 8 * fq;
        const bool zt = (u.pn == 6 || u.pn == 7);
#pragma unroll
        for (int ai = 0; ai < 2; ++ai)
#pragma unroll
            for (int m = 0; m < 4; ++m) { const int row = row0 + ai * HALF + m * 16; bf16_t* rowp = O + (size_t)row * ldc + col0;
#pragma unroll
                for (int bj = 0; bj < 2; ++bj) { f32x4 v0 = acc[ai][bj][m][0], v1 = acc[ai][bj][m][1];
                    if (zt) {
#pragma unroll
                        for (int e = 0; e < 4; ++e) { v0[e] = siluf_(v0[e]); v1[e] = siluf_(v1[e]); } }
                    u32x4 w; w.x = cvt_pk_bf16(v0[0], v0[1]); w.y = cvt_pk_bf16(v0[2], v0[3]); w.z = cvt_pk_bf16(v1[0], v1[1]); w.w = cvt_pk_bf16(v1[2], v1[3]);
                    *(u32x4*)(rowp + bj * HALF) = w;
                    if (m == 3 && fr >= 13) *(u32x4*)(Hl + ((size_t)(row >> 6) * 3 + (fr - 13)) * ldc + col0 + bj * HALF) = w; } }
    }
};
struct EpiSwiGLU {
    static constexpr bool PERM = true;
    bf16_t* O; int ldc;
    __device__ __forceinline__ void operator()(const f32x4 (&acc)[2][2][4][2], const Unit& u, int wr, int wc, int fr, int fq) const {
        const int row0 = u.pm * BM + wr * 64 + fr, col0 = u.pn * HALF + wc * 32 + 8 * fq;
#pragma unroll
        for (int ai = 0; ai < 2; ++ai)
#pragma unroll
            for (int m = 0; m < 4; ++m) { bf16_t* rowp = O + (size_t)(row0 + ai * HALF + m * 16) * ldc + col0;
                float o[8];
#pragma unroll
                for (int n = 0; n < 2; ++n)
#pragma unroll
                    for (int j = 0; j < 4; ++j) { const float g = acc[ai][0][m][n][j], up = acc[ai][1][m][n][j]; o[n * 4 + j] = siluf_(g) * up; }
                u32x4 w; w.x = cvt_pk_bf16(o[0], o[1]); w.y = cvt_pk_bf16(o[2], o[3]); w.z = cvt_pk_bf16(o[4], o[5]); w.w = cvt_pk_bf16(o[6], o[7]);
                *(u32x4*)rowp = w; }
    }
};
template <int CTRL> __device__ __forceinline__ float dpp_f(float x) { return __int_as_float(__builtin_amdgcn_update_dpp(0, __float_as_int(x), CTRL, 0xF, 0xF, true)); }
__device__ __forceinline__ float row16_scan(float x) { x += dpp_f<0x111>(x); x += dpp_f<0x112>(x); x += dpp_f<0x114>(x); x += dpp_f<0x118>(x); return x; }
__device__ __forceinline__ float row16_sum(float x) { x += dpp_f<0xB1>(x); x += dpp_f<0x4E>(x); x += dpp_f<0x141>(x); x += dpp_f<0x140>(x); return x; }
struct EpiGates {
    static constexpr bool PERM = true, AFTER_DRAIN = false;
    bf16_t* Aout; bf16_t* Uout; const bf16_t* XC; const float* ba; const float* bx; const float* lam; float* CA; float* CH;
    __device__ __forceinline__ void operator()(const f32x4 (&acc)[2][2][4][2], const Unit& u, int wr, int wc, int fr, int fq) const {
        const int ch0 = u.pn * HALF + wc * 32 + 8 * fq;
        const unsigned eo0 = (unsigned)(u.pm * BM + wr * 64 + fr) * 1024u + (unsigned)ch0;
        f32x4 bav[2], bxv[2], spl[2];
#pragma unroll
        for (int n = 0; n < 2; ++n) { bav[n] = *(const f32x4*)(ba + ch0 + 4 * n); bxv[n] = *(const f32x4*)(bx + ch0 + 4 * n); spl[n] = *(const f32x4*)(lam + ch0 + 4 * n); }
#pragma unroll
        for (int ai = 0; ai < 2; ++ai) {
            float lm[4][8], um[4][8];
#pragma unroll
            for (int m = 0; m < 4; ++m) { const unsigned eo = eo0 + (unsigned)((ai * HALF + m * 16) * 1024);
                const u32x4 xw = *(const u32x4*)((const char*)XC + (size_t)(eo * 2u));
                const float xv[8] = {bf_lo(xw.x), bf_hi(xw.x), bf_lo(xw.y), bf_hi(xw.y), bf_lo(xw.z), bf_hi(xw.z), bf_lo(xw.w), bf_hi(xw.w)};
                float uv[8], lav[8];
#pragma unroll
                for (int n = 0; n < 2; ++n) {
#pragma unroll
                    for (int j = 0; j < 4; ++j) { const float r = sigmoidf_(acc[ai][0][m][n][j] + bav[n][j]), ig = sigmoidf_(acc[ai][1][m][n][j] + bxv[n][j]);
                        const float la = spl[n][j] * r, t = 2.0f * la; lav[n * 4 + j] = la;
                        const float om = (t > -0.3f) ? -t * (1.0f + t * (0.5f + t * (0.16666667f + t * (0.041666668f + t * (0.0083333333f + t * 0.0013888889f))))) : 1.0f - __expf(t);
                        uv[n * 4 + j] = xv[n * 4 + j] * ig * __builtin_amdgcn_sqrtf(fmaxf(om, 0.f)); } }
                u32x4 wl; wl.x = cvt_pk_bf16(lav[0], lav[1]); wl.y = cvt_pk_bf16(lav[2], lav[3]); wl.z = cvt_pk_bf16(lav[4], lav[5]); wl.w = cvt_pk_bf16(lav[6], lav[7]);
                *(u32x4*)((char*)Aout + (size_t)(eo * 2u)) = wl;
                u32x4 w; w.x = cvt_pk_bf16(uv[0], uv[1]); w.y = cvt_pk_bf16(uv[2], uv[3]); w.z = cvt_pk_bf16(uv[4], uv[5]); w.w = cvt_pk_bf16(uv[6], uv[7]);
                *(u32x4*)((char*)Uout + (size_t)(eo * 2u)) = w;
                lm[m][0] = bf_lo(wl.x); lm[m][1] = bf_hi(wl.x); lm[m][2] = bf_lo(wl.y); lm[m][3] = bf_hi(wl.y); lm[m][4] = bf_lo(wl.z); lm[m][5] = bf_hi(wl.z); lm[m][6] = bf_lo(wl.w); lm[m][7] = bf_hi(wl.w);
                um[m][0] = bf_lo(w.x); um[m][1] = bf_hi(w.x); um[m][2] = bf_lo(w.y); um[m][3] = bf_hi(w.y); um[m][4] = bf_lo(w.z); um[m][5] = bf_hi(w.z); um[m][6] = bf_lo(w.w); um[m][7] = bf_hi(w.w);
                asm volatile("" ::: "memory"); }
            float cav[8], chv[8];
#pragma unroll
            for (int c = 0; c < 8; ++c) {
                float off = 0.f, L[4];
#pragma unroll
                for (int m = 0; m < 4; ++m) { L[m] = row16_scan(lm[m][c]) + off; off += row16_sum(lm[m][c]); }
                float hsum = 0.f;
#pragma unroll
                for (int m = 0; m < 4; ++m) hsum += um[m][c] * __expf(off - L[m]);
                chv[c] = row16_sum(hsum); cav[c] = __expf(off); }
            if (fr == 0) { const size_t o = (size_t)((u.pm >> 4) * 64 + (u.pm & 15) * 4 + 2 * ai + wr) * 1024 + ch0;
                *(f32x4*)(CA + o) = (f32x4){cav[0], cav[1], cav[2], cav[3]}; *(f32x4*)(CA + o + 4) = (f32x4){cav[4], cav[5], cav[6], cav[7]};
                *(f32x4*)(CH + o) = (f32x4){chv[0], chv[1], chv[2], chv[3]}; *(f32x4*)(CH + o + 4) = (f32x4){chv[4], chv[5], chv[6], chv[7]}; }
        }
    }
};

template <class Epi, bool ALIGN_EPI = true>
__device__ __forceinline__ void gemm_phase(PG8_LAS unsigned char* lds, const Gemm g, const StaticOrder& S, const Epi& E) {
    const int tid = threadIdx.x, wid = __builtin_amdgcn_readfirstlane(tid >> 6), lane = tid & 63, wr = wid >> 2, wc = wid & 3, fr = lane & 15, fq = lane >> 4;
    const int K = g.K, nt = K / BK;
    unsigned voffA[2], voffB[2];
#pragma unroll
    for (int i = 0; i < 2; ++i) { int R, C; stage_rc(tid * 16 + i * 8192, R, C); const int Rb = Epi::PERM ? ((R & ~31) + perm32(R & 31)) : R;
        voffA[i] = (unsigned)(R * g.lda + C) * 2u; voffB[i] = (unsigned)(Rb * g.ldb + C) * 2u; }
    const size_t kstep = (size_t)(BK * 2);
    const size_t hstepA = (size_t)HALF * g.lda * 2, hstepB = (size_t)HALF * g.ldb * 2;
    const size_t tstepA = 2 * hstepA, tstepB = 2 * hstepB;
    const unsigned ldsw = (unsigned)wid * 1024u;
    const int aoff = lds_byte(wr * 64 + fr, fq * 8), boff = lds_byte(wc * 32 + fr, fq * 8);
#define PG8_SA(b, h) (((b) * 2 + (h)) * HTB)
#define PG8_SB(b, h) ((4 + (b) * 2 + (h)) * HTB)
#define PG8_STAGE(bufoff, gbase, voff) do { _Pragma("unroll") for (int _i = 0; _i < 2; ++_i) \
        __builtin_amdgcn_global_load_lds((const unsigned*)((const char*)(gbase) + (voff)[_i]), (PG8_LAS unsigned*)(lds + (bufoff) + ldsw + _i * 8192), 16, 0, 0); } while (0)
#define PG8_LDA(dst, b, h) do { _Pragma("unroll") for (int m = 0; m < 4; ++m) _Pragma("unroll") for (int k = 0; k < 2; ++k) dst[m][k] = *(const PG8_LAS bf16x8*)(lds + PG8_SA(b, h) + aoff + m * 2048 + k * 1024); } while (0)
#define PG8_LDB(dst, b, h) do { _Pragma("unroll") for (int n = 0; n < 2; ++n) _Pragma("unroll") for (int k = 0; k < 2; ++k) dst[n][k] = *(const PG8_LAS bf16x8*)(lds + PG8_SB(b, h) + boff + n * 2048 + k * 1024); } while (0)
#define PG8_MMA(ai, bj, At, Bt) do { __builtin_amdgcn_s_setprio(1); _Pragma("unroll") for (int m = 0; m < 4; ++m) _Pragma("unroll") for (int n = 0; n < 2; ++n) _Pragma("unroll") for (int k = 0; k < 2; ++k) \
        acc[ai][bj][m][n] = __builtin_amdgcn_mfma_f32_16x16x32_bf16(Bt[n][k], At[m][k], acc[ai][bj][m][n], 0, 0, 0); __builtin_amdgcn_s_setprio(0); } while (0)
#define PG8_WAIT_V(n) asm volatile("s_waitcnt vmcnt(" #n ")" ::: "memory")
#define PG8_WAIT_L(n) asm volatile("s_waitcnt lgkmcnt(" #n ")" ::: "memory")
#define PG8_BAR __builtin_amdgcn_s_barrier()
#define PG8_SCHED __builtin_amdgcn_sched_barrier(0)
    Unit cur, nxt; int ui = 0;
    if (!S.next(0, cur)) return;
    f32x4 acc[2][2][4][2];
#pragma unroll
    for (int a = 0; a < 2; ++a)
#pragma unroll
        for (int b = 0; b < 2; ++b)
#pragma unroll
            for (int m = 0; m < 4; ++m)
#pragma unroll
                for (int n = 0; n < 2; ++n) acc[a][b][m][n] = (f32x4){0.f, 0.f, 0.f, 0.f};
    bf16x8 At[4][2], B0[2][2], B1[2][2];
    const char* cA = (const char*)g.A + (size_t)cur.pm * tstepA + (size_t)((cur.pn >> 1) * g.acol_mul) * 2; const char* cB = (const char*)g.Bt + (size_t)cur.pn * tstepB;
    PG8_STAGE(PG8_SB(0, 0), cB, voffB); PG8_STAGE(PG8_SB(0, 1), cB + hstepB, voffB); PG8_STAGE(PG8_SA(0, 0), cA, voffA); PG8_STAGE(PG8_SA(0, 1), cA + hstepA, voffA);
    if (wr == 1) PG8_BAR;
    PG8_WAIT_V(2); PG8_BAR;
    PG8_STAGE(PG8_SB(1, 0), cB + kstep, voffB); PG8_STAGE(PG8_SA(1, 0), cA + kstep, voffA); PG8_STAGE(PG8_SB(1, 1), cB + hstepB + kstep, voffB);
    PG8_WAIT_V(6); PG8_BAR;
    for (;;) {
        const bool has_next = S.next(ui + 1, nxt);
        const char* nA = has_next ? (const char*)g.A + (size_t)nxt.pm * tstepA + (size_t)((nxt.pn >> 1) * g.acol_mul) * 2 : cA; const char* nB = has_next ? (const char*)g.Bt + (size_t)nxt.pn * tstepB : cB;
#pragma nounroll
        for (int t = 0; t < nt; t += 2) {
            const bool last = (t == nt - 2);
            const char* a1 = cA + (size_t)(t + 1) * kstep;
            const char* a2 = last ? nA : cA + (size_t)(t + 2) * kstep; const char* b2 = last ? nB : cB + (size_t)(t + 2) * kstep;
            const char* a3 = a2 + kstep; const char* b3 = b2 + kstep;
            PG8_LDB(B0, 0, 0); PG8_LDB(B1, 0, 1); PG8_SCHED; PG8_LDA(At, 0, 0); PG8_STAGE(PG8_SA(1, 1), a1 + hstepA, voffA);
            PG8_WAIT_V(8); PG8_WAIT_L(0); PG8_BAR; PG8_MMA(0, 0, At, B0); PG8_MMA(0, 1, At, B1); PG8_BAR; PG8_SCHED;
            PG8_LDA(At, 0, 1); PG8_STAGE(PG8_SB(0, 0), b2, voffB); PG8_STAGE(PG8_SB(0, 1), b2 + hstepB, voffB); PG8_STAGE(PG8_SA(0, 0), a2, voffA);
            PG8_WAIT_V(8); PG8_WAIT_L(0); PG8_BAR; PG8_MMA(1, 0, At, B0); PG8_MMA(1, 1, At, B1); PG8_BAR; PG8_SCHED;
            PG8_LDB(B0, 1, 0); PG8_LDB(B1, 1, 1); PG8_SCHED; PG8_LDA(At, 1, 0); PG8_STAGE(PG8_SA(0, 1), a2 + hstepA, voffA);
            PG8_WAIT_V(8); PG8_WAIT_L(0); PG8_BAR; PG8_MMA(0, 0, At, B0); PG8_MMA(0, 1, At, B1); PG8_BAR; PG8_SCHED;
            PG8_LDA(At, 1, 1); PG8_STAGE(PG8_SB(1, 0), b3, voffB); PG8_STAGE(PG8_SB(1, 1), b3 + hstepB, voffB); PG8_STAGE(PG8_SA(1, 0), a3, voffA);
            PG8_WAIT_V(8); PG8_WAIT_L(0); PG8_BAR; PG8_MMA(1, 0, At, B0); PG8_MMA(1, 1, At, B1); PG8_BAR; PG8_SCHED;
        }
        if constexpr (ALIGN_EPI) { if (wr == 0) PG8_BAR; }
        E(acc, cur, wr, wc, fr, fq);
        if (!has_next) break;
#pragma unroll
        for (int a = 0; a < 2; ++a)
#pragma unroll
            for (int b = 0; b < 2; ++b)
#pragma unroll
                for (int m = 0; m < 4; ++m)
#pragma unroll
                    for (int n = 0; n < 2; ++n) acc[a][b][m][n] = (f32x4){0.f, 0.f, 0.f, 0.f};
        cur = nxt; cA = nA; cB = nB; ++ui;
        if constexpr (ALIGN_EPI) { if (wr == 1) PG8_BAR; }
    }
    PG8_WAIT_V(0);
    if constexpr (!ALIGN_EPI) { if (wr == 0) PG8_BAR; }
    PG8_BAR;
#undef PG8_SA
#undef PG8_SB
#undef PG8_STAGE
#undef PG8_LDA
#undef PG8_LDB
#undef PG8_MMA
#undef PG8_WAIT_V
#undef PG8_WAIT_L
#undef PG8_BAR
#undef PG8_SCHED
}
}

using pg8::bf_lo; using pg8::bf_hi; using pg8::cvt_pk_bf16; using pg8::sigmoidf_; using pg8::rsq_; using pg8::siluf_; using pg8::softplusf_; using pg8::softplus_fast; using pg8::tanh_fast;

constexpr int NWAVES = 8;
constexpr int N_LAUNCHES = MK_N_LAUNCHES;
constexpr int PER_PHASE = 18;
constexpr int NB = 4, T = 4096, D = 1024, M = NB * T, FF = 2816;
constexpr int NCOLS = 3840;
constexpr int WIN_LD = 3848;
constexpr float EPS = 1e-6f;

constexpr size_t MiB = 1u << 20;
constexpr size_t WS_CTL = 0, CTL_ZERO_BYTES = 64 * 1024;
constexpr size_t WS_MODS = 256 * 1024;
constexpr size_t WS_WSPEC = 512 * 1024;
constexpr size_t WS_SPL = 576 * 1024;
constexpr size_t WS_CARRY = 1 * MiB;
constexpr size_t WS_MODP = 3 * MiB;
constexpr int NKC = 16;
constexpr size_t WS_GB = 6 * MiB;
constexpr size_t WS_W = 8 * MiB;
constexpr size_t WB_IN = WS_W;
constexpr size_t WB_OUT = WB_IN + (size_t)NCOLS * D * 2;
constexpr size_t WB_GU0 = WB_OUT + (size_t)D * D * 2;
constexpr size_t WB_DN0 = WB_GU0 + (size_t)2 * FF * D * 2;
constexpr size_t WB_GU1 = WB_DN0 + (size_t)D * FF * 2;
constexpr size_t WB_DN1 = WB_GU1 + (size_t)2 * FF * D * 2;
constexpr size_t WB_LIN = WB_DN1 + (size_t)D * FF * 2;
constexpr size_t WB_LG = WB_LIN + (size_t)2048 * D * 2;
constexpr size_t WB_LOUT = WB_LG + (size_t)2048 * 256 * 2;
constexpr size_t WB_END = WB_LOUT + (size_t)D * D * 2;
constexpr size_t WS_H = 58 * MiB;
constexpr size_t WS_BIG = 90 * MiB;
constexpr size_t WS_END = 256 * MiB;
static_assert(WB_END <= WS_H, "weights fit");
static_assert(WS_BIG + (size_t)M * NCOLS * 2 <= WS_END, "cols fit");
constexpr size_t BIG_COLS = WS_BIG;
constexpr size_t BIG_Y0 = WS_BIG;
constexpr size_t BIG_ACT = WS_BIG;
constexpr size_t BIG_Y1 = WS_BIG + 88 * MiB;
constexpr size_t BIG_GX = WS_BIG;
constexpr size_t BIG_XC = WS_BIG + 64 * MiB;
constexpr size_t BIG_A = WS_BIG + 96 * MiB;
static_assert(BIG_A + (size_t)M * D * 4 <= WS_END, "lru buffers fit");

constexpr int CW_TMO = 0;
constexpr int CW_BAR = 1024;
constexpr int RING_OFF = 0, RING_BYTES = 131072;
constexpr int LDSCTL_OFF = 150528, MISC_OFF = LDSCTL_OFF + 320;
constexpr int LDS_BYTES = 158720;
constexpr size_t GDN_WP = 34 * MiB;
constexpr size_t WS_HALO = 50 * MiB;
constexpr size_t RW_YL = 210 * MiB;
constexpr size_t GDN_ATT = 226 * MiB;
constexpr size_t RW_DS = 234 * MiB;
constexpr size_t GDN_GL = 250 * MiB;
constexpr size_t RW_WC = 251 * MiB;
constexpr size_t WS_XR = 218 * MiB;
constexpr size_t RW_LW = 7 * MiB;
constexpr size_t DO_WM = 0, DO_BT = 16 * MiB, DO_ARB = 32 * MiB, DO_U = 48 * MiB;

#define GAS __attribute__((address_space(1)))
#define LAS __attribute__((address_space(3)))
typedef unsigned short bf16;
typedef unsigned v4u __attribute__((ext_vector_type(4)));
typedef unsigned v2u __attribute__((ext_vector_type(2)));
typedef float f32x4 __attribute__((ext_vector_type(4)));
typedef GAS unsigned gu32;
#define RLX_AGENT __ATOMIC_RELAXED, __HIP_MEMORY_SCOPE_AGENT
#define LDS_WAIT() asm volatile("s_waitcnt lgkmcnt(0)" ::: "memory")
#define VM_WAIT() asm volatile("s_waitcnt vmcnt(0)" ::: "memory")
__device__ __forceinline__ unsigned f2bf(float f) { unsigned u = __builtin_bit_cast(unsigned, f); return (u + 0x7fffu + ((u >> 16) & 1u)) >> 16; }
__device__ __forceinline__ unsigned pk2(float lo, float hi) { typedef float f2_t __attribute__((ext_vector_type(2))); typedef __bf16 b2_t __attribute__((ext_vector_type(2))); const f2_t v = {lo, hi}; return __builtin_bit_cast(unsigned, __builtin_convertvector(v, b2_t)); }
__device__ __forceinline__ float bf2f(bf16 v) { return __uint_as_float(((unsigned)v) << 16); }

#define XB_TMO      128
#define XB_XCNT(j)  (256  + 64 * (j))
#define XB_XSUB(j)  (1280 + 64 * (j))
#define XB_XGEN(j)  (2304 + 64 * (j))
#define XB_TOP      3328
#define XB_TOPGEN   3392
#define XCD_BAR_WORDS 3456
#define XB_SPIN_CAP (1u << 22)
__device__ __forceinline__ unsigned xb_ld(unsigned* p)              { return __hip_atomic_load(p, __ATOMIC_RELAXED, __HIP_MEMORY_SCOPE_AGENT); }
__device__ __forceinline__ unsigned xb_add(unsigned* p, unsigned v) { return __hip_atomic_fetch_add(p, v, __ATOMIC_RELAXED, __HIP_MEMORY_SCOPE_AGENT); }
__device__ __forceinline__ unsigned xb_xcc_id() { return (unsigned)__builtin_amdgcn_s_getreg((3 << 11) | 20) & 0xFu; }
#define XB_SPIN(cond, bar) do { unsigned _sp = 0; while (cond) { __builtin_amdgcn_s_sleep(1); \
    if ((++_sp & 255u) == 0u) { if (xb_ld(&(bar)[XB_TMO])) break; if (_sp > XB_SPIN_CAP) { atomicAdd(&(bar)[XB_TMO], 1u); break; } } } } while (0)
struct XcdBarrier { unsigned* bar; unsigned x; volatile LAS unsigned* st; };
__device__ __forceinline__ XcdBarrier xcd_barrier_post(unsigned* bar, volatile LAS unsigned* st) {
    XcdBarrier b; b.bar = bar; b.x = xb_xcc_id(); b.st = st;
    if (threadIdx.x == 0) (void)xb_add(&bar[XB_XCNT(b.x)], 1u);
    return b;
}
__device__ __forceinline__ void xcd_barrier_complete(unsigned* bar, unsigned x, unsigned& nloc, unsigned& nx) {
    const unsigned G = gridDim.x * gridDim.y * gridDim.z;
    unsigned sum, cnt, mine, sp = 0u;
    for (;;) {
        sum = 0u; cnt = 0u; mine = 0u;
#pragma unroll
        for (unsigned j = 0; j < 16; ++j) { const unsigned c = xb_ld(&bar[XB_XCNT(j)]); sum += c; cnt += (c > 0u) ? 1u : 0u; mine = (j == x) ? c : mine; }
        if (sum == G) break;
        __builtin_amdgcn_s_sleep(1);
        if ((++sp & 255u) == 0u) { if (xb_ld(&bar[XB_TMO])) break; if (sp > XB_SPIN_CAP) { atomicAdd(&bar[XB_TMO], 1u); break; } }
    }
    nloc = mine > 0u ? mine : 1u; nx = cnt > 0u ? cnt : 1u;
}
__device__ __forceinline__ void xcd_barrier(const XcdBarrier& b) {
    asm volatile("s_waitcnt vmcnt(0)" ::: "memory");
    __syncthreads();
    if (threadIdx.x == 0) {
        unsigned* bar = b.bar;
        __builtin_amdgcn_s_waitcnt(0);
        unsigned nloc = b.st[0], nx = b.st[1];
        if (nloc == 0u) { xcd_barrier_complete(bar, b.x, nloc, nx); b.st[0] = nloc; b.st[1] = nx; }
        const unsigned old = xb_add(&bar[XB_XSUB(b.x)], 1u);
        const unsigned gen = old / nloc;
        if (old + 1u == (gen + 1u) * nloc) {
            __builtin_amdgcn_fence(__ATOMIC_RELEASE, "agent");
            asm volatile("s_waitcnt vmcnt(0)" ::: "memory");
            const unsigned og = xb_add(&bar[XB_TOP], 1u);
            const unsigned tg = og / nx;
            if (og + 1u == (tg + 1u) * nx) xb_add(&bar[XB_TOPGEN], 1u);
            else XB_SPIN(xb_ld(&bar[XB_TOPGEN]) == tg, bar);
            __builtin_amdgcn_fence(__ATOMIC_ACQUIRE, "agent");
            asm volatile("s_waitcnt vmcnt(0)" ::: "memory");
        } else {
            XB_SPIN(xb_ld(&bar[XB_TOPGEN]) == gen, bar);
            __builtin_amdgcn_fence(__ATOMIC_ACQUIRE, "agent");
            asm volatile("s_waitcnt vmcnt(0)" ::: "memory");
        }
    }
    __syncthreads();
}

struct Frame {
    LAS unsigned char* lds;
    float* ldsf;
    volatile LAS unsigned* MISC;
    gu32* ctl;
    int tid, lane, wave;
    int vcu, G;
    const float* const* in;
    unsigned char* ws;
    float* out;
};
struct Args { const float* in[35]; float* out; unsigned char* ws; int ph_lo, ph_hi, li, pad; };

template <int CTRL, int ROWMASK = 0xF> __device__ __forceinline__ float dppg(float x) { return __int_as_float(__builtin_amdgcn_update_dpp(0, __float_as_int(x), CTRL, ROWMASK, 0xF, true)); }
__device__ __forceinline__ float quad_sum(float x) { x += dppg<0xB1>(x); x += dppg<0x4E>(x); return x; }
__device__ __forceinline__ float oct_sum(float x) { x = quad_sum(x); x += dppg<0x141>(x); return x; }
__device__ __forceinline__ float hex_sum(float x) { x = oct_sum(x); x += dppg<0x140>(x); return x; }
__device__ __forceinline__ float wave_sum(float v) {
    v = hex_sum(v); v += dppg<0x142, 0xA>(v); v += dppg<0x143, 0xC>(v);
    return __int_as_float(__builtin_amdgcn_readlane(__float_as_int(v), 63));
}
__device__ __forceinline__ float wave_scan(float x) {
    x += dppg<0x111>(x); x += dppg<0x112>(x); x += dppg<0x114>(x); x += dppg<0x118>(x);
    x += dppg<0x142, 0xA>(x); x += dppg<0x143, 0xC>(x);
    return x;
}

__device__ __forceinline__ void transpose_tile(const float* W, int ld, bf16* WT, int Kdst, float* scr, int lane, const float* ks = nullptr) {
    const float* Wl = W + (size_t)(lane >> 5) * ld + (lane & 31);
#pragma unroll
    for (int hb = 0; hb < 2; ++hb) { float tv[16];
#pragma unroll
        for (int i = 0; i < 16; ++i) tv[i] = Wl[(size_t)(2 * (16 * hb + i)) * ld];
        if (ks) {
#pragma unroll
            for (int i = 0; i < 16; ++i) tv[i] *= ks[2 * (16 * hb + i) + (lane >> 5)]; }
#pragma unroll
        for (int i = 0; i < 16; ++i) scr[(2 * (16 * hb + i) + (lane >> 5)) * 33 + (lane & 31)] = tv[i];
        asm volatile("" ::: "memory"); }
    LDS_WAIT(); asm volatile("" ::: "memory");
    const int c = lane & 7;
#pragma unroll
    for (int j = 0; j < 4; ++j) { const int n = (lane >> 3) + 8 * j; const float* s = scr + (8 * c) * 33 + n;
        v4u o; o.x = pk2(s[0 * 33], s[1 * 33]); o.y = pk2(s[2 * 33], s[3 * 33]); o.z = pk2(s[4 * 33], s[5 * 33]); o.w = pk2(s[6 * 33], s[7 * 33]);
        *(v4u*)(WT + (size_t)n * Kdst + 8 * c) = o; }
    LDS_WAIT(); asm volatile("" ::: "memory");
}

__device__ __forceinline__ void convert_item0(const Args& a, int it, float* scr, int lane) {
    unsigned char* ws = a.ws;
    if (it < 1024) { const int kb = it / 64, nb = it % 64; transpose_tile(a.in[9] + (size_t)(64 * kb) * WIN_LD + 32 * nb, WIN_LD, (bf16*)(ws + WB_IN) + (size_t)(32 * nb) * D + 64 * kb, D, scr, lane); return; } it -= 1024;
    if (it < 896) { const int kb = it / 56, nb = it % 56; transpose_tile(a.in[9] + (size_t)(64 * kb) * WIN_LD + 2056 + 32 * nb, WIN_LD, (bf16*)(ws + WB_IN) + (size_t)(2048 + 32 * nb) * D + 64 * kb, D, scr, lane); return; } it -= 896;
    if (it < 512) { const int kb = it / 32, nb = it % 32; transpose_tile(a.in[10] + (size_t)(64 * kb) * D + 32 * nb, D, (bf16*)(ws + WB_OUT) + (size_t)(32 * nb) * D + 64 * kb, D, scr, lane, kb < 8 ? a.in[14] + (64 * kb) % 128 : nullptr); return; }        it -= 512;
    if (it < 2 * 1408) { const int gu = it / 1408, r = it % 1408, kb = r / 88, nb = r % 88, n0 = 32 * nb;
        const float* W = a.in[gu ? 7 : 6]; bf16* dst = (bf16*)(ws + WB_GU0);
        const int drow = (n0 / 128) * 256 + gu * 128 + (n0 % 128);
        transpose_tile(W + (size_t)(64 * kb) * FF + n0, FF, dst + (size_t)drow * D + 64 * kb, D, scr, lane); return; } it -= 2 * 1408;
    { const int kb = it / 32, nb = it % 32;
        transpose_tile(a.in[8] + (size_t)(64 * kb) * D + 32 * nb, D, (bf16*)(ws + WB_DN0) + (size_t)(32 * nb) * FF + 64 * kb, FF, scr, lane); }
}
constexpr int N_CONV_ITEMS0 = 1024 + 896 + 512 + 2 * 1408 + 1408;
__device__ __forceinline__ void convert_item1(const Args& a, int it, float* scr, int lane) {
    unsigned char* ws = a.ws;
    if (it < 2 * 1408) { const int gu = it / 1408, r = it % 1408, kb = r / 88, nb = r % 88, n0 = 32 * nb;
        const float* W = a.in[gu ? 7 : 6] + (size_t)D * FF; bf16* dst = (bf16*)(ws + WB_GU1);
        const int drow = (n0 / 128) * 256 + gu * 128 + (n0 % 128);
        transpose_tile(W + (size_t)(64 * kb) * FF + n0, FF, dst + (size_t)drow * D + 64 * kb, D, scr, lane); return; } it -= 2 * 1408;
    if (it < 1408) { const int kb = it / 32, nb = it % 32;
        transpose_tile(a.in[8] + (size_t)FF * D + (size_t)(64 * kb) * D + 32 * nb, D, (bf16*)(ws + WB_DN1) + (size_t)(32 * nb) * FF + 64 * kb, FF, scr, lane); return; } it -= 1408;
    if (it < 1024) { const int kb = it / 64, nb = it % 64; transpose_tile(a.in[26] + (size_t)(64 * kb) * 2048 + 32 * nb, 2048, (bf16*)(ws + WB_LIN) + (size_t)(32 * nb) * D + 64 * kb, D, scr, lane); return; } it -= 1024;
    if (it < 256) { const int mt = it / 32, r = it % 32, ax = mt & 1, n = mt >> 1, kb = r / 8, nb = r % 8, e0 = 32 * nb;
        const float* W = a.in[ax ? 31 : 29] + (size_t)n * 256 * 256;
        const int drow = (2 * n + e0 / 128) * 256 + ax * 128 + (e0 % 128);
        transpose_tile(W + (size_t)(64 * kb) * 256 + e0, 256, (bf16*)(ws + WB_LG) + (size_t)drow * 256 + 64 * kb, 256, scr, lane); return; } it -= 256;
    { const int kb = it / 32, nb = it % 32; transpose_tile(a.in[34] + (size_t)(64 * kb) * D + 32 * nb, D, (bf16*)(ws + WB_LOUT) + (size_t)(32 * nb) * D + 64 * kb, D, scr, lane); }
}
constexpr int N_CONV_ITEMS1 = 2 * 1408 + 1408 + 1024 + 256 + 512;

__device__ __forceinline__ void adaln_item(const Args& a, int it, float* scr, int lane) {
    const int kc = it & (NKC - 1), cg = (it / NKC) % 12, combo = it / (12 * NKC);
    const float* cin = a.in[1];
#pragma unroll
    for (int i = 0; i < 4; ++i) { const int idx = lane + 64 * i, b = idx >> 6, kk = idx & 63; const float c = cin[b * D + kc * 64 + kk]; scr[idx] = siluf_(c); }
    LDS_WAIT(); asm volatile("" ::: "memory");
    const float* W = a.in[4] + ((size_t)combo * D + kc * 64) * 3072 + cg * 256 + lane * 4;
    f32x4 acc[4] = {{0.f, 0.f, 0.f, 0.f}, {0.f, 0.f, 0.f, 0.f}, {0.f, 0.f, 0.f, 0.f}, {0.f, 0.f, 0.f, 0.f}};
#pragma unroll 1
    for (int k0 = 0; k0 < 64; k0 += 16) { f32x4 w[16];
#pragma unroll
        for (int i = 0; i < 16; ++i) w[i] = *(const f32x4*)(W + (size_t)(k0 + i) * 3072);
        asm volatile("" ::: "memory");
#pragma unroll
        for (int i = 0; i < 16; ++i) {
#pragma unroll
            for (int b = 0; b < 4; ++b) acc[b] += w[i] * scr[b * 64 + k0 + i]; }
        asm volatile("" ::: "memory"); }
    float* P = (float*)(a.ws + WS_MODP);
#pragma unroll
    for (int b = 0; b < 4; ++b) *(f32x4*)(P + ((size_t)((kc * 4 + combo) * 4 + b)) * 3072 + cg * 256 + lane * 4) = acc[b];
    LDS_WAIT(); asm volatile("" ::: "memory");
}

__device__ __forceinline__ float mod_from_partials(const Args& a, int combo, int b, int n) {
    const float* P = (const float*)(a.ws + WS_MODP);
    float s = a.in[5][combo * 3072 + n];
#pragma unroll
    for (int kc = 0; kc < NKC; ++kc) s += P[((size_t)((kc * 4 + combo) * 4 + b)) * 3072 + n];
    return s;
}

__device__ __forceinline__ void st8_wt(void* p, v2u v) { __hip_atomic_store((unsigned long long*)p, ((unsigned long long)v.y << 32) | v.x, __ATOMIC_RELAXED, __HIP_MEMORY_SCOPE_AGENT); }
template <int MODE, bool XIN_BF = false, bool XOUT_BF = false>
__device__ __forceinline__ void row_pass(const Args& a, Frame& F, const void* xres_v, void* xout_v, const bf16* y, int combo_res, const float* npost, int combo_h, const float* npre) {
    float* tab = F.ldsf;
    const float* xres = (const float*)xres_v; const bf16* xres_b = (const bf16*)xres_v; float* xout = (float*)xout_v; bf16* xout_b = (bf16*)xout_v;
    const bool from_partials = (MODE == 0);
    const float* MODS = (const float*)(a.ws + WS_MODS);
    for (int rb = F.vcu; rb < M / 64; rb += F.G) {
        const int b = rb / (T / 64);
        __syncthreads();
        for (int k = F.tid; k < D; k += NWAVES * 64) {
            if (MODE != 2) {
                float sh, sc;
                if (from_partials) { sh = mod_from_partials(a, combo_h, b, k); sc = mod_from_partials(a, combo_h, b, D + k); }
                else { sh = MODS[(combo_h * 4 + b) * 3072 + k]; sc = MODS[(combo_h * 4 + b) * 3072 + D + k]; }
                tab[k] = npre[k] * (1.0f + sc); tab[D + k] = sh;
            }
            if (MODE != 0) tab[2 * D + k] = MODS[(combo_res * 4 + b) * 3072 + 2 * D + k] * npost[k];
        }
        if (MODE == 0) { const float* WSP = (const float*)(a.ws + WS_WSPEC); for (int i = F.tid * 4; i < 8 * D; i += NWAVES * 64 * 4) *(f32x4*)(tab + 3 * D + i) = *(const f32x4*)(WSP + i); }
        __syncthreads();
        constexpr int RB = 4;
#pragma unroll 1
        for (int r0 = 0; r0 < 64 / NWAVES; r0 += RB) {
            asm volatile("" ::: "memory");
            const size_t ro = (size_t)(rb * 64 + F.wave + NWAVES * r0) * D + 4 * F.lane;
            f32x4 v[RB][4];
            if (MODE == 0) {
#pragma unroll
                for (int q = 0; q < RB; ++q)
#pragma unroll
                    for (int j = 0; j < 4; ++j) v[q][j] = *(const f32x4*)(xres + ro + (size_t)q * NWAVES * D + 256 * j);
            } else {
                v2u yw[RB][4]; v2u xw[RB][4];
#pragma unroll
                for (int q = 0; q < RB; ++q)
#pragma unroll
                    for (int j = 0; j < 4; ++j) { yw[q][j] = *(const v2u*)(y + ro + (size_t)q * NWAVES * D + 256 * j);
                        if (XIN_BF) xw[q][j] = *(const v2u*)(xres_b + ro + (size_t)q * NWAVES * D + 256 * j); else v[q][j] = *(const f32x4*)(xres + ro + (size_t)q * NWAVES * D + 256 * j); }
                float rs[RB];
#pragma unroll
                for (int q = 0; q < RB; ++q) { float ss = 0.f;
#pragma unroll
                    for (int j = 0; j < 4; ++j) { const float y0 = bf_lo(yw[q][j].x), y1 = bf_hi(yw[q][j].x), y2 = bf_lo(yw[q][j].y), y3 = bf_hi(yw[q][j].y); ss += (y0 * y0 + y1 * y1) + (y2 * y2 + y3 * y3); }
                    rs[q] = rsq_(wave_sum(ss) * (1.0f / D) + EPS); }
#pragma unroll
                for (int q = 0; q < RB; ++q)
#pragma unroll
                    for (int j = 0; j < 4; ++j) asm volatile("" : "+v"(yw[q][j].x), "+v"(yw[q][j].y));
#pragma unroll
                for (int j = 0; j < 4; ++j) { const f32x4 gp = *(const f32x4*)(tab + 2 * D + 256 * j + 4 * F.lane);
#pragma unroll
                    for (int q = 0; q < RB; ++q) { f32x4 xr; if (XIN_BF) xr = (f32x4){bf_lo(xw[q][j].x), bf_hi(xw[q][j].x), bf_lo(xw[q][j].y), bf_hi(xw[q][j].y)}; else xr = v[q][j];
                        const f32x4 yv = (f32x4){bf_lo(yw[q][j].x), bf_hi(yw[q][j].x), bf_lo(yw[q][j].y), bf_hi(yw[q][j].y)};
                        v[q][j] = xr + gp * (yv * rs[q]);
#ifdef PROBE_A0
                        if (MODE == 2) { const float* pv = (const float*)(a.ws + 49152); v[q][j] = v[q][j] * (1.0f + pv[0]); if (rb == 0 && F.wave == 0 && r0 == 0 && q == 0 && j == 0 && F.lane == 0) v[q][j].x += pv[1]; }
#endif
                        if (XOUT_BF) { v2u o; o.x = pk2(v[q][j].x, v[q][j].y); o.y = pk2(v[q][j].z, v[q][j].w); st8_wt(xout_b + ro + (size_t)q * NWAVES * D + 256 * j, o); } else *(f32x4*)(xout + ro + (size_t)q * NWAVES * D + 256 * j) = v[q][j]; } }
            }
            if (MODE != 2) {
                float rs[RB];
#pragma unroll
                for (int q = 0; q < RB; ++q) { float ss = 0.f;
#pragma unroll
                    for (int j = 0; j < 4; ++j) ss += (v[q][j].x * v[q][j].x + v[q][j].y * v[q][j].y) + (v[q][j].z * v[q][j].z + v[q][j].w * v[q][j].w);
                    rs[q] = rsq_(wave_sum(ss) * (1.0f / D) + EPS); }
                bf16* H = (bf16*)(a.ws + WS_H);
#pragma unroll
                for (int j = 0; j < 4; ++j) { const f32x4 g = *(const f32x4*)(tab + 256 * j + 4 * F.lane), sh = *(const f32x4*)(tab + D + 256 * j + 4 * F.lane);
#pragma unroll
                    for (int q = 0; q < RB; ++q) { v[q][j] = v[q][j] * rs[q] * g + sh;
                        v2u o; o.x = pk2(v[q][j].x, v[q][j].y); o.y = pk2(v[q][j].z, v[q][j].w); st8_wt(H + ro + (size_t)q * NWAVES * D + 256 * j, o); } }
                if (MODE == 0) {
                    const float* WSP = tab + 3 * D;
                    const int hh = F.lane & 3;
                    float al[RB], bb[RB];
#pragma unroll
                    for (int q = 0; q < RB; ++q) { al[q] = 0.f; bb[q] = 0.f; }
#pragma unroll
                    for (int c = 0; c < 8; ++c) { float sq[RB];
#pragma unroll
                        for (int q = 0; q < RB; ++q) sq[q] = 0.f;
#pragma unroll
                        for (int j = 0; j < 4; ++j) { const f32x4 w = *(const f32x4*)(WSP + c * D + 256 * j + 4 * F.lane);
#pragma unroll
                            for (int q = 0; q < RB; ++q) sq[q] += (v[q][j].x * w.x + v[q][j].y * w.y) + (v[q][j].z * w.z + v[q][j].w * w.w); }
#pragma unroll
                        for (int q = 0; q < RB; ++q) { const float d = wave_sum(sq[q]); if (c < 4) al[q] = (hh == c) ? d : al[q]; else bb[q] = (hh == c - 4) ? d : bb[q]; } }
                    if (F.lane < 4) { float* GB = (float*)(a.ws + WS_GB); const float ea = -__expf(a.in[12][hh]), ab = a.in[13][hh];
#pragma unroll
                        for (int q = 0; q < RB; ++q) { const size_t row = (size_t)(rb * 64 + F.wave + NWAVES * (r0 + q));
                            GB[row * 8 + hh] = ea * softplusf_(al[q] + ab);
                            GB[row * 8 + 4 + hh] = sigmoidf_(bb[q]); } }
                }
            }
        }
    }
}

typedef float f32x16 __attribute__((ext_vector_type(16)));
typedef short bf16x8s __attribute__((ext_vector_type(8)));
typedef float f32x2_t __attribute__((ext_vector_type(2))); typedef __bf16 bf16x2_t __attribute__((ext_vector_type(2)));
#define MFMA32(a, b, c) __builtin_amdgcn_mfma_f32_32x32x16_bf16((a), (b), (c), 0, 0, 0)
__device__ __forceinline__ unsigned cvtpk(float lo, float hi) { f32x2_t v = {lo, hi}; bf16x2_t b = __builtin_convertvector(v, bf16x2_t); return __builtin_bit_cast(unsigned, b); }
__device__ __forceinline__ bf16 bf1(float x) { return (bf16)cvtpk(x, x); }
__device__ __forceinline__ int pi_(int k) { return (k & ~12) | ((k & 4) << 1) | ((k & 8) >> 1); }
__device__ __forceinline__ int img256(int row, int pos) { return row * 256 + ((((pos >> 3) ^ (row & 15))) << 4) + ((pos & 7) << 1); }
__device__ __forceinline__ int img128(int row, int pos) { return row * 128 + ((((pos >> 3) ^ ((row >> 1) & 7))) << 4) + ((pos & 7) << 1); }
__device__ __forceinline__ int crow(int r, int hh) { return (r & 3) + 8 * (r >> 2) + 4 * hh; }
__device__ __forceinline__ bf16x8s pack8(const f32x16& x, int s) { v4u p; p.x = cvtpk(x[8 * s], x[8 * s + 1]); p.y = cvtpk(x[8 * s + 2], x[8 * s + 3]); p.z = cvtpk(x[8 * s + 4], x[8 * s + 5]); p.w = cvtpk(x[8 * s + 6], x[8 * s + 7]); return __builtin_bit_cast(bf16x8s, p); }
__device__ __forceinline__ f32x16 unpack16(const v4u x0, const v4u x1) { f32x16 v;
    v[0] = bf_lo(x0.x); v[1] = bf_hi(x0.x); v[2] = bf_lo(x0.y); v[3] = bf_hi(x0.y); v[4] = bf_lo(x0.z); v[5] = bf_hi(x0.z); v[6] = bf_lo(x0.w); v[7] = bf_hi(x0.w);
    v[8] = bf_lo(x1.x); v[9] = bf_hi(x1.x); v[10] = bf_lo(x1.y); v[11] = bf_hi(x1.y); v[12] = bf_lo(x1.z); v[13] = bf_hi(x1.z); v[14] = bf_lo(x1.w); v[15] = bf_hi(x1.w); return v; }
__device__ __forceinline__ f32x16 zero16() { f32x16 z;
#pragma unroll
    for (int i = 0; i < 16; ++i) z[i] = 0.f; return z; }


typedef unsigned wtv4 __attribute__((__vector_size__(16)));
__device__ __forceinline__ __amdgpu_buffer_rsrc_t wt_rsrc(const void* p, unsigned bytes) {
    const unsigned long long v = (unsigned long long)p; const unsigned lo = __builtin_amdgcn_readfirstlane((unsigned)v), hi = __builtin_amdgcn_readfirstlane((unsigned)(v >> 32));
    return __builtin_amdgcn_make_buffer_rsrc((void*)(((unsigned long long)hi << 32) | lo), 0, (int)bytes, 0x00020000); }
__device__ __forceinline__ void wt16(__amdgpu_buffer_rsrc_t rs, unsigned off, v4u v) { __builtin_amdgcn_raw_buffer_store_b128(__builtin_bit_cast(wtv4, v), rs, (int)off, 0, 16); }
__device__ __forceinline__ void wt8(void* p, v2u v) { __hip_atomic_store((unsigned long long*)p, ((unsigned long long)v.y << 32) | v.x, __ATOMIC_RELAXED, __HIP_MEMORY_SCOPE_AGENT); }
__device__ __forceinline__ void wt4(void* p, float v) { __hip_atomic_store((unsigned*)p, __float_as_uint(v), __ATOMIC_RELAXED, __HIP_MEMORY_SCOPE_AGENT); }

constexpr size_t WS_QCTR = 18432;
constexpr size_t WS_RDY = 20480;
__device__ __forceinline__ void unit_arrive(unsigned char* ws, int pq, int lane) {
    if (pq >= 0) { asm volatile("s_waitcnt vmcnt(0)" ::: "memory");
        if (lane == 0) __hip_atomic_fetch_add((unsigned*)(ws + WS_RDY) + (pq % 48) * 64 + pq / 48, 1u, __ATOMIC_RELAXED, __HIP_MEMORY_SCOPE_AGENT); }
}
__device__ __forceinline__ void tri_inverse64(float* MTf_in, int lane) {
    LAS float* MTf; { unsigned a32 = (unsigned)(unsigned long long)((LAS float*)MTf_in); asm volatile("" : "+v"(a32)); MTf = (LAS float*)(unsigned long long)a32; }
    const int c = lane & 31, hb = lane >> 5;
    LAS float* Mb = MTf + hb * (32 * 68 + 32);
    float Tc[32];
#pragma unroll
    for (int i = 0; i < 32; ++i) Tc[i] = 0.f;
    f32x4 mrow[2][4];
#pragma unroll
    for (int i = 0; i < 32; ++i) {
        if (i + 1 < 32) {
#pragma unroll
            for (int j = 0; j < i + 1 && j < 16; j += 4) mrow[(i + 1) & 1][j >> 2] = *(const LAS f32x4*)(Mb + (i + 1) * 68 + j); }
        float a0 = 0.f, a1 = 0.f, a2 = 0.f, a3 = 0.f;
#pragma unroll
        for (int j = 0; j < i; j += 4) { f32x4 m4; if (j < 16) m4 = mrow[i & 1][j >> 2]; else m4 = *(const LAS f32x4*)(Mb + i * 68 + j); a0 += m4.x * Tc[j]; a1 += m4.y * Tc[j + 1]; a2 += m4.z * Tc[j + 2]; a3 += m4.w * Tc[j + 3]; }
        Tc[i] = (c == i ? 1.0f : 0.0f) - ((a0 + a1) + (a2 + a3));
        Mb[i * 68 + c] = Tc[i];
        asm volatile("" ::: "memory");
    }
    f32x16 X = zero16();
#pragma unroll
    for (int q = 0; q < 16; ++q) { const float av = MTf[(32 + c) * 68 + 2 * q + hb], bv = MTf[(2 * q + hb) * 68 + c]; X = __builtin_amdgcn_mfma_f32_32x32x2f32(av, bv, X, 0, 0, 0); }
    f32x16 Y = zero16();
#pragma unroll
    for (int r = 0; r < 16; ++r) { const float av = MTf[(32 + c) * 68 + 32 + (r & 3) + 8 * (r >> 2) + 4 * hb]; Y = __builtin_amdgcn_mfma_f32_32x32x2f32(av, X[r], Y, 0, 0, 0); }
    asm volatile("" ::: "memory");
#pragma unroll
    for (int r = 0; r < 16; ++r) MTf[(32 + (r & 3) + 8 * (r >> 2) + 4 * hb) * 68 + c] = -Y[r];
}

struct UnitPF { v4u r[14]; float g, be; };
__device__ __forceinline__ void unit_issue_main(const Args& a, int tid_, int q, UnitPF& P) {
    if (q < 0) return;
    const int n = q / 48, rr = q % 48, wave = tid_ >> 6, lane = tid_ & 63;
    const bf16* COLS = (const bf16*)(a.ws + BIG_COLS); const bf16* HALO = (const bf16*)(a.ws + WS_HALO);
    if (rr < 16) { const int b = rr >> 2, h = rr & 3, R0 = b * T + n * 64;
        const int cpart = wave < 2 ? 0 : (wave < 4 ? 1 : 2), cm = tid_ & 15, cwcol = cpart * 512 + h * 128 + cm * 8;
        const int ct0 = cpart < 2 ? ((tid_ >> 4) & 7) * 8 : ((tid_ - 256) >> 4) * 4;
#pragma unroll
        for (int r = 0; r < 11; ++r) { const int tau = ct0 + r - 3; P.r[r] = (v4u){0u, 0u, 0u, 0u};
            if (r < 7 || cpart < 2) {
                if (tau >= 0) P.r[r] = *(const v4u*)(COLS + (size_t)(R0 + tau) * NCOLS + cwcol);
                else if (n > 0) P.r[r] = *(const v4u*)(HALO + ((size_t)((b * 64 + n - 1) * 3) + (3 + tau)) * NCOLS + cwcol); } }
        if (wave == 0) { const float* GB = (const float*)(a.ws + WS_GB); P.g = GB[(size_t)(R0 + lane) * 8 + h]; P.be = GB[(size_t)(R0 + lane) * 8 + 4 + h]; }
    } else { const int b = (rr - 16) >> 3, h = (rr - 16) & 7, R0 = b * T + n * 64, hc0 = h * 64;
#pragma unroll
        for (int i = 0; i < 7; ++i) {
            const int wi = wave + 8 * i, g8b = wi >> 3, tok = (wi & 7) * 8 + (lane >> 3), lc = (g8b * 8 + (lane & 7)) * 8;
            const int rc = g8b < 3 ? g8b * 512 + hc0 + (lc & 63) : 1536 + (lc - 192);
            P.r[2 * i] = *(const v4u*)(COLS + (size_t)(R0 + tok) * NCOLS + 2048 + rc);
            v4u pw = {0u, 0u, 0u, 0u};
            if (tok > 0) pw = *(const v4u*)(COLS + (size_t)(R0 + tok - 1) * NCOLS + 2048 + rc);
            else if (n > 0) pw = *(const v4u*)(HALO + ((size_t)((b * 64 + n - 1) * 3) + 2) * NCOLS + 2048 + rc);
            P.r[2 * i + 1] = pw; }
    }
}
__device__ __forceinline__ void gdn_prep_unit(const Args& a, Frame& F, int b, int n, int h, int pq, UnitPF& P, int qn, unsigned claim, volatile LAS unsigned* slot) {
    unsigned char* L = (unsigned char*)F.ldsf;
    constexpr int QH = 0, KH = 16384, VT = 32768, KBT = 49152, KDT = 65536, MT = 81920, GS = MT + 17408, ATTI = GS + 1024, WPI = ATTI + 8192;
    float* Gs = (float*)(L + GS); float* MTf = (float*)(L + MT);
    int tid_ = F.tid; asm volatile("" : "+v"(tid_));
    const int R0 = b * T + n * 64, uid = (b * 64 + n) * 4 + h, lane = tid_ & 63, r32 = lane & 31, hh = lane >> 5;
    unsigned char* ws = a.ws;
    const bf16* COLS = (const bf16*)(ws + BIG_COLS); const bf16* HALO = (const bf16*)(ws + WS_HALO); const float* GB = (const float*)(ws + WS_GB); const float* cw = a.in[11];
    unsigned char* colsb = ws + BIG_COLS;
    const __amdgpu_buffer_rsrc_t wrs = wt_rsrc(ws, 0x10000000u);
#define SLOT(part, o) (colsb + (size_t)(R0 + ((o) >> 8)) * (NCOLS * 2) + ((part) * 512 + h * 128) * 2 + ((o) & 255))
    const int cpart = F.wave < 2 ? 0 : (F.wave < 4 ? 1 : 2), cm = tid_ & 15, cwcol = cpart * 512 + h * 128 + cm * 8;
    const int ct0 = cpart < 2 ? ((tid_ >> 4) & 7) * 8 : ((tid_ - 256) >> 4) * 4;
    v4u xr[11]; f32x4 wa[4], wb[4];
#pragma unroll
    for (int r = 0; r < 11; ++r) xr[r] = P.r[r];
#pragma unroll
    for (int j = 0; j < 4; ++j) { wa[j] = *(const f32x4*)(cw + j * 1536 + cwcol); wb[j] = *(const f32x4*)(cw + j * 1536 + cwcol + 4); }
    if (F.wave == 0) {
        const float g = P.g, be = P.be;
        float G = g;
        G = wave_scan(G);
        const float Gl = __int_as_float(__builtin_amdgcn_readlane(__float_as_int(G), 63));
        Gs[lane] = G; Gs[64 + lane] = be; Gs[128 + lane] = __expf(G); Gs[192 + lane] = __expf(Gl - G);
        if (lane == 0) wt4((float*)(ws + GDN_GL) + uid, __expf(Gl));
    }
    __syncthreads();
    unsigned qdpk[8][4];
    { const int part = cpart, m = cm, c8 = m * 8;
      if (part < 2) {
          const int run = (tid_ >> 4) & 7, t0 = run * 8;
          unsigned kbt[8][4], kdt[8][4];
#pragma unroll
          for (int r = 0; r < 8; ++r) { const int tok = t0 + r;
              float v[8];
#pragma unroll
              for (int e = 0; e < 8; ++e) v[e] = 0.f;
#pragma unroll
              for (int j = 0; j < 4; ++j) { const v4u xw = xr[r + j];
                  v[0] += wa[j].x * bf_lo(xw.x); v[1] += wa[j].y * bf_hi(xw.x); v[2] += wa[j].z * bf_lo(xw.y); v[3] += wa[j].w * bf_hi(xw.y);
                  v[4] += wb[j].x * bf_lo(xw.z); v[5] += wb[j].y * bf_hi(xw.z); v[6] += wb[j].z * bf_lo(xw.w); v[7] += wb[j].w * bf_hi(xw.w); }
              float ss = 0.f;
#pragma unroll
              for (int e = 0; e < 8; ++e) { v[e] = siluf_(v[e]); ss += v[e] * v[e]; }
              ss = hex_sum(ss);
              const float sc = rsq_(ss + EPS) * (part == 0 ? 0.08838834764831845f : 1.0f);
#pragma unroll
              for (int e = 0; e < 8; ++e) v[e] *= sc;
              v4u o; o.x = cvtpk(v[0], v[1]); o.y = cvtpk(v[2], v[3]); o.z = cvtpk(v[4], v[5]); o.w = cvtpk(v[6], v[7]);
              *(v4u*)(L + (part == 0 ? QH : KH) + tok * 256 + ((m ^ (tok & 15)) << 4)) = o;
              if (part == 0) { const float eg = Gs[128 + tok];
                  qdpk[r][0] = cvtpk(v[0] * eg, v[1] * eg); qdpk[r][1] = cvtpk(v[2] * eg, v[3] * eg); qdpk[r][2] = cvtpk(v[4] * eg, v[5] * eg); qdpk[r][3] = cvtpk(v[6] * eg, v[7] * eg);
              } else { const float sb = Gs[64 + tok] * Gs[128 + tok], sd = Gs[192 + tok];
#pragma unroll
                  for (int e = 0; e < 8; ++e) { const unsigned xb = cvtpk(v[e] * sb, v[e] * sb) & 0xffffu, xd = cvtpk(v[e] * sd, v[e] * sd) & 0xffffu;
                      if (r & 1) { kbt[e][r >> 1] |= xb << 16; kdt[e][r >> 1] |= xd << 16; } else { kbt[e][r >> 1] = xb; kdt[e][r >> 1] = xd; } } }
          }
          if (part == 1) { const int ab = run >> 1, bb = run & 1;
#pragma unroll
              for (int e = 0; e < 8; ++e) { const int ch = c8 + e, sw = (ch >> 1) & 7;
                  *(v4u*)(L + KBT + ch * 128 + ((run ^ sw) << 4)) = (v4u){kbt[e][0], kbt[e][1], kbt[e][2], kbt[e][3]};
                  *(v2u*)(L + KDT + ch * 128 + (((2 * ab) ^ sw) << 4) + 8 * bb) = (v2u){kdt[e][0], kdt[e][1]};
                  *(v2u*)(L + KDT + ch * 128 + (((2 * ab + 1) ^ sw) << 4) + 8 * bb) = (v2u){kdt[e][2], kdt[e][3]}; } }
      } else {
          const int run = (tid_ - 256) >> 4, t0 = run * 4;
          unsigned vbt[8][2];
#pragma unroll
          for (int r = 0; r < 4; ++r) { const int tok = t0 + r;
              float v[8];
#pragma unroll
              for (int e = 0; e < 8; ++e) v[e] = 0.f;
#pragma unroll
              for (int j = 0; j < 4; ++j) { const v4u xw = xr[r + j];
                  v[0] += wa[j].x * bf_lo(xw.x); v[1] += wa[j].y * bf_hi(xw.x); v[2] += wa[j].z * bf_lo(xw.y); v[3] += wa[j].w * bf_hi(xw.y);
                  v[4] += wb[j].x * bf_lo(xw.z); v[5] += wb[j].y * bf_hi(xw.z); v[6] += wb[j].z * bf_lo(xw.w); v[7] += wb[j].w * bf_hi(xw.w); }
              const float be = Gs[64 + tok];
#pragma unroll
              for (int e = 0; e < 8; ++e) { const float y = siluf_(v[e]) * be; const unsigned xb = cvtpk(y, y) & 0xffffu; if (r & 1) vbt[e][r >> 1] |= xb << 16; else vbt[e][r >> 1] = xb; } }
#pragma unroll
          for (int e = 0; e < 8; ++e) { const int ch = c8 + e; *(v2u*)(L + VT + ch * 128 + ((((t0 >> 3)) ^ ((ch >> 1) & 7)) << 4) + (t0 & 7) * 2) = (v2u){vbt[e][0], vbt[e][1]}; }
      }
    }
    unit_arrive(ws, pq, lane);
    __syncthreads();
    if (F.wave < 2) { const int m = tid_ & 15, cA = 2 * (m >> 1), t0 = ((tid_ >> 4) & 7) * 8;
#pragma unroll
        for (int r = 0; r < 8; ++r) { const int tok = t0 + r;
            wt8(SLOT(0, tok * 256 + ((cA ^ (tok & 15)) << 4) + (m & 1) * 8), (v2u){qdpk[r][0], qdpk[r][1]});
            wt8(SLOT(0, tok * 256 + (((cA + 1) ^ (tok & 15)) << 4) + (m & 1) * 8), (v2u){qdpk[r][2], qdpk[r][3]}); } }
    { const int o = tid_ * 32; const v4u x0 = *(const v4u*)(L + KDT + o), x1 = *(const v4u*)(L + KDT + o + 16); wt16(wrs, (unsigned)(SLOT(1, o) - ws), x0); wt16(wrs, (unsigned)(SLOT(1, o + 16) - ws), x1); }
    { const int p = F.wave >> 2, ti = (F.wave >> 1) & 1, tj = F.wave & 1;
      f32x16 acc = zero16();
      if (!(ti == 0 && tj == 1)) {
          const int i = 32 * ti + r32, j = 32 * tj + r32; const unsigned char* Ab = L + (p ? QH : KH) + i * 256; const unsigned char* Bb = L + KH + j * 256;
#pragma unroll
          for (int ks = 0; ks < 8; ++ks) { const bf16x8s A = *(const bf16x8s*)(Ab + (((2 * ks + hh) ^ (i & 15)) << 4)); const bf16x8s B = *(const bf16x8s*)(Bb + (((2 * ks + hh) ^ (j & 15)) << 4)); acc = MFMA32(A, B, acc); }
      }
      const int j = 32 * tj + r32; const float Gj = Gs[j]; const int pj = pi_(j);
      unsigned char* att = L + ATTI;
#pragma unroll
      for (int r = 0; r < 16; ++r) { const int i = 32 * ti + crow(r, hh); const float e = __expf(fminf(Gs[i] - Gj, 0.f));
          if (p == 0) MTf[i * 68 + j] = (i > j) ? Gs[64 + i] * acc[r] * e : 0.f;
          else *(bf16*)(att + img128(i, pj)) = bf1((i >= j) ? acc[r] * e : 0.f); }
    }
    __syncthreads();
    { const v4u x = *(const v4u*)(L + ATTI + tid_ * 16); wt16(wrs, (unsigned)(GDN_ATT + (size_t)uid * 8192 + tid_ * 16), x); }
    if (tid_ == 0) *slot = claim;
    unit_issue_main(a, tid_, qn, P);
    if (F.wave == 0) tri_inverse64(MTf, lane);
    __syncthreads();
    { const int ti = F.wave >> 2, cj = F.wave & 3, t = 32 * ti + r32, ch = 32 * cj + r32;
      f32x16 au = zero16(), aw = zero16();
#pragma unroll
      for (int ks = 0; ks < 4; ++ks) { const f32x4 t0 = *(const f32x4*)(MTf + t * 68 + 16 * ks + 8 * hh), t1 = *(const f32x4*)(MTf + t * 68 + 16 * ks + 8 * hh + 4);
          v4u pa; pa.x = cvtpk(t0.x, t0.y); pa.y = cvtpk(t0.z, t0.w); pa.z = cvtpk(t1.x, t1.y); pa.w = cvtpk(t1.z, t1.w); const bf16x8s A = __builtin_bit_cast(bf16x8s, pa);
          const int sw = ((2 * ks + hh) ^ ((ch >> 1) & 7)) << 4;
          const bf16x8s Bu = *(const bf16x8s*)(L + VT + ch * 128 + sw), Bw = *(const bf16x8s*)(L + KBT + ch * 128 + sw);
          au = MFMA32(A, Bu, au); aw = MFMA32(A, Bw, aw); }
      v4u u0, u1; u0.x = cvtpk(au[0], au[1]); u0.y = cvtpk(au[2], au[3]); u0.z = cvtpk(au[4], au[5]); u0.w = cvtpk(au[6], au[7]);
      u1.x = cvtpk(au[8], au[9]); u1.y = cvtpk(au[10], au[11]); u1.z = cvtpk(au[12], au[13]); u1.w = cvtpk(au[14], au[15]);
      const int o = ((ti * 4 + cj) * 64 + lane) * 32;
      wt16(wrs, (unsigned)(SLOT(2, o) - ws), u0); wt16(wrs, (unsigned)(SLOT(2, o + 16) - ws), u1);
      unsigned char* wp = L + WPI; const int pk = pi_(ch);
#pragma unroll
      for (int r = 0; r < 16; ++r) { const int tt = 32 * ti + crow(r, hh); *(bf16*)(wp + img256(tt, pk)) = bf1(-aw[r]); }
    }
    __syncthreads();
    { const int o = tid_ * 32; const v4u x0 = *(const v4u*)(L + WPI + o), x1 = *(const v4u*)(L + WPI + o + 16); wt16(wrs, (unsigned)(GDN_WP + (size_t)uid * 16384 + o), x0); wt16(wrs, (unsigned)(GDN_WP + (size_t)uid * 16384 + o + 16), x1); }
#undef SLOT
}


__device__ __forceinline__ void unit_publish(unsigned char* ws, int q) {
    asm volatile("s_waitcnt vmcnt(0)" ::: "memory");
    __syncthreads();
    if (threadIdx.x == 0) __hip_atomic_store((unsigned*)(ws + WS_RDY) + (q % 48) * 64 + q / 48, 1u, __ATOMIC_RELAXED, __HIP_MEMORY_SCOPE_AGENT);
}
__device__ __forceinline__ void unit_wait4(unsigned char* ws, int r, int k) {
    unsigned* f = (unsigned*)(ws + WS_RDY) + r * 64 + 4 * k; unsigned spins = 0;
    for (;;) { unsigned ok = 1u;
#pragma unroll
        for (int i = 0; i < 4; ++i) ok &= (__hip_atomic_load(f + i, __ATOMIC_RELAXED, __HIP_MEMORY_SCOPE_AGENT) >= 8u) ? 1u : 0u;
        if (__builtin_amdgcn_readfirstlane(ok)) break;
        __builtin_amdgcn_s_sleep(8); if (++spins > (1u << 13)) break; }
    __builtin_amdgcn_fence(__ATOMIC_ACQUIRE, "agent");
    asm volatile("s_waitcnt vmcnt(0)" ::: "memory");
}
__device__ __forceinline__ __amdgpu_buffer_rsrc_t mk_rsrc(const void* p, unsigned bytes) {
    const unsigned long long v = (unsigned long long)p; const unsigned lo = __builtin_amdgcn_readfirstlane((unsigned)v), hi = __builtin_amdgcn_readfirstlane((unsigned)(v >> 32));
    return __builtin_amdgcn_make_buffer_rsrc((void*)(((unsigned long long)hi << 32) | lo), 0, (int)bytes, 0x00020000); }
__device__ __forceinline__ void aload16(v4u& dst, __amdgpu_buffer_rsrc_t rs, unsigned voff, unsigned soff) {
    const unsigned so = __builtin_amdgcn_readfirstlane(soff);
    asm volatile("s_nop 4\n\tbuffer_load_dwordx4 %0, %1, %2, %3 offen" : "=v"(dst) : "v"(voff), "s"(rs), "s"(so) : "memory"); }
__device__ __forceinline__ void aload4(float& dst, __amdgpu_buffer_rsrc_t rs, unsigned voff, unsigned soff) {
    const unsigned so = __builtin_amdgcn_readfirstlane(soff);
    asm volatile("s_nop 4\n\tbuffer_load_dword %0, %1, %2, %3 offen" : "=v"(dst) : "v"(voff), "s"(rs), "s"(so) : "memory"); }
#define VMW4(N, A) asm volatile("s_waitcnt vmcnt(" #N ")" : "+v"((A)[0]), "+v"((A)[1]), "+v"((A)[2]), "+v"((A)[3]) :: "memory")
constexpr int GSTG = 57600;
constexpr int GUB = 2 * GSTG;
constexpr int GOB = GUB + 16384;
constexpr int GOBS = 136;
struct GdnSet { v4u sx[14]; float sg; };
struct GdnAux { v4u su[4]; v4u z[4]; };
__device__ __forceinline__ void gdn_ld_sx(__amdgpu_buffer_rsrc_t rs, int b, int h, int n, int ltid, GdnSet& S) {
    const int R0 = b * T + n * 64, uid = (b * 64 + n) * 4 + h;
    const unsigned ow = (unsigned)(GDN_WP + (size_t)uid * 16384), os = (unsigned)(BIG_COLS + (size_t)R0 * (NCOLS * 2) + (h * 128) * 2), oa = (unsigned)(GDN_ATT + (size_t)uid * 8192);
    const unsigned l16 = (unsigned)ltid * 16u, lsl = (l16 >> 8) * (unsigned)(NCOLS * 2) + (l16 & 255u);
#pragma unroll
    for (int i = 0; i < 4; ++i) aload16(S.sx[i], rs, l16, ow + 4096u * i);
#pragma unroll
    for (int i = 4; i < 12; ++i) aload16(S.sx[i], rs, lsl, os + (i < 8 ? 0u : 1024u) + (unsigned)((i & 3) * 16 * NCOLS * 2));
#pragma unroll
    for (int i = 12; i < 14; ++i) aload16(S.sx[i], rs, l16, oa + 4096u * (i - 12));
    aload4(S.sg, rs, 0u, (unsigned)(GDN_GL + (size_t)uid * 4));
}
__device__ __forceinline__ void gdn_ld_su(__amdgpu_buffer_rsrc_t rs, int b, int h, int n, int ltid, GdnAux& S) {
    const unsigned os = (unsigned)(BIG_COLS + (size_t)(b * T + n * 64) * (NCOLS * 2) + (2 * 512 + h * 128) * 2);
    const unsigned l16 = (unsigned)ltid * 16u, lsl = (l16 >> 8) * (unsigned)(NCOLS * 2) + (l16 & 255u);
#pragma unroll
    for (int i = 0; i < 4; ++i) aload16(S.su[i], rs, lsl, os + (unsigned)(i * 16 * NCOLS * 2));
}
__device__ __forceinline__ void gdn_ld_z(__amdgpu_buffer_rsrc_t rs, int b, int h, int n, int lw, int lane, GdnAux& S) {
    const unsigned voff = (unsigned)((lw * 16 + (lane >> 2)) * (NCOLS * 2) + (lane & 3) * 16);
    const unsigned so = (unsigned)(BIG_COLS + (size_t)(b * T + n * 64) * (NCOLS * 2) + (1536 + h * 128) * 2);
#pragma unroll
    for (int q = 0; q < 4; ++q) aload16(S.z[q], rs, voff, so + 64u * q);
}
#define GDN_WAIT_SX(N, S) asm volatile("s_waitcnt vmcnt(" #N ")" : "+v"((S).sx[0]), "+v"((S).sx[1]), "+v"((S).sx[2]), "+v"((S).sx[3]), "+v"((S).sx[4]), "+v"((S).sx[5]), "+v"((S).sx[6]), "+v"((S).sx[7]), \
    "+v"((S).sx[8]), "+v"((S).sx[9]), "+v"((S).sx[10]), "+v"((S).sx[11]), "+v"((S).sx[12]), "+v"((S).sx[13]), "+v"((S).sg) :: "memory")
__device__ __forceinline__ void gdn_st_sx(unsigned char* L, int stg, int ltid, const GdnSet& S) {
#pragma unroll
    for (int i = 0; i < 14; ++i) { const int q = ltid + 256 * i; *(v4u*)(L + stg * GSTG + q * 16) = S.sx[i]; }
    if (ltid == 0) *(float*)(L + stg * GSTG + 57344) = S.sg;
}
__device__ __forceinline__ void gdn_st_su(unsigned char* L, int ltid, const GdnAux& S) {
#pragma unroll
    for (int i = 0; i < 4; ++i) *(v4u*)(L + GUB + (ltid + 256 * i) * 16) = S.su[i];
}
constexpr int GNW = GOB + 17408;
__device__ __forceinline__ void gdn_post(unsigned char* ws, const unsigned char* L, int b, int h, int n, int lw, int lane, const GdnAux& S) {
    const int tok = lw * 16 + (lane >> 2), part = lane & 3; const size_t row = (size_t)(b * T + n * 64 + tok);
    bf16* op = (bf16*)(ws + WS_H) + row * D + h * 128 + 8 * part;
    float ss = 0.f;
    v4u xv[4];
#pragma unroll
    for (int q = 0; q < 4; ++q) { xv[q] = *(const v4u*)(L + GOB + (tok * GOBS + 8 * (4 * q + part)) * 2); const v4u xq = xv[q];
        const float a0 = bf_lo(xq.x), a1 = bf_hi(xq.x), a2 = bf_lo(xq.y), a3 = bf_hi(xq.y), a4 = bf_lo(xq.z), a5 = bf_hi(xq.z), a6 = bf_lo(xq.w), a7 = bf_hi(xq.w);
        ss += ((a0 * a0 + a1 * a1) + (a2 * a2 + a3 * a3)) + ((a4 * a4 + a5 * a5) + (a6 * a6 + a7 * a7)); }
    ss = quad_sum(ss);
    const float rstd = rsq_(ss * (1.0f / 128.0f) + EPS);
#pragma unroll
    for (int q = 0; q < 4; ++q) { const v4u z = S.z[q]; const v4u x = xv[q];
        v4u r; r.x = cvtpk(bf_lo(x.x) * rstd * bf_lo(z.x), bf_hi(x.x) * rstd * bf_hi(z.x)); r.y = cvtpk(bf_lo(x.y) * rstd * bf_lo(z.y), bf_hi(x.y) * rstd * bf_hi(z.y));
        r.z = cvtpk(bf_lo(x.z) * rstd * bf_lo(z.z), bf_hi(x.z) * rstd * bf_hi(z.z)); r.w = cvtpk(bf_lo(x.w) * rstd * bf_lo(z.w), bf_hi(x.w) * rstd * bf_hi(z.w));
        *(v4u*)(op + 32 * q) = r; }
}
#define SB0() __builtin_amdgcn_sched_barrier(0)
__device__ __forceinline__ bf16x8s ldfrag(const unsigned char* p) { return *(const bf16x8s*)p; }
__device__ __forceinline__ void gdn_chain_step(unsigned char* L, int stg, int vt, int lane, int r32, int hh, f32x16 (&S)[4]) {
    const unsigned char* st = L + stg * GSTG;
    f32x16 o[2], vn[2];
#pragma unroll
    for (int rb = 0; rb < 2; ++rb) { const unsigned char* up = L + GUB + ((rb * 4 + vt) * 64 + lane) * 32; vn[rb] = unpack16(*(const v4u*)up, *(const v4u*)(up + 16)); }
    const float glc = *(const float*)(st + 57344);
#define G_OFF1(j) ((32 * ((j) >> 3) + r32) * 256 + (((4 * (((j) >> 1) & 3) + 2 * ((j) & 1) + hh) ^ ((32 * ((j) >> 3) + r32) & 15)) << 4))
    bf16x8s aw[4], aq[4];
#pragma unroll
    for (int j = 0; j < 3; ++j) { aw[j] = ldfrag(st + G_OFF1(j)); aq[j] = ldfrag(st + 16384 + G_OFF1(j)); }
    bf16x8s Sb[4][2];
#pragma unroll
    for (int kt = 0; kt < 4; ++kt) { Sb[kt][0] = pack8(S[kt], 0); Sb[kt][1] = pack8(S[kt], 1); }
    o[0] = zero16(); o[1] = zero16();
    SB0();
#pragma unroll
    for (int j = 0; j < 16; ++j) { const int rb = j >> 3, kt = (j >> 1) & 3, s2 = j & 1;
        if (j + 3 < 16) { aw[(j + 3) & 3] = ldfrag(st + G_OFF1(j + 3)); aq[(j + 3) & 3] = ldfrag(st + 16384 + G_OFF1(j + 3)); }
        SB0();
        vn[rb] = MFMA32(aw[j & 3], Sb[kt][s2], vn[rb]); o[rb] = MFMA32(aq[j & 3], Sb[kt][s2], o[rb]);
        SB0(); }
#define G_OFF2(c, q) (49152 + (c) * 128 + ((((q) + hh) ^ (((c) >> 1) & 7)) << 4))
#define G_OFF3(k, q) (32768 + (k) * 128 + ((((q) + hh) ^ (((k) >> 1) & 7)) << 4))
    bf16x8s at[6];
    { const int c0 = r32, c1 = 32 + r32;
      at[0] = ldfrag(st + G_OFF2(c0, 0)); at[1] = ldfrag(st + G_OFF2(c0, 2)); at[2] = ldfrag(st + G_OFF2(c1, 0)); at[3] = ldfrag(st + G_OFF2(c1, 2)); at[4] = ldfrag(st + G_OFF2(c1, 4)); at[5] = ldfrag(st + G_OFF2(c1, 6)); }
    bf16x8s ak[4];
#pragma unroll
    for (int j = 0; j < 3; ++j) ak[j] = ldfrag(st + G_OFF3(32 * (j >> 2) + r32, 2 * (j & 3)));
    bf16x8s Vb[2][2];
#pragma unroll
    for (int rb = 0; rb < 2; ++rb) { Vb[rb][0] = pack8(vn[rb], 0); Vb[rb][1] = pack8(vn[rb], 1); }
#pragma unroll
    for (int kt = 0; kt < 4; ++kt)
#pragma unroll
        for (int r = 0; r < 16; ++r) S[kt][r] *= glc;
    o[0] = MFMA32(at[0], Vb[0][0], o[0]); o[0] = MFMA32(at[1], Vb[0][1], o[0]);
    o[1] = MFMA32(at[2], Vb[0][0], o[1]); o[1] = MFMA32(at[3], Vb[0][1], o[1]); o[1] = MFMA32(at[4], Vb[1][0], o[1]); o[1] = MFMA32(at[5], Vb[1][1], o[1]);
    SB0();
#pragma unroll
    for (int j = 0; j < 16; ++j) { const int kt = j >> 2, rb2 = (j >> 1) & 1, s2 = j & 1;
        if (j + 3 < 16) ak[(j + 3) & 3] = ldfrag(st + G_OFF3(32 * ((j + 3) >> 2) + r32, 2 * ((j + 3) & 3)));
        SB0();
        S[kt] = MFMA32(ak[j & 3], Vb[rb2][s2], S[kt]);
        SB0(); }
    __syncthreads();
#pragma unroll
    for (int rb = 0; rb < 2; ++rb)
#pragma unroll
        for (int r = 0; r < 16; ++r) *(bf16*)(L + GOB + ((32 * rb + crow(r, hh)) * GOBS + 32 * vt + r32) * 2) = bf1(o[rb][r]);
    __syncthreads();
#undef G_OFF1
#undef G_OFF2
#undef G_OFF3
}
template <bool FAST>
__device__ __forceinline__ void gdn_loader_step(__amdgpu_buffer_rsrc_t rs, unsigned char* ws, unsigned char* L, int b, int h, int n, int lw, int ltid, GdnSet& P, GdnAux& X) {
    if (FAST) GDN_WAIT_SX(31, P); else GDN_WAIT_SX(0, P);
    if (n + 1 < T / 64) gdn_st_sx(L, (n + 1) & 1, ltid, P);
    if (((n + 3) & 3) == 0 && n + 3 < T / 64) unit_wait4(ws, b * 4 + h, (n + 3) >> 2);
    gdn_ld_sx(rs, b, h, n + 3 < T / 64 ? n + 3 : T / 64 - 1, ltid, P);
    if (FAST) VMW4(19, X.z); else VMW4(0, X.z);
    if (n > 0) gdn_post(ws, L, b, h, n - 1, lw, ltid & 63, X);
    gdn_ld_z(rs, b, h, n, lw, ltid & 63, X);
    __syncthreads();
    if (FAST) VMW4(19, X.su); else VMW4(0, X.su);
    if (n + 1 < T / 64) gdn_st_su(L, ltid, X);
    gdn_ld_su(rs, b, h, n + 2 < T / 64 ? n + 2 : T / 64 - 1, ltid, X);
    __syncthreads();
}
__device__ __forceinline__ void gdn_chain(const Args& a, Frame& F, int b, int h) {
    unsigned char* L = (unsigned char*)F.ldsf;
    unsigned char* ws = a.ws;
    int tid0 = F.tid; asm volatile("" : "+v"(tid0));
    const int lane = tid0 & 63, r32_ = lane & 31, hh_ = lane >> 5;
    const bool chain = F.wave < 4; const int vt = F.wave & 3;
    if (chain) {
        f32x16 S[4];
#pragma unroll
        for (int kt = 0; kt < 4; ++kt) S[kt] = zero16();
        __syncthreads();
        for (int n = 0; n < T / 64; n += 2) {
            int r32 = r32_, hh = hh_; asm volatile("" : "+v"(r32), "+v"(hh));
            gdn_chain_step(L, 0, vt, lane, r32, hh, S);
            gdn_chain_step(L, 1, vt, lane, r32, hh, S);
        }
        __syncthreads();
    } else {
        GdnSet A, B; GdnAux X;
        const int lt = tid0 - 256, lw = F.wave - 4;
        const __amdgpu_buffer_rsrc_t rs = mk_rsrc(ws, 0x10000000u);
        if (lt < 128) *(float*)(L + GNW + lt * 4) = a.in[14][lt];
        unit_wait4(ws, b * 4 + h, 0);
        gdn_ld_sx(rs, b, h, 0, lt, A); gdn_ld_su(rs, b, h, 0, lt, X); GDN_WAIT_SX(0, A); VMW4(0, X.su); gdn_st_sx(L, 0, lt, A); gdn_st_su(L, lt, X);
        gdn_ld_sx(rs, b, h, 1, lt, B); gdn_ld_sx(rs, b, h, 2, lt, A); gdn_ld_su(rs, b, h, 1, lt, X); gdn_ld_z(rs, b, h, 0, lw, lane, X);
        __syncthreads();
        for (int n = 0; n < 4; n += 2) {
            int ltid = lt; asm volatile("" : "+v"(ltid));
            gdn_loader_step<false>(rs, ws, L, b, h, n, lw, ltid, B, X);
            gdn_loader_step<false>(rs, ws, L, b, h, n + 1, lw, ltid, A, X);
        }
        for (int n = 4; n < T / 64; n += 2) {
            int ltid = lt; asm volatile("" : "+v"(ltid));
            gdn_loader_step<true>(rs, ws, L, b, h, n, lw, ltid, B, X);
            gdn_loader_step<true>(rs, ws, L, b, h, n + 1, lw, ltid, A, X);
        }
        VMW4(0, X.z);
        gdn_post(ws, L, b, h, T / 64 - 1, lw, lane, X);
        asm volatile("s_waitcnt vmcnt(0)" ::: "memory");
        __syncthreads();
    }
}

__device__ __forceinline__ void rwkv_prep_unit(const Args& a, Frame& F, int b, int n, int h, int pq, UnitPF& P, int qn, unsigned claim, volatile LAS unsigned* slot) {
    unsigned char* L = (unsigned char*)F.ldsf;
    constexpr int RM = 0, KM = 16384, VM = 32768;
    constexpr int KT = 0, KTT = 8192, BTI = 16384, KTIL = 24576, RT = 32768, VT = 40960;
    constexpr int LWI = 49152, LAI = 57344, LGI = 65536;
    constexpr int KHT = 49152, BHT = 57344, AKK = 65536, ARK = 73728;
    constexpr int LOGW = 81920, AA = 98560, CLS = 114944, MT = 115456;
    constexpr int LWS = 65;
    constexpr int GI = MT, ARBI = LOGW, WMI = AA;
    float* MTf = (float*)(L + MT); float* LOGWf = (float*)(L + LOGW); float* AAf = (float*)(L + AA); float* CLf = (float*)(L + CLS);
    int tid_ = F.tid; asm volatile("" : "+v"(tid_));
    const int R0 = b * T + n * 64, uid = ((b * 64 + n) << 3) + h, lane = tid_ & 63, r32 = lane & 31, hh = lane >> 5, hc0 = h * 64;
    unsigned char* ws = a.ws; unsigned char* dob = (unsigned char*)a.out;
    const bf16* COLS = (const bf16*)(ws + BIG_COLS); const bf16* HALO = (const bf16*)(ws + WS_HALO);
    unsigned char* colsb = ws + BIG_COLS;
    const __amdgpu_buffer_rsrc_t wrs = wt_rsrc(ws, 0x10000000u), wrd = wt_rsrc(dob, 0x04000000u);
    const float* mu = a.in[15]; const float* w0 = a.in[16]; const float* a0 = a.in[18]; const float* k_k = a.in[21]; const float* k_a = a.in[22]; const float* r_k = a.in[23];
#define SLOTR(part, o) (colsb + (size_t)(R0 + ((o) >> 7)) * (NCOLS * 2) + (2048 + (part) * 512 + hc0) * 2 + ((o) & 127))
#pragma unroll
    for (int i = 0; i < 7; ++i) {
        const int wi = F.wave + 8 * i, g8b = wi >> 3, tok = (wi & 7) * 8 + (lane >> 3), lc = (g8b * 8 + (lane & 7)) * 8;
        const int rc = g8b < 3 ? g8b * 512 + hc0 + (lc & 63) : 1536 + (lc - 192);
        const v4u cw = P.r[2 * i], pw = P.r[2 * i + 1];
        const float cur[8] = {bf_lo(cw.x), bf_hi(cw.x), bf_lo(cw.y), bf_hi(cw.y), bf_lo(cw.z), bf_hi(cw.z), bf_lo(cw.w), bf_hi(cw.w)};
        const float prv[8] = {bf_lo(pw.x), bf_hi(pw.x), bf_lo(pw.y), bf_hi(pw.y), bf_lo(pw.z), bf_hi(pw.z), bf_lo(pw.w), bf_hi(pw.w)};
        float v[8];
        { const f32x4 m0 = *(const f32x4*)(mu + rc), m1 = *(const f32x4*)(mu + rc + 4); const float mm[8] = {m0.x, m0.y, m0.z, m0.w, m1.x, m1.y, m1.z, m1.w};
#pragma unroll
          for (int e = 0; e < 8; ++e) v[e] = cur[e] + mm[e] * (prv[e] - cur[e]); }
        if (g8b < 3) { float* dst = (float*)(L + (g8b == 0 ? RM : (g8b == 1 ? KM : VM))) + tok * 64 + (lc & 63);
            *(f32x4*)dst = (f32x4){v[0], v[1], v[2], v[3]}; *(f32x4*)(dst + 4) = (f32x4){v[4], v[5], v[6], v[7]}; }
        else { const int idx = lc - 192;
            if (g8b == 3) {
#pragma unroll
                for (int e = 0; e < 8; ++e) v[e] = tanh_fast(v[e]);
            } else if (g8b >= 5) {
#pragma unroll
                for (int e = 0; e < 8; ++e) v[e] = sigmoidf_(v[e]);
            }
            v4u o; o.x = cvtpk(v[0], v[1]); o.y = cvtpk(v[2], v[3]); o.z = cvtpk(v[4], v[5]); o.w = cvtpk(v[6], v[7]);
            if (g8b == 3) *(v4u*)(L + LWI + tok * 128 + (((idx >> 3) ^ ((tok >> 1) & 7)) << 4)) = o;
            else if (g8b == 4) *(v4u*)(L + LAI + tok * 128 + ((((idx - 64) >> 3) ^ ((tok >> 1) & 7)) << 4)) = o;
            else *(v4u*)(L + LGI + tok * 256 + ((((idx - 128) >> 3) ^ (tok & 15)) << 4)) = o; }
    }
    unit_arrive(ws, pq, lane);
    __syncthreads();
    { const int wq = F.wave & 3, ti = wq >> 1, tj = wq & 1, t = 32 * ti + r32, j = 32 * tj + r32;
      const unsigned char* lwb = ws + RW_LW + ((size_t)(h * 64 + j) * 256) * 2;
      if (F.wave < 4) {
          f32x16 aw = zero16(), aa = zero16();
#pragma unroll
          for (int ks = 0; ks < 4; ++ks) { const int sw = ((2 * ks + hh) ^ ((t >> 1) & 7)) << 4;
              const bf16x8s Aw = *(const bf16x8s*)(L + LWI + t * 128 + sw), Aa = *(const bf16x8s*)(L + LAI + t * 128 + sw);
              const bf16x8s Bw = *(const bf16x8s*)(lwb + (16 * ks + 8 * hh) * 2), Ba = *(const bf16x8s*)(lwb + (64 + 16 * ks + 8 * hh) * 2);
              aw = MFMA32(Aw, Bw, aw); aa = MFMA32(Aa, Ba, aa); }
          const float w0j = w0[hc0 + j], a0j = a0[hc0 + j];
#pragma unroll
          for (int r = 0; r < 16; ++r) { const int tt = 32 * ti + crow(r, hh);
              LOGWf[j * LWS + tt] = -__expf(-softplus_fast(-(w0j + aw[r])) - 0.5f); AAf[tt * 64 + j] = sigmoidf_(a0j + aa[r]); }
      } else {
          f32x16 ag = zero16();
#pragma unroll
          for (int ks = 0; ks < 8; ++ks) { const bf16x8s Ag = *(const bf16x8s*)(L + LGI + t * 256 + (((2 * ks + hh) ^ (t & 15)) << 4));
              const bf16x8s Bg = *(const bf16x8s*)(lwb + (128 + 16 * ks + 8 * hh) * 2); ag = MFMA32(Ag, Bg, ag); }
#pragma unroll
          for (int r = 0; r < 16; ++r) { const int tt = 32 * ti + crow(r, hh); *(bf16*)(L + GI + tt * 128 + j * 2) = bf1(ag[r]); }
      }
    }
    __syncthreads();
    { const int o = tid_ * 16; const v4u x = *(const v4u*)(L + GI + o); wt16(wrs, (unsigned)(SLOTR(1, o) - ws), x); }
    {
#pragma unroll
      for (int q = 0; q < 8; ++q) { const int j = F.wave * 8 + q; float x = LOGWf[j * LWS + lane];
          x = wave_scan(x);
          LOGWf[j * LWS + lane] = x; if (lane == 63) CLf[j] = x; }
    }
    __syncthreads();
    const int et = tid_ >> 3, em = tid_ & 7, ej0 = em * 8;
    unsigned pk_kt[4], pk_bt[4], pk_ktil[4], pk_rt[4], pk_bh[4], pk_kh[4], pk_v[4], pk_bv[4];
    {
        float rr[8], kk_[8], vv[8], aa[8], cu[8], cp[8], cl[8];
        { const f32x4 x0 = *(const f32x4*)(L + RM + (et * 64 + ej0) * 4), x1 = *(const f32x4*)(L + RM + (et * 64 + ej0 + 4) * 4); rr[0] = x0.x; rr[1] = x0.y; rr[2] = x0.z; rr[3] = x0.w; rr[4] = x1.x; rr[5] = x1.y; rr[6] = x1.z; rr[7] = x1.w; }
        { const f32x4 x0 = *(const f32x4*)(L + KM + (et * 64 + ej0) * 4), x1 = *(const f32x4*)(L + KM + (et * 64 + ej0 + 4) * 4); kk_[0] = x0.x; kk_[1] = x0.y; kk_[2] = x0.z; kk_[3] = x0.w; kk_[4] = x1.x; kk_[5] = x1.y; kk_[6] = x1.z; kk_[7] = x1.w; }
        { const f32x4 x0 = *(const f32x4*)(L + VM + (et * 64 + ej0) * 4), x1 = *(const f32x4*)(L + VM + (et * 64 + ej0 + 4) * 4); vv[0] = x0.x; vv[1] = x0.y; vv[2] = x0.z; vv[3] = x0.w; vv[4] = x1.x; vv[5] = x1.y; vv[6] = x1.z; vv[7] = x1.w; }
        { const f32x4 x0 = *(const f32x4*)(AAf + et * 64 + ej0), x1 = *(const f32x4*)(AAf + et * 64 + ej0 + 4); aa[0] = x0.x; aa[1] = x0.y; aa[2] = x0.z; aa[3] = x0.w; aa[4] = x1.x; aa[5] = x1.y; aa[6] = x1.z; aa[7] = x1.w; }
#pragma unroll
        for (int e = 0; e < 8; ++e) { cu[e] = LOGWf[(ej0 + e) * LWS + et]; const float pv_ = LOGWf[(ej0 + e) * LWS + (et > 0 ? et - 1 : 0)]; cp[e] = et > 0 ? pv_ : 0.f; }
        { const f32x4 x0 = *(const f32x4*)(CLf + ej0), x1 = *(const f32x4*)(CLf + ej0 + 4); cl[0] = x0.x; cl[1] = x0.y; cl[2] = x0.z; cl[3] = x0.w; cl[4] = x1.x; cl[5] = x1.y; cl[6] = x1.z; cl[7] = x1.w; }
        float kkr[8], km2[8]; float ss = 0.f, bs = 0.f;
#pragma unroll
        for (int e = 0; e < 8; e += 4) { const int c = hc0 + ej0 + e; const f32x4 kk4 = *(const f32x4*)(k_k + c), ka4 = *(const f32x4*)(k_a + c), rk4 = *(const f32x4*)(r_k + c);
#pragma unroll
            for (int q = 0; q < 4; ++q) { kkr[e + q] = kk_[e + q] * kk4[q]; ss += kkr[e + q] * kkr[e + q]; km2[e + q] = kk_[e + q] * (1.0f + (aa[e + q] - 1.0f) * ka4[q]); bs += rr[e + q] * km2[e + q] * rk4[q]; } }
        ss = oct_sum(ss); bs = oct_sum(bs);
        const float rn = rsq_(ss + EPS);
        float o_kt[8], o_bt[8], o_ktil[8], o_rt[8], o_bh[8], o_kh[8], o_bv[8];
#pragma unroll
        for (int e = 0; e < 8; ++e) { const float kkn = kkr[e] * rn, kka = kkn * aa[e];
            const float eW = __expf(cu[e]), eWm1 = __expf(cp[e]), eWi = __expf(-cu[e]), eWC = __expf(cl[e] - cu[e]);
            o_kt[e] = kkn * eWm1; o_bt[e] = kka * eWi; o_ktil[e] = km2[e] * eWi; o_rt[e] = rr[e] * eW; o_bh[e] = kka * eWC; o_kh[e] = km2[e] * eWC; o_bv[e] = bs * vv[e]; }
#pragma unroll
        for (int q = 0; q < 4; ++q) { pk_kt[q] = cvtpk(o_kt[2 * q], o_kt[2 * q + 1]); pk_bt[q] = cvtpk(o_bt[2 * q], o_bt[2 * q + 1]); pk_ktil[q] = cvtpk(o_ktil[2 * q], o_ktil[2 * q + 1]); pk_rt[q] = cvtpk(o_rt[2 * q], o_rt[2 * q + 1]);
            pk_bh[q] = cvtpk(o_bh[2 * q], o_bh[2 * q + 1]); pk_kh[q] = cvtpk(o_kh[2 * q], o_kh[2 * q + 1]); pk_v[q] = cvtpk(vv[2 * q], vv[2 * q + 1]); pk_bv[q] = cvtpk(o_bv[2 * q], o_bv[2 * q + 1]); }
        if (tid_ < 64) wt4((float*)(ws + RW_WC) + (size_t)uid * 64 + tid_, __expf(CLf[tid_]));
    }
    __syncthreads();
    { const int sw = (em ^ ((et >> 1) & 7)) << 4;
      *(v4u*)(L + KT + et * 128 + sw) = (v4u){pk_kt[0], pk_kt[1], pk_kt[2], pk_kt[3]};
      *(v4u*)(L + BTI + et * 128 + sw) = (v4u){pk_bt[0], pk_bt[1], pk_bt[2], pk_bt[3]};
      *(v4u*)(L + KTIL + et * 128 + sw) = (v4u){pk_ktil[0], pk_ktil[1], pk_ktil[2], pk_ktil[3]};
      *(v4u*)(L + RT + et * 128 + sw) = (v4u){pk_rt[0], pk_rt[1], pk_rt[2], pk_rt[3]};
      const int pt = pi_(et);
#pragma unroll
      for (int e = 0; e < 8; ++e) { const int j = ej0 + e; const int sh = (e & 1) * 16; const int q = e >> 1;
          const int ad = j * 128 + (((et >> 3) ^ ((j >> 1) & 7)) << 4) + (et & 7) * 2;
          *(bf16*)(L + KTT + ad) = (bf16)(pk_kt[q] >> sh); *(bf16*)(L + VT + ad) = (bf16)(pk_v[q] >> sh); *(bf16*)(L + KHT + ad) = (bf16)(pk_kh[q] >> sh);
          *(bf16*)(L + BHT + j * 128 + (((pt >> 3) ^ ((j >> 1) & 7)) << 4) + (pt & 7) * 2) = (bf16)(pk_bh[q] >> sh); }
      const int cA = 2 * (em >> 1), swr = (et >> 1) & 7;
      wt8(SLOTR(0, et * 128 + ((cA ^ swr) << 4) + (em & 1) * 8), (v2u){pk_rt[0], pk_rt[1]});
      wt8(SLOTR(0, et * 128 + (((cA + 1) ^ swr) << 4) + (em & 1) * 8), (v2u){pk_rt[2], pk_rt[3]});
      wt16(wrs, (unsigned)(SLOTR(2, et * 128 + ej0 * 2) - ws), (v4u){pk_bv[0], pk_bv[1], pk_bv[2], pk_bv[3]});
    }
    __syncthreads();
    { const v4u x = *(const v4u*)(L + BHT + tid_ * 16); wt16(wrd, (unsigned)(DO_BT + (size_t)uid * 8192 + tid_ * 16), x); }
#pragma unroll
    for (int rep = 0; rep < 2; ++rep) { const int q = F.wave + 8 * rep, pr = q >> 2, ti = (q >> 1) & 1, tj = q & 1, t = 32 * ti + r32, s2 = 32 * tj + r32;
        f32x16 acc = zero16();
        if (!(ti == 0 && tj == 1)) {
            const unsigned char* Ab = L + (pr < 2 ? KT : RT) + t * 128; const unsigned char* Bb = L + ((pr & 1) ? KTIL : BTI) + s2 * 128;
#pragma unroll
            for (int ks = 0; ks < 4; ++ks) { const bf16x8s A = *(const bf16x8s*)(Ab + (((2 * ks + hh) ^ ((t >> 1) & 7)) << 4)); const bf16x8s B = *(const bf16x8s*)(Bb + (((2 * ks + hh) ^ ((s2 >> 1) & 7)) << 4)); acc = MFMA32(A, B, acc); }
        }
        const int ps = pi_(s2);
#pragma unroll
        for (int r = 0; r < 16; ++r) { const int tt = 32 * ti + crow(r, hh);
            if (pr == 0) MTf[tt * 68 + s2] = (tt > s2) ? acc[r] : 0.f;
            else if (pr == 1) *(bf16*)(L + AKK + img128(tt, s2)) = bf1((tt > s2) ? acc[r] : 0.f);
            else if (pr == 2) *(bf16*)(L + ARBI + img128(tt, ps)) = bf1((tt >= s2) ? acc[r] : 0.f);
            else *(bf16*)(L + ARK + img128(tt, s2)) = bf1((tt >= s2) ? acc[r] : 0.f); }
    }
    __syncthreads();
    { const v4u x = *(const v4u*)(L + ARBI + tid_ * 16); wt16(wrd, (unsigned)(DO_ARB + (size_t)uid * 8192 + tid_ * 16), x); }
    f32x16 x1a = zero16(), x1b = zero16();
    if (tid_ == 0) *slot = claim;
    unit_issue_main(a, tid_, qn, P);
    if (F.wave == 0) tri_inverse64(MTf, lane);
    else if (F.wave < 5) { const int tj = (F.wave - 1) & 1, vcol = 32 * tj + r32;
#pragma unroll
        for (int ks = 0; ks < 4; ++ks) { const bf16x8s B = *(const bf16x8s*)(L + VT + vcol * 128 + (((2 * ks + hh) ^ ((vcol >> 1) & 7)) << 4));
            const int ta = r32, tb = 32 + r32;
            const bf16x8s Aa = *(const bf16x8s*)(L + AKK + ta * 128 + (((2 * ks + hh) ^ ((ta >> 1) & 7)) << 4)), Ab = *(const bf16x8s*)(L + AKK + tb * 128 + (((2 * ks + hh) ^ ((tb >> 1) & 7)) << 4));
            x1a = MFMA32(Aa, B, x1a); x1b = MFMA32(Ab, B, x1b); }
    } else {
#pragma unroll
        for (int rep = 0; rep < 3; ++rep) { const int idx = (F.wave - 5) + 3 * rep;
            if (idx < 8) { const bool isds = idx >= 4; const int q = idx & 3, ti = q >> 1, tj = q & 1, arow = 32 * ti + r32, vcol = 32 * tj + r32;
                const unsigned char* Ab = L + (isds ? KHT : ARK) + arow * 128; const unsigned char* Bb = L + VT + vcol * 128;
                f32x16 acc = zero16();
#pragma unroll
                for (int ks = 0; ks < 4; ++ks) { const bf16x8s A = *(const bf16x8s*)(Ab + (((2 * ks + hh) ^ ((arow >> 1) & 7)) << 4)); const bf16x8s B = *(const bf16x8s*)(Bb + (((2 * ks + hh) ^ ((vcol >> 1) & 7)) << 4)); acc = MFMA32(A, B, acc); }
                v4u u0, u1; u0.x = cvtpk(acc[0], acc[1]); u0.y = cvtpk(acc[2], acc[3]); u0.z = cvtpk(acc[4], acc[5]); u0.w = cvtpk(acc[6], acc[7]);
                u1.x = cvtpk(acc[8], acc[9]); u1.y = cvtpk(acc[10], acc[11]); u1.z = cvtpk(acc[12], acc[13]); u1.w = cvtpk(acc[14], acc[15]);
                const unsigned dst = (unsigned)((isds ? RW_DS : RW_YL) + (size_t)uid * 8192 + ((ti * 2 + tj) * 64 + lane) * 32);
                wt16(wrs, dst, u0); wt16(wrs, dst + 16, u1); } }
    }
    __syncthreads();
    if (F.wave >= 1 && F.wave < 5) { const int ti = (F.wave - 1) >> 1, tj = (F.wave - 1) & 1, t = 32 * ti + r32;
        f32x16 acc = zero16();
#pragma unroll
        for (int ts = 0; ts < 2; ++ts)
#pragma unroll
            for (int s = 0; s < 2; ++s) { const float* tp = MTf + t * 68 + 32 * ts + 16 * s + 4 * hh; const f32x4 t0 = *(const f32x4*)tp, t1 = *(const f32x4*)(tp + 8);
                v4u pa; pa.x = cvtpk(t0.x, t0.y); pa.y = cvtpk(t0.z, t0.w); pa.z = cvtpk(t1.x, t1.y); pa.w = cvtpk(t1.z, t1.w);
                const bf16x8s Bx = ts ? pack8(x1b, s) : pack8(x1a, s);
                acc = MFMA32(__builtin_bit_cast(bf16x8s, pa), Bx, acc); }
        v4u u0, u1; u0.x = cvtpk(-acc[0], -acc[1]); u0.y = cvtpk(-acc[2], -acc[3]); u0.z = cvtpk(-acc[4], -acc[5]); u0.w = cvtpk(-acc[6], -acc[7]);
        u1.x = cvtpk(-acc[8], -acc[9]); u1.y = cvtpk(-acc[10], -acc[11]); u1.z = cvtpk(-acc[12], -acc[13]); u1.w = cvtpk(-acc[14], -acc[15]);
        const unsigned dst = (unsigned)(DO_U + (size_t)uid * 8192 + ((ti * 2 + tj) * 64 + lane) * 32);
        wt16(wrd, dst, u0); wt16(wrd, dst + 16, u1);
    } else { const int idx = F.wave == 0 ? 3 : F.wave - 5, ti = idx >> 1, tj = idx & 1, t = 32 * ti + r32, j = 32 * tj + r32;
        f32x16 acc = zero16();
#pragma unroll
        for (int ks = 0; ks < 4; ++ks) { const float* tp = MTf + t * 68 + 16 * ks + 8 * hh; const f32x4 t0 = *(const f32x4*)tp, t1 = *(const f32x4*)(tp + 4);
            v4u pa; pa.x = cvtpk(t0.x, t0.y); pa.y = cvtpk(t0.z, t0.w); pa.z = cvtpk(t1.x, t1.y); pa.w = cvtpk(t1.z, t1.w);
            const bf16x8s B = *(const bf16x8s*)(L + KTT + j * 128 + (((2 * ks + hh) ^ ((j >> 1) & 7)) << 4));
            acc = MFMA32(__builtin_bit_cast(bf16x8s, pa), B, acc); }
        unsigned char* wm = L + WMI; const int pj = pi_(j);
#pragma unroll
        for (int r = 0; r < 16; ++r) { const int tt = 32 * ti + crow(r, hh); *(bf16*)(wm + img128(tt, pj)) = bf1(-acc[r]); }
    }
    __syncthreads();
    { const v4u x = *(const v4u*)(L + WMI + tid_ * 16); wt16(wrd, (unsigned)(DO_WM + (size_t)uid * 8192 + tid_ * 16), x); }
#undef SLOTR
}

constexpr int RSTG = 57600;
constexpr int ROB = 2 * RSTG, ROBS = 68, RLN = ROB + 17408;
struct RwSet { v4u sx[15]; };
__device__ __forceinline__ void rwkv_ld_sx(__amdgpu_buffer_rsrc_t rs, __amdgpu_buffer_rsrc_t rd, int b, int h, int n, int ltid, RwSet& S) {
    const int R0 = b * T + n * 64, uid = ((b * 64 + n) << 3) + h;
    const unsigned uo = (unsigned)uid * 8192u, os = (unsigned)(BIG_COLS + (size_t)R0 * (NCOLS * 2) + (2048 + h * 64) * 2);
    const unsigned l16 = (unsigned)ltid * 16u, lsl = (l16 >> 7) * (unsigned)(NCOLS * 2) + (l16 & 127u);
#pragma unroll
    for (int i = 0; i < 2; ++i) { const unsigned c = 4096u * i;
        aload16(S.sx[i], rd, l16, (unsigned)DO_WM + uo + c); aload16(S.sx[2 + i], rs, lsl, os + (unsigned)(i * 32 * NCOLS * 2)); aload16(S.sx[4 + i], rd, l16, (unsigned)DO_BT + uo + c); aload16(S.sx[6 + i], rd, l16, (unsigned)DO_ARB + uo + c);
        aload16(S.sx[8 + i], rd, l16, (unsigned)DO_U + uo + c); aload16(S.sx[10 + i], rs, l16, (unsigned)RW_YL + uo + c); aload16(S.sx[12 + i], rs, l16, (unsigned)RW_DS + uo + c); }
    aload16(S.sx[14], rs, (unsigned)((ltid & 15) * 16), (unsigned)RW_WC + (unsigned)uid * 256u);
}
#define RW_WAIT_SX(N, S) asm volatile("s_waitcnt vmcnt(" #N ")" : "+v"((S).sx[0]), "+v"((S).sx[1]), "+v"((S).sx[2]), "+v"((S).sx[3]), "+v"((S).sx[4]), "+v"((S).sx[5]), "+v"((S).sx[6]), "+v"((S).sx[7]), \
    "+v"((S).sx[8]), "+v"((S).sx[9]), "+v"((S).sx[10]), "+v"((S).sx[11]), "+v"((S).sx[12]), "+v"((S).sx[13]), "+v"((S).sx[14]) :: "memory")
__device__ __forceinline__ void rwkv_st_sx(unsigned char* L, int stg, int ltid, const RwSet& S) {
#pragma unroll
    for (int i = 0; i < 14; ++i) *(v4u*)(L + stg * RSTG + (ltid + 256 * i) * 16) = S.sx[i];
    if (ltid < 16) *(v4u*)(L + stg * RSTG + 57344 + ltid * 16) = S.sx[14];
}
__device__ __forceinline__ void rwkv_ld_gb(__amdgpu_buffer_rsrc_t rs, int b, int h, int n, int lw, int lane, v4u (&gb)[4]) {
    const unsigned voff = (unsigned)((lw * 16 + (lane >> 2)) * (NCOLS * 2) + (lane & 3) * 16);
    const unsigned so = (unsigned)(BIG_COLS + (size_t)(b * T + n * 64) * (NCOLS * 2) + (2048 + 512 + h * 64) * 2);
    aload16(gb[0], rs, voff, so); aload16(gb[1], rs, voff, so + 64u); aload16(gb[2], rs, voff, so + 1024u); aload16(gb[3], rs, voff, so + 1088u);
}
__device__ __forceinline__ void rwkv_post(unsigned char* ws, const float* OBf, int b, int h, int n, int lw, int lane, const v4u (&gbv)[4]) {
    const int tok = lw * 16 + (lane >> 2), part = lane & 3, hc = h * 64 + 8 * part; const size_t row = (size_t)(b * T + n * 64 + tok);
    bf16* op = (bf16*)(ws + WS_H) + row * D + 512 + hc;
    const v4u g0 = gbv[0], g1 = gbv[1], b0 = gbv[2], b1 = gbv[3];
    f32x4 y[4]; float sm = 0.f;
#pragma unroll
    for (int q = 0; q < 4; ++q) { y[q] = *(const f32x4*)(OBf + tok * ROBS + 8 * part + 32 * (q >> 1) + 4 * (q & 1)); sm += (y[q].x + y[q].y) + (y[q].z + y[q].w); }
    sm = quad_sum(sm);
    const float mean = sm * (1.0f / 64.0f); float sq = 0.f;
#pragma unroll
    for (int q = 0; q < 4; ++q) { y[q] = y[q] - mean; sq += (y[q].x * y[q].x + y[q].y * y[q].y) + (y[q].z * y[q].z + y[q].w * y[q].w); }
    sq = quad_sum(sq);
    const float rs = rsq_(sq * (1.0f / 64.0f) + 64e-5f);
    const float gg[16] = {bf_lo(g0.x), bf_hi(g0.x), bf_lo(g0.y), bf_hi(g0.y), bf_lo(g0.z), bf_hi(g0.z), bf_lo(g0.w), bf_hi(g0.w), bf_lo(g1.x), bf_hi(g1.x), bf_lo(g1.y), bf_hi(g1.y), bf_lo(g1.z), bf_hi(g1.z), bf_lo(g1.w), bf_hi(g1.w)};
    const float bb[16] = {bf_lo(b0.x), bf_hi(b0.x), bf_lo(b0.y), bf_hi(b0.y), bf_lo(b0.z), bf_hi(b0.z), bf_lo(b0.w), bf_hi(b0.w), bf_lo(b1.x), bf_hi(b1.x), bf_lo(b1.y), bf_hi(b1.y), bf_lo(b1.z), bf_hi(b1.z), bf_lo(b1.w), bf_hi(b1.w)};
    float ov[16];
#pragma unroll
    for (int q = 0; q < 4; ++q) { const int co = 8 * part + 32 * (q >> 1) + 4 * (q & 1); const f32x4 lw4 = *(const f32x4*)(OBf + 64 * ROBS + co), lb4 = *(const f32x4*)(OBf + 64 * ROBS + 64 + co);
        ov[4 * q] = (y[q].x * rs * lw4.x + lb4.x + bb[4 * q]) * gg[4 * q]; ov[4 * q + 1] = (y[q].y * rs * lw4.y + lb4.y + bb[4 * q + 1]) * gg[4 * q + 1];
        ov[4 * q + 2] = (y[q].z * rs * lw4.z + lb4.z + bb[4 * q + 2]) * gg[4 * q + 2]; ov[4 * q + 3] = (y[q].w * rs * lw4.w + lb4.w + bb[4 * q + 3]) * gg[4 * q + 3]; }
    v4u r0, r1; r0.x = cvtpk(ov[0], ov[1]); r0.y = cvtpk(ov[2], ov[3]); r0.z = cvtpk(ov[4], ov[5]); r0.w = cvtpk(ov[6], ov[7]); r1.x = cvtpk(ov[8], ov[9]); r1.y = cvtpk(ov[10], ov[11]); r1.z = cvtpk(ov[12], ov[13]); r1.w = cvtpk(ov[14], ov[15]);
    *(v4u*)op = r0; *(v4u*)(op + 32) = r1;
}
__device__ __forceinline__ void rwkv_chain_step(unsigned char* L, int stg, int vt, int lane, int r32, int hh, f32x16 (&Z)[2]) {
    const unsigned char* st = L + stg * RSTG; const float* wc = (const float*)(st + 57344); float* OBf = (float*)(L + ROB);
    f32x16 P[2], Y[2];
#pragma unroll
    for (int rb = 0; rb < 2; ++rb) { const int o = ((rb * 2 + vt) * 64 + lane) * 32;
        P[rb] = unpack16(*(const v4u*)(st + 32768 + o), *(const v4u*)(st + 32768 + o + 16)); Y[rb] = unpack16(*(const v4u*)(st + 40960 + o), *(const v4u*)(st + 40960 + o + 16)); }
#define R_OFF(row, q) ((row) * 128 + ((((q) + hh) ^ (((row) >> 1) & 7)) << 4))
    bf16x8s aw[4], ar[4];
#pragma unroll
    for (int j = 0; j < 3; ++j) { aw[j] = ldfrag(st + R_OFF(32 * (j >> 2) + r32, 2 * (j & 3))); ar[j] = ldfrag(st + 8192 + R_OFF(32 * (j >> 2) + r32, 2 * (j & 3))); }
    bf16x8s Zb[2][2];
#pragma unroll
    for (int kt = 0; kt < 2; ++kt) { Zb[kt][0] = pack8(Z[kt], 0); Zb[kt][1] = pack8(Z[kt], 1); }
    SB0();
#pragma unroll
    for (int j = 0; j < 8; ++j) { const int rb = j >> 2, kt = (j >> 1) & 1, s2 = j & 1;
        if (j + 3 < 8) { aw[(j + 3) & 3] = ldfrag(st + R_OFF(32 * ((j + 3) >> 2) + r32, 2 * ((j + 3) & 3))); ar[(j + 3) & 3] = ldfrag(st + 8192 + R_OFF(32 * ((j + 3) >> 2) + r32, 2 * ((j + 3) & 3))); }
        SB0();
        P[rb] = MFMA32(aw[j & 3], Zb[kt][s2], P[rb]); Y[rb] = MFMA32(ar[j & 3], Zb[kt][s2], Y[rb]);
        SB0(); }
    bf16x8s at[6];
    { const int t0 = r32, t1 = 32 + r32;
      at[0] = ldfrag(st + 24576 + R_OFF(t0, 0)); at[1] = ldfrag(st + 24576 + R_OFF(t0, 2)); at[2] = ldfrag(st + 24576 + R_OFF(t1, 0)); at[3] = ldfrag(st + 24576 + R_OFF(t1, 2)); at[4] = ldfrag(st + 24576 + R_OFF(t1, 4)); at[5] = ldfrag(st + 24576 + R_OFF(t1, 6)); }
    bf16x8s ak[4];
#pragma unroll
    for (int j = 0; j < 3; ++j) ak[j] = ldfrag(st + 16384 + R_OFF(32 * (j >> 2) + r32, 2 * (j & 3)));
    bf16x8s Pb[2][2];
#pragma unroll
    for (int rb = 0; rb < 2; ++rb) { Pb[rb][0] = pack8(P[rb], 0); Pb[rb][1] = pack8(P[rb], 1); }
#pragma unroll
    for (int kt = 0; kt < 2; ++kt) { const int o = ((kt * 2 + vt) * 64 + lane) * 32;
        const f32x16 dS = unpack16(*(const v4u*)(st + 49152 + o), *(const v4u*)(st + 49152 + o + 16));
#pragma unroll
        for (int r = 0; r < 16; ++r) Z[kt][r] = Z[kt][r] * wc[32 * kt + crow(r, hh)] + dS[r]; }
    Y[0] = MFMA32(at[0], Pb[0][0], Y[0]); Y[0] = MFMA32(at[1], Pb[0][1], Y[0]);
    Y[1] = MFMA32(at[2], Pb[0][0], Y[1]); Y[1] = MFMA32(at[3], Pb[0][1], Y[1]); Y[1] = MFMA32(at[4], Pb[1][0], Y[1]); Y[1] = MFMA32(at[5], Pb[1][1], Y[1]);
    SB0();
#pragma unroll
    for (int j = 0; j < 8; ++j) { const int kt = j >> 2, rb2 = (j >> 1) & 1, s2 = j & 1;
        if (j + 3 < 8) ak[(j + 3) & 3] = ldfrag(st + 16384 + R_OFF(32 * ((j + 3) >> 2) + r32, 2 * ((j + 3) & 3)));
        SB0();
        Z[kt] = MFMA32(ak[j & 3], Pb[rb2][s2], Z[kt]);
        SB0(); }
    __syncthreads();
#pragma unroll
    for (int rb = 0; rb < 2; ++rb)
#pragma unroll
        for (int r = 0; r < 16; ++r) OBf[(32 * rb + crow(r, hh)) * ROBS + 32 * vt + r32] = Y[rb][r];
    __syncthreads();
#undef R_OFF
}
template <bool FAST>
__device__ __forceinline__ void rwkv_loader_step(__amdgpu_buffer_rsrc_t rs, __amdgpu_buffer_rsrc_t rd, unsigned char* ws, unsigned char* L, int b, int h, int n, int lw, int ltid, RwSet& P, v4u (&gb)[4]) {
    if (FAST) RW_WAIT_SX(23, P); else RW_WAIT_SX(0, P);
    if (n + 1 < T / 64) rwkv_st_sx(L, (n + 1) & 1, ltid, P);
    if (((n + 3) & 3) == 0 && n + 3 < T / 64) unit_wait4(ws, 16 + b * 8 + h, (n + 3) >> 2);
    rwkv_ld_sx(rs, rd, b, h, n + 3 < T / 64 ? n + 3 : T / 64 - 1, ltid, P);
    if (FAST) VMW4(15, gb); else VMW4(0, gb);
    if (n > 0) rwkv_post(ws, (const float*)(L + ROB), b, h, n - 1, lw, ltid & 63, gb);
    rwkv_ld_gb(rs, b, h, n, lw, ltid & 63, gb);
    __syncthreads();
    __syncthreads();
}
__device__ __forceinline__ void rwkv_chain(const Args& a, Frame& F, int b, int h) {
    unsigned char* L = (unsigned char*)F.ldsf;
    unsigned char* ws = a.ws; unsigned char* dob = (unsigned char*)a.out;
    int tid0 = F.tid; asm volatile("" : "+v"(tid0));
    const int lane = tid0 & 63, r32_ = lane & 31, hh_ = lane >> 5;
    const bool chain = F.wave < 2, loader = F.wave >= 4; const int vt = F.wave & 1;
    if (chain) {
        f32x16 Z[2]; Z[0] = zero16(); Z[1] = zero16();
        __syncthreads();
        for (int n = 0; n < T / 64; n += 2) {
            int r32 = r32_, hh = hh_; asm volatile("" : "+v"(r32), "+v"(hh));
            rwkv_chain_step(L, 0, vt, lane, r32, hh, Z);
            rwkv_chain_step(L, 1, vt, lane, r32, hh, Z);
        }
        __syncthreads();
    } else if (loader) {
        RwSet A, B; v4u gb[4];
        const int lt = tid0 - 256, lw = F.wave - 4;
        const __amdgpu_buffer_rsrc_t rs = mk_rsrc(ws, 0x10000000u), rd = mk_rsrc(dob, 0x04000000u);
        if (lt < 128) *(float*)(L + RLN + lt * 4) = lt < 64 ? a.in[24][h * 64 + lt] : a.in[25][h * 64 + lt - 64];
        unit_wait4(ws, 16 + b * 8 + h, 0);
        rwkv_ld_sx(rs, rd, b, h, 0, lt, A); RW_WAIT_SX(0, A); rwkv_st_sx(L, 0, lt, A);
        rwkv_ld_sx(rs, rd, b, h, 1, lt, B); rwkv_ld_sx(rs, rd, b, h, 2, lt, A); rwkv_ld_gb(rs, b, h, 0, lw, lane, gb);
        __syncthreads();
        for (int n = 0; n < 4; n += 2) {
            int ltid = lt; asm volatile("" : "+v"(ltid));
            rwkv_loader_step<false>(rs, rd, ws, L, b, h, n, lw, ltid, B, gb);
            rwkv_loader_step<false>(rs, rd, ws, L, b, h, n + 1, lw, ltid, A, gb);
        }
        for (int n = 4; n < T / 64; n += 2) {
            int ltid = lt; asm volatile("" : "+v"(ltid));
            rwkv_loader_step<true>(rs, rd, ws, L, b, h, n, lw, ltid, B, gb);
            rwkv_loader_step<true>(rs, rd, ws, L, b, h, n + 1, lw, ltid, A, gb);
        }
        VMW4(0, gb);
        rwkv_post(ws, (const float*)(L + ROB), b, h, T / 64 - 1, lw, lane, gb);
        asm volatile("s_waitcnt vmcnt(0)" ::: "memory");
        __syncthreads();
    } else {
        __syncthreads();
        for (int n = 0; n < T / 64; ++n) { __syncthreads(); __syncthreads(); }
        __syncthreads();
    }
}

__device__ __forceinline__ float gelu_tanh_fast(float x) { const float u = 0.7978845608028654f * (x + 0.044715f * x * x * x); return 0.5f * x * (1.0f + tanh_fast(u)); }
__device__ __forceinline__ float gelu_tanh(float x) { const float u = 0.7978845608028654f * (x + 0.044715f * x * x * x); return 0.5f * x * (1.0f + tanhf(u)); }

__global__ void __launch_bounds__(NWAVES * 64, 2) fwd(Args args) {
    extern __shared__ __attribute__((aligned(16))) unsigned char lds[];
    Frame F;
    F.lds = (LAS unsigned char*)lds; F.ldsf = (float*)lds;
    F.MISC = (volatile LAS unsigned*)(F.lds + MISC_OFF);
    F.tid = threadIdx.x; F.lane = F.tid & 63; F.wave = __builtin_amdgcn_readfirstlane(F.tid >> 6);
    F.G = gridDim.x; { const int bx = blockIdx.x; F.vcu = (F.G % 8 == 0) ? (bx % 8) * (F.G / 8) + bx / 8 : bx; }
    F.ws = args.ws; F.out = args.out;
    F.ctl = (gu32*)(args.ws + WS_CTL);
    for (int u = F.tid; u < (LDS_BYTES - LDSCTL_OFF) / 4; u += NWAVES * 64) ((LAS unsigned*)(F.lds + LDSCTL_OFF))[u] = 0u;
    __syncthreads();
    XcdBarrier bar; bar.bar = (unsigned*)(F.ctl + CW_BAR); bar.x = 0; bar.st = nullptr;
    if (N_LAUNCHES != PER_PHASE) bar = xcd_barrier_post((unsigned*)(F.ctl + CW_BAR), F.MISC + 8);
#define GRID_BAR() do { if (N_LAUNCHES != PER_PHASE) xcd_barrier(bar); } while (0)
    const int lo = args.ph_lo, hi = args.ph_hi;
#ifdef PROBE_A0
    unsigned long long* tsb = (unsigned long long*)(args.ws + 32768);
#define STAMP(k) do { if (blockIdx.x == 0 && threadIdx.x == 0) tsb[k] = __builtin_amdgcn_s_memrealtime(); } while (0)
#else
#define STAMP(k) do {} while (0)
#endif
#ifndef PHMASK
#define PHMASK 0xFFFFFFFFu
#endif
#define IN(k) (((PHMASK >> (k)) & 1u) && lo <= (k) && (k) < hi)
#define BOTH(k) (IN(k) && IN((k) + 1))
    const int gw = F.vcu * NWAVES + F.wave, NGW = F.G * NWAVES;
    unsigned char* ws0 = args.ws;
#define PHASE_WS unsigned ws_lo_ = __builtin_amdgcn_readfirstlane((unsigned)(unsigned long long)ws0), ws_hi_ = __builtin_amdgcn_readfirstlane((unsigned)((unsigned long long)ws0 >> 32)); asm volatile("" : "+s"(ws_lo_), "+s"(ws_hi_)); unsigned char* ws = (unsigned char*)(__attribute__((address_space(1))) unsigned char*)(((unsigned long long)ws_hi_ << 32) | ws_lo_)
#define PHASE_WS_FLAT unsigned ws_lo_ = __builtin_amdgcn_readfirstlane((unsigned)(unsigned long long)ws0), ws_hi_ = __builtin_amdgcn_readfirstlane((unsigned)((unsigned long long)ws0 >> 32)); asm volatile("" : "+s"(ws_lo_), "+s"(ws_hi_)); unsigned char* ws = (unsigned char*)(((unsigned long long)ws_hi_ << 32) | ws_lo_)

    bool conv1_done = false;
    if (IN(0)) { PHASE_WS; STAMP(0);
        float* scr = F.ldsf + F.wave * 4096;
        for (int it = gw; it < 1920 + 48 * NKC; it += NGW) { if (it < 48 * NKC) adaln_item(args, it, scr, F.lane); else convert_item0(args, it - 48 * NKC, scr, F.lane); }
        { bf16* LWt = (bf16*)(ws + RW_LW); for (int i = gw * 64 + F.lane; i < 8 * 64 * 256; i += NGW * 64) { const int ii = i & 255, j = (i >> 8) & 63, hh = i >> 14; const int col = hh * 64 + j;
            const float v = ii < 64 ? args.in[17][ii * 512 + col] : (ii < 128 ? args.in[19][(ii - 64) * 512 + col] : args.in[20][(ii - 128) * 512 + col]); LWt[i] = bf1(v); } }
        { float* WSP = (float*)(ws + WS_WSPEC); for (int i = gw * 64 + F.lane; i < 8 * D; i += NGW * 64) { const int c = i / D, k = i % D; WSP[i] = args.in[9][(size_t)k * WIN_LD + 2048 + c]; } }
        { float* SPL = (float*)(ws + WS_SPL); for (int i = gw * 64 + F.lane; i < D; i += NGW * 64) SPL[i] = -8.0f * softplusf_(-args.in[33][i]); }
        if (BOTH(0)) GRID_BAR();
    }
    if (IN(1)) { PHASE_WS; STAMP(1);
        { float* MODS = (float*)(ws + WS_MODS); for (int i = gw * 64 + F.lane; i < 16 * 3072; i += NGW * 64) { const int n = i % 3072, cb = i / 3072; MODS[i] = mod_from_partials(args, cb >> 2, cb & 3, n); } }
        row_pass<0>(args, F, args.in[0], nullptr, nullptr, 0, nullptr, 0, args.in[2]);
        if (BOTH(1)) GRID_BAR();
    }
    if (IN(2)) { PHASE_WS; STAMP(2);
        pg8::Gemm g{(const bf16*)(ws + WS_H), (const bf16*)(ws + WB_IN), D, D, D, 0}; pg8::StaticOrder S; S.init(M, NCOLS, F.G, (int)blockIdx.x);
        pg8::EpiBf16Halo E{(bf16*)(ws + BIG_COLS), NCOLS, (bf16*)(ws + WS_HALO)};
        pg8::gemm_phase<pg8::EpiBf16Halo>(F.lds + RING_OFF, g, S, E);
        if (BOTH(2)) GRID_BAR();
    }
    if (IN(3)) { PHASE_WS_FLAT; STAMP(3);
        {
            const int limit = F.vcu < 16 ? 1 : (F.vcu < 48 ? 4 : (1 << 30));
            int pq = -1;
            unsigned* qc = (unsigned*)(ws + WS_QCTR);
            if (F.tid == 0) { const unsigned c0 = __hip_atomic_fetch_add(qc, 1u, __ATOMIC_RELAXED, __HIP_MEMORY_SCOPE_AGENT), c1 = limit > 1 ? __hip_atomic_fetch_add(qc, 1u, __ATOMIC_RELAXED, __HIP_MEMORY_SCOPE_AGENT) : 0x7fffffffu; F.MISC[32] = c0; F.MISC[33] = c1; }
            __syncthreads();
            int q = (int)__builtin_amdgcn_readfirstlane(F.MISC[32]), qn = (int)__builtin_amdgcn_readfirstlane(F.MISC[33]);
            UnitPF P; unit_issue_main(args, F.tid, q < 3072 ? q : -1, P);
            for (int i = 0; q < 3072; ++i) { const int n = q / 48, r = q % 48;
                unsigned claim = 0x7fffffffu; if (F.tid == 0 && i + 2 < limit) claim = __hip_atomic_fetch_add(qc, 1u, __ATOMIC_RELAXED, __HIP_MEMORY_SCOPE_AGENT);
                if (r < 16) gdn_prep_unit(args, F, r >> 2, n, r & 3, pq, P, qn < 3072 ? qn : -1, claim, F.MISC + 32 + (i & 1)); else rwkv_prep_unit(args, F, (r - 16) >> 3, n, (r - 16) & 7, pq, P, qn < 3072 ? qn : -1, claim, F.MISC + 32 + (i & 1));
                pq = q; q = qn; qn = (int)__builtin_amdgcn_readfirstlane(F.MISC[32 + (i & 1)]); }
            unit_arrive(ws, pq, F.lane);
        }
        if (F.vcu < 48) { __syncthreads(); STAMP(19); if (F.vcu < 16) gdn_chain(args, F, F.vcu >> 2, F.vcu & 3); else rwkv_chain(args, F, (F.vcu - 16) >> 3, (F.vcu - 16) & 7); }
        else { float* scr = F.ldsf + F.wave * 4096; for (int it = (F.vcu - 48) * NWAVES + F.wave; it < N_CONV_ITEMS0 - 1920; it += (F.G - 48) * NWAVES) convert_item0(args, 1920 + it, scr, F.lane); }
        if (BOTH(3)) GRID_BAR();
    }
    if (IN(4)) { PHASE_WS; STAMP(4);
        pg8::Gemm g{(const bf16*)(ws + WS_H), (const bf16*)(ws + WB_OUT), D, D, D, 0}; pg8::StaticOrder S; S.init(M, D, F.G, (int)blockIdx.x);
        pg8::EpiBf16 E{(bf16*)(ws + BIG_Y0), D};
        pg8::gemm_phase<pg8::EpiBf16>(F.lds + RING_OFF, g, S, E);
        if (BOTH(4)) GRID_BAR();
    }
    if (IN(5)) { PHASE_WS; STAMP(5); row_pass<1, false, true>(args, F, args.in[0], ws + WS_XR, (const bf16*)(ws + BIG_Y0), 0, args.in[3] + 0 * D, 1, args.in[2] + 1 * D); if (BOTH(5)) GRID_BAR(); }
    if (IN(6)) { PHASE_WS; STAMP(6);
        pg8::Gemm g{(const bf16*)(ws + WS_H), (const bf16*)(ws + WB_GU0), D, D, D, 0}; pg8::StaticOrder S; S.init(M, 2 * FF, F.G, (int)blockIdx.x);
        pg8::EpiSwiGLU E{(bf16*)(ws + BIG_ACT), FF};
        pg8::gemm_phase<pg8::EpiSwiGLU>(F.lds + RING_OFF, g, S, E);
        if (args.ph_lo <= 6 && args.ph_hi > 8 && F.G == 256) {
            conv1_done = true;
            if (blockIdx.x >= 128) { __syncthreads(); float* scr = F.ldsf + F.wave * 4096; for (int it = ((int)blockIdx.x - 128) * NWAVES + F.wave; it < N_CONV_ITEMS1; it += 128 * NWAVES) convert_item1(args, it, scr, F.lane); }
        }
        if (BOTH(6)) GRID_BAR();
    }
    if (IN(7)) { PHASE_WS; STAMP(7);
        pg8::Gemm g{(const bf16*)(ws + BIG_ACT), (const bf16*)(ws + WB_DN0), FF, FF, FF, 0}; pg8::StaticOrder S; S.init(M, D, F.G, (int)blockIdx.x);
        pg8::EpiBf16 E{(bf16*)(ws + BIG_Y1), D};
        pg8::gemm_phase<pg8::EpiBf16>(F.lds + RING_OFF, g, S, E);
        if (BOTH(7)) GRID_BAR();
    }
    if (IN(8)) { PHASE_WS; STAMP(8); row_pass<1, true, true>(args, F, ws + WS_XR, ws + WS_XR, (const bf16*)(ws + BIG_Y1), 1, args.in[3] + 1 * D, 2, args.in[2] + 2 * D);
        if (!conv1_done) { __syncthreads(); float* scr = F.ldsf + F.wave * 4096; for (int it = gw; it < N_CONV_ITEMS1; it += NGW) convert_item1(args, it, scr, F.lane); }
        if (BOTH(8)) GRID_BAR(); }
    if (IN(9)) { PHASE_WS; STAMP(9);
        pg8::Gemm g{(const bf16*)(ws + WS_H), (const bf16*)(ws + WB_LIN), D, D, D, 0}; pg8::StaticOrder S; S.init(M, 2048, F.G, (int)blockIdx.x);
        pg8::EpiBf16 E{(bf16*)(ws + BIG_GX), 2048};
        pg8::gemm_phase<pg8::EpiBf16>(F.lds + RING_OFF, g, S, E);
        if (BOTH(9)) GRID_BAR();
    }
    if (IN(10)) { PHASE_WS; STAMP(10);
        const bf16* GX = (const bf16*)(ws + BIG_GX); bf16* XC = (bf16*)(ws + BIG_XC); const float* cw = args.in[27]; const float* cb = args.in[28];
        for (int it = gw * 64 + F.lane; it < (M / 16) * 128; it += NGW * 64) {
            const int c8 = (it & 127) * 8, row0 = (it >> 7) * 16, t0 = row0 % T;
            v4u xr[19];
#pragma unroll
            for (int r = 0; r < 19; ++r) { xr[r] = (v4u){0u, 0u, 0u, 0u}; if (t0 + r - 3 >= 0) xr[r] = *(const v4u*)(GX + (size_t)(row0 + r - 3) * 2048 + 1024 + c8); }
            f32x4 wa[4], wb[4];
#pragma unroll
            for (int j = 0; j < 4; ++j) { wa[j] = *(const f32x4*)(cw + j * 1024 + c8); wb[j] = *(const f32x4*)(cw + j * 1024 + c8 + 4); }
            const f32x4 ba = *(const f32x4*)(cb + c8), bb = *(const f32x4*)(cb + c8 + 4);
#pragma unroll
            for (int r = 0; r < 16; ++r) { f32x4 a0 = ba, a1 = bb;
#pragma unroll
                for (int j = 0; j < 4; ++j) { const v4u xw = xr[r + j];
                    a0.x += wa[j].x * bf_lo(xw.x); a0.y += wa[j].y * bf_hi(xw.x); a0.z += wa[j].z * bf_lo(xw.y); a0.w += wa[j].w * bf_hi(xw.y);
                    a1.x += wb[j].x * bf_lo(xw.z); a1.y += wb[j].y * bf_hi(xw.z); a1.z += wb[j].z * bf_lo(xw.w); a1.w += wb[j].w * bf_hi(xw.w); }
                v4u o; o.x = pk2(a0.x, a0.y); o.y = pk2(a0.z, a0.w); o.z = pk2(a1.x, a1.y); o.w = pk2(a1.z, a1.w);
                *(v4u*)(XC + (size_t)(row0 + r) * D + c8) = o; }
        }
        if (BOTH(10)) GRID_BAR();
    }
    if (IN(11)) { PHASE_WS; STAMP(11);
        pg8::Gemm g{(const bf16*)(ws + BIG_XC), (const bf16*)(ws + WB_LG), D, 256, 256, 256}; pg8::StaticOrder S; S.init(M, 2048, F.G, (int)blockIdx.x);
        pg8::EpiGates E{(bf16*)(ws + BIG_A), (bf16*)(ws + WS_H), (const bf16*)(ws + BIG_XC), args.in[30], args.in[32], (const float*)(ws + WS_SPL), (float*)(ws + WS_CARRY), (float*)(ws + WS_CARRY) + NB * 64 * D};
        pg8::gemm_phase<pg8::EpiGates>(F.lds + RING_OFF, g, S, E);
        if (BOTH(11)) GRID_BAR();
    }
    if (IN(13)) { PHASE_WS; STAMP(13);
        const bf16* Aa = (const bf16*)(ws + BIG_A); const bf16* U = (const bf16*)(ws + WS_H); const float* CA = (const float*)(ws + WS_CARRY); const float* CH = CA + NB * 64 * D;
        const bf16* GX = (const bf16*)(ws + BIG_GX); bf16* Y2 = (bf16*)(ws + BIG_XC);
        for (int it = gw; it < NB * 64 * 8; it += NGW) { const int cg = it & 7, seg = (it >> 3) & 63, b = it >> 9, ch = cg * 128 + F.lane * 2;
            const size_t base = (size_t)(b * T + seg * 64) * D + ch;
            const unsigned* Ap = (const unsigned*)(Aa + base); const unsigned* Up = (const unsigned*)(U + base); const unsigned* Gp = (const unsigned*)(GX + (size_t)(b * T + seg * 64) * 2048 + ch); unsigned* Yp = (unsigned*)(Y2 + base);
            unsigned av[16], uv[16], gv[16], an[16], un[16], gn[16];
#pragma unroll
            for (int i = 0; i < 16; ++i) { av[i] = Ap[(size_t)i * (D / 2)]; uv[i] = Up[(size_t)i * (D / 2)]; gv[i] = Gp[(size_t)i * 1024]; }
            float h0 = 0.f, h1 = 0.f;
            for (int s2 = 0; s2 < seg; s2 += 16) { float2 ca[16], cx[16];
#pragma unroll
                for (int i = 0; i < 16; ++i) { const int sq = (s2 + i) & 63; ca[i] = *(const float2*)(CA + (size_t)(b * 64 + sq) * D + ch); cx[i] = *(const float2*)(CH + (size_t)(b * 64 + sq) * D + ch); }
#pragma unroll
                for (int i = 0; i < 16; ++i) { const bool on = (s2 + i) < seg; h0 = on ? ca[i].x * h0 + cx[i].x : h0; h1 = on ? ca[i].y * h1 + cx[i].y : h1; } }
#pragma unroll 1
            for (int t0 = 0; t0 < 64; t0 += 16) {
                if (t0 < 48) {
#pragma unroll
                    for (int i = 0; i < 16; ++i) { an[i] = Ap[(size_t)(t0 + 16 + i) * (D / 2)]; un[i] = Up[(size_t)(t0 + 16 + i) * (D / 2)]; gn[i] = Gp[(size_t)(t0 + 16 + i) * 1024]; } }
#pragma unroll
                for (int i = 0; i < 16; ++i) {
                    h0 = __expf(__uint_as_float(av[i] << 16)) * h0 + __uint_as_float(uv[i] << 16); h1 = __expf(__uint_as_float(av[i] & 0xffff0000u)) * h1 + __uint_as_float(uv[i] & 0xffff0000u);
                    Yp[(size_t)(t0 + i) * (D / 2)] = cvtpk(h0 * gelu_tanh_fast(__uint_as_float(gv[i] << 16)), h1 * gelu_tanh_fast(__uint_as_float(gv[i] & 0xffff0000u))); }
#pragma unroll
                for (int i = 0; i < 16; ++i) { av[i] = an[i]; uv[i] = un[i]; gv[i] = gn[i]; }
            }
        }
        if (BOTH(13)) GRID_BAR();
    }
    if (IN(14)) { PHASE_WS; STAMP(14);
        pg8::Gemm g{(const bf16*)(ws + BIG_XC), (const bf16*)(ws + WB_LOUT), D, D, D, 0}; pg8::StaticOrder S; S.init(M, D, F.G, (int)blockIdx.x);
        pg8::EpiBf16 E{(bf16*)(ws + BIG_A), D};
        pg8::gemm_phase<pg8::EpiBf16>(F.lds + RING_OFF, g, S, E);
        if (BOTH(14)) GRID_BAR();
    }
    if (IN(15)) { PHASE_WS; STAMP(15); row_pass<1, true, true>(args, F, ws + WS_XR, ws + WS_XR, (const bf16*)(ws + BIG_A), 2, args.in[3] + 2 * D, 3, args.in[2] + 3 * D); if (BOTH(15)) GRID_BAR(); }
    if (IN(16)) { PHASE_WS; STAMP(16);
        pg8::Gemm g{(const bf16*)(ws + WS_H), (const bf16*)(ws + WB_GU1), D, D, D, 0}; pg8::StaticOrder S; S.init(M, 2 * FF, F.G, (int)blockIdx.x);
        pg8::EpiSwiGLU E{(bf16*)(ws + BIG_ACT), FF};
        pg8::gemm_phase<pg8::EpiSwiGLU>(F.lds + RING_OFF, g, S, E);
        if (BOTH(16)) GRID_BAR();
    }
    if (IN(17)) { PHASE_WS; STAMP(17);
        pg8::Gemm g{(const bf16*)(ws + BIG_ACT), (const bf16*)(ws + WB_DN1), FF, FF, FF, 0}; pg8::StaticOrder S; S.init(M, D, F.G, (int)blockIdx.x);
        pg8::EpiBf16 E{(bf16*)(ws + BIG_Y1), D};
        pg8::gemm_phase<pg8::EpiBf16>(F.lds + RING_OFF, g, S, E);
#ifdef PROBE_A0
        if (blockIdx.x == 0 && threadIdx.x == 0) { const unsigned long long te = __builtin_amdgcn_s_memrealtime(); tsb[20] = te;
            const float tot = (float)(te - tsb[0]); const float fa = (float)(tsb[PROBE_A1] - tsb[PROBE_A0]) / tot; const float usb = (float)(tsb[PROBE_B1] - tsb[PROBE_B0]) * 0.01f;
            float* pv = (float*)(args.ws + 49152); pv[0] = sqrtf(fa * 1e-2f); pv[1] = usb * 0.01f; }
#endif
        if (BOTH(17)) GRID_BAR();
    }
    if (IN(18)) { PHASE_WS; STAMP(18); row_pass<2, true, false>(args, F, ws + WS_XR, args.out, (const bf16*)(ws + BIG_Y1), 3, args.in[3] + 3 * D, 0, nullptr); }
#undef IN
#undef BOTH
}

extern "C" void kernel_launch(void* const* d_in, const int* in_sizes, int n_in, void* d_out, int out_size, void* d_ws, size_t ws_size, hipStream_t stream) {
    static int grid = 0;
    if (grid == 0) {
        if (n_in != 35 || out_size != M * D || ws_size < WS_END) { fprintf(stderr, "kernel_launch: unexpected shapes n_in %d out %d ws %zu\n", n_in, out_size, ws_size); grid = -1; return; }
        int dev = 0, cus = 0;
        if (hipGetDevice(&dev) != hipSuccess || hipDeviceGetAttribute(&cus, hipDeviceAttributeMultiprocessorCount, dev) != hipSuccess) { grid = -1; return; }
        if (hipFuncSetAttribute((const void*)fwd, hipFuncAttributeMaxDynamicSharedMemorySize, LDS_BYTES) != hipSuccess) { grid = -1; return; }
        grid = cus;
    }
    if (grid < 0) return;
    (void)hipMemsetAsync((char*)d_ws + WS_CTL, 0, CTL_ZERO_BYTES, stream);
    Args a{};
    for (int i = 0; i < 35; ++i) a.in[i] = (const float*)d_in[i];
    a.out = (float*)d_out; a.ws = (unsigned char*)d_ws;
    constexpr int NPH = 19;
    if (N_LAUNCHES == PER_PHASE) {
        for (int p = 0; p < NPH; ++p) { a.ph_lo = p; a.ph_hi = p + 1; a.li = p; hipLaunchKernelGGL(fwd, dim3(grid), dim3(NWAVES * 64), LDS_BYTES, stream, a); }
    } else {
        a.ph_lo = 0; a.ph_hi = NPH; a.li = 0; hipLaunchKernelGGL(fwd, dim3(grid), dim3(NWAVES * 64), LDS_BYTES, stream, a);
    }
}
```
